# Optimizing an MI355X kernel written in HIP

```python
import math
import jax, jax.numpy as jnp
from jax import lax
import numpy as np

D_MODEL = 1024
BATCH = 2
SEQ = 8192
DEPTH = 1

GRID_W = 64
CTX_LEN = 256
MIX_WIDTH = D_MODEL
POOL_WIDTH = MIX_WIDTH // 2
S5_WIDTH = MIX_WIDTH - POOL_WIDTH
POOL_WINDOWS = (2, 4, 8, 16)
N_POOL_GROUPS = len(POOL_WINDOWS)
POOL_CH = POOL_WIDTH // N_POOL_GROUPS
S5_GROUP = 16
S5_GROUPS = S5_WIDTH // S5_GROUP
S5_STATE = 64
D_FF = 2816
N_MOD = 9
EPS = 1e-6
DT_MIN = 1e-3
DT_MAX = 1e-1

kernel_name = "hybrid_pool_s5_macaron_dit_layer"


def rmsnorm(x, g):
    xf = x.astype(jnp.float32)
    y = xf * lax.rsqrt(jnp.mean(xf * xf, axis=-1, keepdims=True) + EPS)
    return (y * g.astype(jnp.float32)).astype(x.dtype)


def modulate(h, shift, scale):
    return h * (1 + scale) + shift


def swiglu(h, w1, w3, w2):
    return (jax.nn.silu(h @ w1) * (h @ w3)) @ w2


def ffn_sublayer(x, g, shift, scale, gate, w1, w3, w2):
    h = modulate(rmsnorm(x, g), shift, scale)
    return x + 0.5 * gate * swiglu(h, w1, w3, w2)


def window_mean(v, w, axis):
    n = v.shape[axis]
    lo = w // 2
    hi = w - 1 - lo
    t = np.arange(n)
    i_hi = np.clip(t + hi + 1, 0, n)
    i_lo = np.clip(t - lo, 0, n)
    vf = jnp.moveaxis(v.astype(jnp.float32), axis, 0)
    s = jnp.concatenate([jnp.zeros_like(vf[:1]), jnp.cumsum(vf, axis=0)], axis=0)
    cnt = (i_hi - i_lo).astype(np.float32).reshape((n,) + (1,) * (vf.ndim - 1))
    m = (s[i_hi] - s[i_lo]) / cnt
    return jnp.moveaxis(m, 0, axis).astype(v.dtype)


def pool_mixer(u, w_pool, scale, rows):
    bn, length, _ = u.shape
    ug = u.reshape(bn, length, N_POOL_GROUPS, POOL_CH)
    outs = []
    for k, w in enumerate(POOL_WINDOWS):
        v = ug[:, :, k]
        if rows is None:
            p = window_mean(v, w, 1)
        else:
            v2 = v.reshape(bn, rows, GRID_W, POOL_CH)
            p = window_mean(window_mean(v2, w, 1), w, 2).reshape(bn, length, POOL_CH)
        outs.append(p - v)
    d = jnp.stack(outs, axis=2)
    y = jnp.einsum('blkc,kcd->blkd', d, w_pool).reshape(bn, length, POOL_WIDTH)
    return y * scale


def s5_discretise(a_re, a_im, log_dt, b):
    lam = lax.complex(a_re.astype(jnp.float32), a_im.astype(jnp.float32))
    dt = jnp.exp(log_dt.astype(jnp.float32))[:, None]
    abar = jnp.exp(lam * dt)
    bbar = ((abar - 1) / lam)[..., None] * b
    return abar, bbar


def _ssm_combine(e1, e2):
    a1, b1 = e1
    a2, b2 = e2
    return a2 * a1, a2 * b1 + b2


def s5_scan(abar, bbar, u, h0, reverse):
    bu = jnp.einsum('gpc,blgc->blgp', bbar, u.astype(jnp.float32).astype(jnp.complex64))
    if h0 is not None:
        edge = -1 if reverse else 0
        bu = bu.at[:, edge].add(abar * h0)
    a = jnp.broadcast_to(abar, bu.shape)
    _, h = lax.associative_scan(_ssm_combine, (a, bu), axis=1, reverse=reverse)
    return h


def s5_readout(h_f, h_b, u, c_f, c_b, d_skip, w_glu):
    bn, length = u.shape[:2]
    y = (jnp.einsum('gcp,blgp->blgc', c_f, h_f).real
         + jnp.einsum('gcp,blgp->blgc', c_b, h_b).real)
    y = y.reshape(bn, length, S5_WIDTH) + d_skip.astype(jnp.float32) * u.reshape(bn, length, S5_WIDTH).astype(jnp.float32)
    y = jax.nn.gelu(y)
    y = y * jax.nn.sigmoid(y @ w_glu.astype(jnp.float32))
    return y.astype(u.dtype)


def setup_inputs(seed: int = 0) -> dict:
    key = jax.random.key(seed)
    ks = jax.random.split(key, 24)
    f32 = jnp.float32
    D, F, G, P = D_MODEL, D_FF, S5_GROUPS, S5_STATE
    nrm = lambda k, shape, s: jax.random.normal(k, shape, f32) * s
    n_idx = jnp.arange(P, dtype=f32)
    log_dt = jax.random.uniform(ks[14], (DEPTH, 2, G), f32, math.log(DT_MIN), math.log(DT_MAX))
    return {
        "x": nrm(ks[0], (BATCH, SEQ, D), 1.0),
        "c": nrm(ks[1], (BATCH, D), 1.0),
        "ctx": nrm(ks[2], (BATCH, CTX_LEN, D), 1.0),
        "c_ctx": nrm(ks[3], (D,), 1.0),
        "norm_g": 1.0 + nrm(ks[4], (DEPTH, 3, D), 0.02),
        "w_ada": nrm(ks[5], (DEPTH, D, N_MOD * D), 0.5 * D ** -0.5),
        "b_ada": nrm(ks[6], (DEPTH, N_MOD * D), 0.01),
        "ffn_w1": nrm(ks[7], (DEPTH, 2, D, F), D ** -0.5),
        "ffn_w3": nrm(ks[8], (DEPTH, 2, D, F), D ** -0.5),
        "ffn_w2": nrm(ks[9], (DEPTH, 2, F, D), F ** -0.5),
        "w_in": nrm(ks[10], (DEPTH, D, MIX_WIDTH), D ** -0.5),
        "pool_w": nrm(ks[11], (DEPTH, N_POOL_GROUPS, POOL_CH, POOL_CH), POOL_CH ** -0.5),
        "pool_scale": 1.0 + nrm(ks[12], (DEPTH, POOL_WIDTH), 0.02),
        "s5_a_re": -0.5 + nrm(ks[13], (DEPTH, 2, G, P), 0.01),
        "s5_a_im": math.pi * n_idx + nrm(ks[15], (DEPTH, 2, G, P), 0.01),
        "s5_log_dt": log_dt,
        "s5_b_re": nrm(ks[16], (DEPTH, G, P, S5_GROUP), (2.0 * S5_GROUP) ** -0.5),
        "s5_b_im": nrm(ks[17], (DEPTH, G, P, S5_GROUP), (2.0 * S5_GROUP) ** -0.5),
        "s5_c_re": nrm(ks[18], (DEPTH, 2, G, S5_GROUP, P), (2.0 * P) ** -0.5),
        "s5_c_im": nrm(ks[19], (DEPTH, 2, G, S5_GROUP, P), (2.0 * P) ** -0.5),
        "s5_d": nrm(ks[20], (DEPTH, S5_WIDTH), 1.0),
        "s5_w_glu": nrm(ks[21], (DEPTH, S5_WIDTH, S5_WIDTH), S5_WIDTH ** -0.5),
        "w_out": nrm(ks[22], (DEPTH, MIX_WIDTH, D), MIX_WIDTH ** -0.5),
        "final_g": 1.0 + nrm(ks[23], (D,), 0.02),
    }


def reference(x, c, ctx, c_ctx, norm_g, w_ada, b_ada, ffn_w1, ffn_w3, ffn_w2, w_in,
              pool_w, pool_scale, s5_a_re, s5_a_im, s5_log_dt, s5_b_re, s5_b_im,
              s5_c_re, s5_c_im, s5_d, s5_w_glu, w_out, final_g):
    f32 = jnp.float32
    bn, length, _ = x.shape
    rows = length // GRID_W
    lc = ctx.shape[1]
    xl, xc = x, ctx
    for l in range(DEPTH):
        last = l == DEPTH - 1
        ml = jnp.split((jax.nn.silu(c) @ w_ada[l] + b_ada[l])[:, None, :], N_MOD, axis=-1)
        mc = jnp.split((jax.nn.silu(c_ctx) @ w_ada[l] + b_ada[l])[None, None, :], N_MOD, axis=-1)

        xl = ffn_sublayer(xl, norm_g[l, 0], ml[0], ml[1], ml[2], ffn_w1[l, 0], ffn_w3[l, 0], ffn_w2[l, 0])
        xc = ffn_sublayer(xc, norm_g[l, 0], mc[0], mc[1], mc[2], ffn_w1[l, 0], ffn_w3[l, 0], ffn_w2[l, 0])

        hl = modulate(rmsnorm(xl, norm_g[l, 1]), ml[3], ml[4]) @ w_in[l]
        hc = modulate(rmsnorm(xc, norm_g[l, 1]), mc[3], mc[4]) @ w_in[l]
        pool_in_l, s5_in_l = hl[..., :POOL_WIDTH], hl[..., POOL_WIDTH:]
        pool_in_c, s5_in_c = hc[..., :POOL_WIDTH], hc[..., POOL_WIDTH:]

        b_cplx = lax.complex(s5_b_re[l].astype(f32), s5_b_im[l].astype(f32))
        abar_f, bbar_f = s5_discretise(s5_a_re[l, 0], s5_a_im[l, 0], s5_log_dt[l, 0], b_cplx)
        abar_b, bbar_b = s5_discretise(s5_a_re[l, 1], s5_a_im[l, 1], s5_log_dt[l, 1], b_cplx)
        c_f = lax.complex(s5_c_re[l, 0].astype(f32), s5_c_im[l, 0].astype(f32))
        c_b = lax.complex(s5_c_re[l, 1].astype(f32), s5_c_im[l, 1].astype(f32))

        uc = s5_in_c.reshape(bn, lc, S5_GROUPS, S5_GROUP)
        ul = s5_in_l.reshape(bn, length, S5_GROUPS, S5_GROUP)
        hc_f = s5_scan(abar_f, bbar_f, uc, None, False)
        hc_b = s5_scan(abar_b, bbar_b, uc, None, True)
        hl_f = s5_scan(abar_f, bbar_f, ul, hc_f[:, -1], False)
        hl_b = s5_scan(abar_b, bbar_b, ul, hc_b[:, 0], True)

        mix_l = jnp.concatenate([
            pool_mixer(pool_in_l, pool_w[l], pool_scale[l], rows),
            s5_readout(hl_f, hl_b, ul, c_f, c_b, s5_d[l], s5_w_glu[l]),
        ], axis=-1) @ w_out[l]
        xl = xl + ml[5] * mix_l
        if not last:
            mix_c = jnp.concatenate([
                pool_mixer(pool_in_c, pool_w[l], pool_scale[l], None),
                s5_readout(hc_f, hc_b, uc, c_f, c_b, s5_d[l], s5_w_glu[l]),
            ], axis=-1) @ w_out[l]
            xc = xc + mc[5] * mix_c

        xl = ffn_sublayer(xl, norm_g[l, 2], ml[6], ml[7], ml[8], ffn_w1[l, 1], ffn_w3[l, 1], ffn_w2[l, 1])
        if not last:
            xc = ffn_sublayer(xc, norm_g[l, 2], mc[6], mc[7], mc[8], ffn_w1[l, 1], ffn_w3[l, 1], ffn_w2[l, 1])
    return rmsnorm(xl, final_g)
```

```cpp
#include <hip/hip_runtime.h>
#include <hip/hip_cooperative_groups.h>
#include <cstdio>
#include <cstdint>
namespace cg = cooperative_groups;

#define LAS __attribute__((address_space(3)))
typedef unsigned short bf16_t;
typedef short bf16x8 __attribute__((ext_vector_type(8)));
typedef float f32x4 __attribute__((ext_vector_type(4)));
typedef float f32x2 __attribute__((ext_vector_type(2)));
typedef unsigned u32x4 __attribute__((ext_vector_type(4)));
typedef unsigned u32x2 __attribute__((ext_vector_type(2)));

__device__ __forceinline__ unsigned cvt_pk_bf16(float lo, float hi) { unsigned r; asm volatile("v_cvt_pk_bf16_f32 %0, %1, %2" : "=v"(r) : "v"(lo), "v"(hi)); return r; }
__device__ __forceinline__ float bf_lo(unsigned w) { return __builtin_bit_cast(float, w << 16); }
__device__ __forceinline__ float bf_hi(unsigned w) { return __builtin_bit_cast(float, w & 0xffff0000u); }
__device__ __forceinline__ float bf2f(bf16_t h) { return __builtin_bit_cast(float, ((unsigned)h) << 16); }
__device__ __forceinline__ float sigmoid_fast(float x) { return __builtin_amdgcn_rcpf(1.f + __expf(-x)); }
__device__ __forceinline__ float silu_fast(float x) { return x * sigmoid_fast(x); }
__device__ __forceinline__ float gelu_tanh(float x) { const float z = 1.5957691216057308f * (x + 0.044715f * x * x * x); return x * sigmoid_fast(z); }

namespace pg8 {
constexpr int BM = 256, BK = 64, HALF = 128, HTB = HALF * BK * 2, STAGE_BYTES = 8 * HTB, NXCD = 8, WGM = 8;
__host__ __device__ __forceinline__ int lds_byte(int r, int c) { const int st = (r >> 4) * 2 + (c >> 5), rr = r & 15, cc = c & 31, ob = rr * 64 + cc * 2; return st * 1024 + (ob ^ (((ob >> 9) & 1) << 5)); }
__host__ __device__ __forceinline__ void stage_rc(int b, int& R, int& C) { const int st = b / 1024, sb = b % 1024, swz = sb ^ (((sb >> 9) & 1) << 5); R = (st >> 1) * 16 + swz / 64; C = (st & 1) * 32 + (swz % 64) / 2; }
__host__ __device__ __forceinline__ int perm32(int rho) { const int n = rho >> 4, i = rho & 15; return 8 * (i >> 2) + 4 * n + (i & 3); }

struct Unit { int pm, pn, g; };
struct Gemm { const bf16_t* A; const bf16_t* Bt; int lda, ldb, K; size_t gsA, gsB; };

struct StaticOrder {
    int nM, nN, nwg, G, c;
    __device__ void init(int M, int N, int G_, int c_) { nM = M / BM; nN = N / BM; nwg = nM * nN; G = G_; c = c_; }
    __device__ bool next(int i, Unit& u) const {
        const long L = (long)i * G + c; if (L >= nwg) return false;
        int wgid = (int)L; { const int q = nwg / NXCD, r = nwg % NXCD, xcd = wgid % NXCD, off = wgid / NXCD; wgid = (xcd < r ? xcd * (q + 1) : r * (q + 1) + (xcd - r) * q) + off; }
        const int nig = WGM * nN, gid = wgid / nig, fm = gid * WGM, gsz = (nM - fm) < WGM ? (nM - fm) : WGM;
        u.pm = fm + ((wgid % nig) % gsz); u.pn = (wgid % nig) / gsz; u.g = 0; return true;
    }
};
struct GroupOrder {
    int nM, nN, ng, G, c;
    __device__ void init(int nM_, int nN_, int ng_, int G_, int c_) { nM = nM_; nN = nN_; ng = ng_; G = G_; c = c_; }
    __device__ bool next(int i, Unit& u) const {
        if (c >= G) return false;
        const long L = (long)i * G + c; if (L >= (long)ng * nM * nN) return false;
        const int per = nM * nN, l = (int)L; u.g = l / per; const int r = l % per; u.pm = r / nN; u.pn = r % nN; return true;
    }
};

template <class Epi, class Sched>
__device__ __forceinline__ void gemm_phase(LAS unsigned char* lds, const Gemm g, const Sched& S, const Epi& E) {
    int tid_ = threadIdx.x; asm volatile("" : "+v"(tid_));
    const int tid = tid_, wid = __builtin_amdgcn_readfirstlane(tid >> 6), lane = tid & 63, wr = wid >> 2, wc = wid & 3, fr = lane & 15, fq = lane >> 4;
    const int nt = g.K / BK;
    unsigned voffA[2], voffB[2];
#pragma unroll
    for (int i = 0; i < 2; ++i) { int R, C; stage_rc(tid * 16 + i * 8192, R, C); const int Rb = Epi::PERM ? ((R & ~31) + perm32(R & 31)) : R;
        voffA[i] = (unsigned)(R * g.lda + C) * 2u; voffB[i] = (unsigned)(Rb * g.ldb + C) * 2u; }
    const size_t kstep = (size_t)(BK * 2);
    const size_t hstepA = (size_t)HALF * g.lda * 2, hstepB = (size_t)HALF * g.ldb * 2;
    const size_t tstepA = 2 * hstepA, tstepB = 2 * hstepB;
    const unsigned ldsw = (unsigned)wid * 1024u;
    const int aoff = lds_byte(wr * 64 + fr, fq * 8), boff = lds_byte(wc * 32 + fr, fq * 8);
#define PG8_SA(b, h) (((b) * 2 + (h)) * HTB)
#define PG8_SB(b, h) ((4 + (b) * 2 + (h)) * HTB)
#define PG8_STAGE(bufoff, gbase, voff) do { _Pragma("unroll") for (int _i = 0; _i < 2; ++_i) \
        __builtin_amdgcn_global_load_lds((const unsigned*)((const char*)(gbase) + (voff)[_i]), (LAS unsigned*)(lds + (bufoff) + ldsw + _i * 8192), 16, 0, 0); } while (0)
#define PG8_LDA(dst, b, h) do { _Pragma("unroll") for (int m = 0; m < 4; ++m) _Pragma("unroll") for (int k = 0; k < 2; ++k) dst[m][k] = *(const LAS bf16x8*)(lds + PG8_SA(b, h) + aoff + m * 2048 + k * 1024); } while (0)
#define PG8_LDB(dst, b, h) do { _Pragma("unroll") for (int n = 0; n < 2; ++n) _Pragma("unroll") for (int k = 0; k < 2; ++k) dst[n][k] = *(const LAS bf16x8*)(lds + PG8_SB(b, h) + boff + n * 2048 + k * 1024); } while (0)
#define PG8_MMA(ai, bj, At, Bt) do { __builtin_amdgcn_s_setprio(1); _Pragma("unroll") for (int m = 0; m < 4; ++m) _Pragma("unroll") for (int n = 0; n < 2; ++n) _Pragma("unroll") for (int k = 0; k < 2; ++k) \
        acc[ai][bj][m][n] = __builtin_amdgcn_mfma_f32_16x16x32_bf16(Bt[n][k], At[m][k], acc[ai][bj][m][n], 0, 0, 0); __builtin_amdgcn_s_setprio(0); } while (0)
#define PG8_WAIT_V(n) asm volatile("s_waitcnt vmcnt(" #n ")" ::: "memory")
#define PG8_WAIT_L(n) asm volatile("s_waitcnt lgkmcnt(" #n ")" ::: "memory")
#define PG8_BAR __builtin_amdgcn_s_barrier()
#define PG8_SCHED __builtin_amdgcn_sched_barrier(0)
    Unit cur, nxt; int ui = 0;
    if (!S.next(0, cur)) return;
    f32x4 acc[2][2][4][2];
#pragma unroll
    for (int a = 0; a < 2; ++a)
#pragma unroll
        for (int b = 0; b < 2; ++b)
#pragma unroll
            for (int m = 0; m < 4; ++m)
#pragma unroll
                for (int n = 0; n < 2; ++n) acc[a][b][m][n] = (f32x4){0.f, 0.f, 0.f, 0.f};
    bf16x8 At[4][2], B0[2][2], B1[2][2];
    const char* cA = (const char*)(g.A + (size_t)cur.g * g.gsA) + (size_t)cur.pm * tstepA; const char* cB = (const char*)(g.Bt + (size_t)cur.g * g.gsB) + (size_t)cur.pn * tstepB;
    PG8_STAGE(PG8_SB(0, 0), cB, voffB); PG8_STAGE(PG8_SB(0, 1), cB + hstepB, voffB); PG8_STAGE(PG8_SA(0, 0), cA, voffA); PG8_STAGE(PG8_SA(0, 1), cA + hstepA, voffA);
    if (wr == 1) PG8_BAR;
    PG8_WAIT_V(2); PG8_BAR;
    PG8_STAGE(PG8_SB(1, 0), cB + kstep, voffB); PG8_STAGE(PG8_SA(1, 0), cA + kstep, voffA); PG8_STAGE(PG8_SB(1, 1), cB + hstepB + kstep, voffB);
    PG8_WAIT_V(6); PG8_BAR;
    for (;;) {
        const bool has_next = S.next(ui + 1, nxt);
        const char* nA = has_next ? (const char*)(g.A + (size_t)nxt.g * g.gsA) + (size_t)nxt.pm * tstepA : cA;
        const char* nB = has_next ? (const char*)(g.Bt + (size_t)nxt.g * g.gsB) + (size_t)nxt.pn * tstepB : cB;
        for (int t = 0; t < nt; t += 2) {
            const bool last = (t == nt - 2);
            const char* a1 = cA + (size_t)(t + 1) * kstep;
            const char* a2 = last ? nA : cA + (size_t)(t + 2) * kstep; const char* b2 = last ? nB : cB + (size_t)(t + 2) * kstep;
            const char* a3 = a2 + kstep; const char* b3 = b2 + kstep;
            PG8_LDB(B0, 0, 0); PG8_LDB(B1, 0, 1); PG8_SCHED; PG8_LDA(At, 0, 0); PG8_STAGE(PG8_SA(1, 1), a1 + hstepA, voffA);
            PG8_WAIT_V(8); PG8_WAIT_L(0); PG8_BAR; PG8_MMA(0, 0, At, B0); PG8_MMA(0, 1, At, B1); PG8_BAR; PG8_SCHED;
            PG8_LDA(At, 0, 1); PG8_STAGE(PG8_SB(0, 0), b2, voffB); PG8_STAGE(PG8_SB(0, 1), b2 + hstepB, voffB); PG8_STAGE(PG8_SA(0, 0), a2, voffA);
            PG8_WAIT_V(8); PG8_WAIT_L(0); PG8_BAR; PG8_MMA(1, 0, At, B0); PG8_MMA(1, 1, At, B1); PG8_BAR; PG8_SCHED;
            PG8_LDB(B0, 1, 0); PG8_LDB(B1, 1, 1); PG8_SCHED; PG8_LDA(At, 1, 0); PG8_STAGE(PG8_SA(0, 1), a2 + hstepA, voffA);
            PG8_WAIT_V(8); PG8_WAIT_L(0); PG8_BAR; PG8_MMA(0, 0, At, B0); PG8_MMA(0, 1, At, B1); PG8_BAR; PG8_SCHED;
            PG8_LDA(At, 1, 1); PG8_STAGE(PG8_SB(1, 0), b3, voffB); PG8_STAGE(PG8_SB(1, 1), b3 + hstepB, voffB); PG8_STAGE(PG8_SA(1, 0), a3, voffA);
            PG8_WAIT_V(8); PG8_WAIT_L(0); PG8_BAR; PG8_MMA(1, 0, At, B0); PG8_MMA(1, 1, At, B1); PG8_BAR; PG8_SCHED;
        }
        if (wr == 0) PG8_BAR;
        E(acc, cur, wr, wc, fr, fq);
        if (!has_next) break;
#pragma unroll
        for (int a = 0; a < 2; ++a)
#pragma unroll
            for (int b = 0; b < 2; ++b)
#pragma unroll
                for (int m = 0; m < 4; ++m)
#pragma unroll
                    for (int n = 0; n < 2; ++n) acc[a][b][m][n] = (f32x4){0.f, 0.f, 0.f, 0.f};
        cur = nxt; cA = nA; cB = nB; ++ui;
        if (wr == 1) PG8_BAR;
    }
    PG8_WAIT_V(0);
    PG8_BAR;
#undef PG8_SA
#undef PG8_SB
#undef PG8_STAGE
#undef PG8_LDA
#undef PG8_LDB
#undef PG8_MMA
#undef PG8_WAIT_V
#undef PG8_WAIT_L
#undef PG8_BAR
#undef PG8_SCHED
}
}

constexpr int D = 1024, SEQ = 8192, ML = 16384, CTXL = 256, MC = 512, MALL = ML + MC, FF = 2816, NMODW = 9 * 1024;
constexpr int TCH = 32, KS5 = 768, ROWS5 = 512;
constexpr float EPS = 1e-6f;
constexpr size_t MiB = 1u << 20;
constexpr size_t WS_MOD = 128 * 1024, WS_HCTX = 512 * 1024;
constexpr size_t WS_WIN = 1 * MiB, WS_WMIX = 3 * MiB, WS_WGLU = 5 * MiB, WS_BB = 5 * MiB + 512 * 1024, WS_KTAB = 6 * MiB, WS_PW = 8 * MiB;
constexpr size_t WS_W13A = 10 * MiB, WS_W2A = 21 * MiB, WS_W13B = 27 * MiB, WS_W2B = 38 * MiB, WS_WST = 44 * MiB, WS_BS5 = 52 * MiB;
constexpr size_t WS_HN = 76 * MiB, WS_MIX = 109 * MiB, WS_X1C = 141 * MiB, WS_UCTX = 143 * MiB, WS_UB = 144 * MiB;
constexpr size_t WS_POOL = 144 * MiB, WS_AS5 = 160 * MiB, WS_S = 184 * MiB, WS_Y = 200 * MiB, WS_END = 236 * MiB;
constexpr int LDS_BYTES = 147456;

struct KArgs { const float* in[24]; float* out; unsigned char* ws; };

struct EpiUp {
    static constexpr bool PERM = true;
    bf16_t* O;
    __device__ __forceinline__ void operator()(const f32x4 (&acc)[2][2][4][2], const pg8::Unit& u, int wr, int wc, int fr, int fq) const {
        const int row0 = u.pm * 256 + wr * 64 + fr, f0 = u.pn * 128 + wc * 16 + 4 * fq;
#pragma unroll
        for (int ai = 0; ai < 2; ++ai)
#pragma unroll
            for (int m = 0; m < 4; ++m) { bf16_t* rowp = O + (size_t)(row0 + ai * 128 + m * 16) * FF + f0;
#pragma unroll
                for (int bj = 0; bj < 2; ++bj) { const f32x4 a = acc[ai][bj][m][0], b = acc[ai][bj][m][1];
                    u32x2 w; w.x = cvt_pk_bf16(silu_fast(a[0]) * b[0], silu_fast(a[1]) * b[1]); w.y = cvt_pk_bf16(silu_fast(a[2]) * b[2], silu_fast(a[3]) * b[3]);
                    *(u32x2*)(rowp + bj * 64) = w; } }
    }
};
struct EpiRes {
    static constexpr bool PERM = false;
    const float* resid_l; const float* resid_c; float* out_l; float* out_c; const float* gate; float coef;
    __device__ __forceinline__ void operator()(const f32x4 (&acc)[2][2][4][2], const pg8::Unit& u, int wr, int wc, int fr, int fq) const {
        const int set = u.pm < 32 ? 0 : (u.pm < 64 ? 1 : 2);
        const bool isc = u.pm >= 64;
        const float* rb = isc ? resid_c - (size_t)ML * D : resid_l; float* ob = isc ? out_c - (size_t)ML * D : out_l;
        const int row0 = u.pm * 256 + wr * 64 + fr, col0 = u.pn * 256 + wc * 32 + 4 * fq;
        f32x4 gv[2][2];
#pragma unroll
        for (int bj = 0; bj < 2; ++bj)
#pragma unroll
            for (int n = 0; n < 2; ++n) gv[bj][n] = *(const f32x4*)(gate + set * NMODW + col0 + bj * 128 + n * 16) * coef;
#pragma unroll
        for (int ai = 0; ai < 2; ++ai)
#pragma unroll
            for (int m = 0; m < 4; ++m) { const size_t off = (size_t)(row0 + ai * 128 + m * 16) * D + col0;
#pragma unroll
                for (int bj = 0; bj < 2; ++bj)
#pragma unroll
                    for (int n = 0; n < 2; ++n) { const f32x4 r = *(const f32x4*)(rb + off + bj * 128 + n * 16); *(f32x4*)(ob + off + bj * 128 + n * 16) = r + gv[bj][n] * acc[ai][bj][m][n]; }
                asm volatile("" ::: "memory"); }
    }
};
struct EpiWin {
    static constexpr bool PERM = true;
    bf16_t* pool; bf16_t* As5; float* Uctx;
    __device__ __forceinline__ void operator()(const f32x4 (&acc)[2][2][4][2], const pg8::Unit& u, int wr, int wc, int fr, int fq) const {
        const int row0 = u.pm * 256 + wr * 64 + fr;
        const bool isc = u.pm >= 64, ispool = u.pn < 2;
        if (isc && ispool) return;
#pragma unroll
        for (int ai = 0; ai < 2; ++ai)
#pragma unroll
            for (int m = 0; m < 4; ++m) { const int row = row0 + ai * 128 + m * 16;
#pragma unroll
                for (int bj = 0; bj < 2; ++bj) { const int col0 = u.pn * 256 + bj * 128 + wc * 32 + 8 * fq; const f32x4 v0 = acc[ai][bj][m][0], v1 = acc[ai][bj][m][1];
                    if (isc) { float* p = Uctx + (size_t)(row - ML) * 512 + (col0 - 512); *(f32x4*)p = v0; *(f32x4*)(p + 4) = v1; }
                    else { u32x4 w; w.x = cvt_pk_bf16(v0[0], v0[1]); w.y = cvt_pk_bf16(v0[2], v0[3]); w.z = cvt_pk_bf16(v1[0], v1[1]); w.w = cvt_pk_bf16(v1[2], v1[3]);
                        const int b = row >> 13, tok = row & 8191;
                        if (ispool) { const int k = col0 >> 7, slab = (col0 >> 3) & 15; *(u32x4*)(pool + ((size_t)((b * 4 + k) * 16 + slab) * 8192 + tok) * 8) = w; }
                        else { const int cs = col0 - 512, gg = cs >> 4, c0 = cs & 15; *(u32x4*)(As5 + ((size_t)gg * ROWS5 + b * 256 + (tok >> 5)) * KS5 + (tok & 31) * 16 + c0) = w; } } } }
    }
};
struct EpiState {
    static constexpr bool PERM = false;
    float* S;
    __device__ __forceinline__ void operator()(const f32x4 (&acc)[2][2][4][2], const pg8::Unit& u, int wr, int wc, int fr, int fq) const {
        const int row0 = u.pm * 256 + wr * 64 + fr, col0 = wc * 32 + 4 * fq;
#pragma unroll
        for (int ai = 0; ai < 2; ++ai)
#pragma unroll
            for (int m = 0; m < 4; ++m) { float* rowp = S + ((size_t)u.g * ROWS5 + row0 + ai * 128 + m * 16) * 256 + col0;
#pragma unroll
                for (int bj = 0; bj < 2; ++bj)
#pragma unroll
                    for (int n = 0; n < 2; ++n) *(f32x4*)(rowp + bj * 128 + n * 16) = acc[ai][bj][m][n]; }
    }
};
struct EpiS5 {
    static constexpr bool PERM = true;
    bf16_t* Y;
    __device__ __forceinline__ void operator()(const f32x4 (&acc)[2][2][4][2], const pg8::Unit& u, int wr, int wc, int fr, int fq) const {
        const int row0 = u.pm * 256 + wr * 64 + fr;
#pragma unroll
        for (int ai = 0; ai < 2; ++ai)
#pragma unroll
            for (int m = 0; m < 4; ++m) { const int row = row0 + ai * 128 + m * 16, b = row >> 8, chunk = row & 255;
#pragma unroll
                for (int bj = 0; bj < 2; ++bj) { const int n0 = u.pn * 256 + bj * 128 + wc * 32 + 8 * fq, t = n0 >> 4, c0 = n0 & 15; const f32x4 v0 = acc[ai][bj][m][0], v1 = acc[ai][bj][m][1];
                    u32x4 w; w.x = cvt_pk_bf16(gelu_tanh(v0[0]), gelu_tanh(v0[1])); w.y = cvt_pk_bf16(gelu_tanh(v0[2]), gelu_tanh(v0[3]));
                    w.z = cvt_pk_bf16(gelu_tanh(v1[0]), gelu_tanh(v1[1])); w.w = cvt_pk_bf16(gelu_tanh(v1[2]), gelu_tanh(v1[3]));
                    *(u32x4*)(Y + (size_t)(b * SEQ + chunk * TCH + t) * 512 + u.g * 16 + c0) = w; } }
    }
};
struct EpiGlu {
    static constexpr bool PERM = true;
    const bf16_t* Y; bf16_t* mix;
    __device__ __forceinline__ void operator()(const f32x4 (&acc)[2][2][4][2], const pg8::Unit& u, int wr, int wc, int fr, int fq) const {
        const int row0 = u.pm * 256 + wr * 64 + fr;
#pragma unroll
        for (int ai = 0; ai < 2; ++ai)
#pragma unroll
            for (int m = 0; m < 4; ++m) { const int row = row0 + ai * 128 + m * 16;
#pragma unroll
                for (int bj = 0; bj < 2; ++bj) { const int col0 = u.pn * 256 + bj * 128 + wc * 32 + 8 * fq; const f32x4 v0 = acc[ai][bj][m][0], v1 = acc[ai][bj][m][1];
                    const u32x4 y = *(const u32x4*)(Y + (size_t)row * 512 + col0); u32x4 w;
                    w.x = cvt_pk_bf16(bf_lo(y.x) * sigmoid_fast(v0[0]), bf_hi(y.x) * sigmoid_fast(v0[1])); w.y = cvt_pk_bf16(bf_lo(y.y) * sigmoid_fast(v0[2]), bf_hi(y.y) * sigmoid_fast(v0[3]));
                    w.z = cvt_pk_bf16(bf_lo(y.z) * sigmoid_fast(v1[0]), bf_hi(y.z) * sigmoid_fast(v1[1])); w.w = cvt_pk_bf16(bf_lo(y.w) * sigmoid_fast(v1[2]), bf_hi(y.w) * sigmoid_fast(v1[3]));
                    *(u32x4*)(mix + (size_t)row * D + 512 + col0) = w; } }
    }
};

__device__ __forceinline__ float wave_sum(float v) {
#pragma unroll
    for (int o = 1; o < 64; o <<= 1) v += __shfl_xor(v, o);
    return v;
}
__device__ __forceinline__ void transpose_item(const float* W, int ldw, bf16_t* WT, int ldd, int mode, LAS float* scr, int kb, int nb, int lane) {
    const int k0 = 64 * kb, n0 = 32 * nb;
#pragma unroll 8
    for (int i = 0; i < 32; ++i) { const int kk = 2 * i + (lane >> 5); scr[kk * 33 + (lane & 31)] = W[(size_t)(k0 + kk) * ldw + n0 + (lane & 31)]; }
    asm volatile("s_waitcnt lgkmcnt(0)" ::: "memory");
    const int c = lane & 7;
#pragma unroll
    for (int j = 0; j < 4; ++j) { const int n = (lane >> 3) + 8 * j, ncol = n0 + n; const LAS float* s = scr + (8 * c) * 33 + n;
        const int row = mode == 0 ? ncol : (8 * (ncol >> 2) + (ncol & 3) + (mode == 2 ? 4 : 0));
        u32x4 o; o.x = cvt_pk_bf16(s[0 * 33], s[1 * 33]); o.y = cvt_pk_bf16(s[2 * 33], s[3 * 33]); o.z = cvt_pk_bf16(s[4 * 33], s[5 * 33]); o.w = cvt_pk_bf16(s[6 * 33], s[7 * 33]);
        *(u32x4*)(WT + (size_t)row * ldd + k0 + 8 * c) = o; }
    asm volatile("s_waitcnt lgkmcnt(0)" ::: "memory");
}
__device__ __forceinline__ void norm_mod_row(const float* xrow, const float* g, const float* shift, const float* scale, bf16_t* orow, int lane) {
    const f32x4* xr = (const f32x4*)xrow + lane; f32x4 v[4]; float s = 0.f;
#pragma unroll
    for (int j = 0; j < 4; ++j) { v[j] = xr[64 * j]; s += (v[j].x * v[j].x + v[j].y * v[j].y) + (v[j].z * v[j].z + v[j].w * v[j].w); }
    const float r = 1.0f / sqrtf(wave_sum(s) * (1.f / D) + EPS);
    u32x2* o8 = (u32x2*)orow + lane;
#pragma unroll
    for (int j = 0; j < 4; ++j) { const f32x4 gg = ((const f32x4*)g)[lane + 64 * j], sh = ((const f32x4*)shift)[lane + 64 * j], sc = ((const f32x4*)scale)[lane + 64 * j];
        const f32x4 y = (v[j] * r) * gg; const f32x4 h = y * (sc + 1.0f) + sh; u32x2 w; w.x = cvt_pk_bf16(h.x, h.y); w.y = cvt_pk_bf16(h.z, h.w); o8[64 * j] = w; }
}

#ifndef PHMASK
#define PHMASK 0xFFFFF
#endif
#define PH(k) if constexpr (((PHMASK) >> (k)) & 1)
__global__ void __launch_bounds__(512, 2) fwd_megakernel(KArgs a) {
    extern __shared__ __attribute__((aligned(16))) unsigned char lds_raw[];
    LAS unsigned char* lds = (LAS unsigned char*)lds_raw;
    cg::grid_group grid = cg::this_grid();
    const int tid = threadIdx.x, lane = tid & 63, wave = __builtin_amdgcn_readfirstlane(tid >> 6);
    const int G = gridDim.x, bid = blockIdx.x;
    const int gw = bid * 8 + wave, NGW = G * 8;
#define ws (a.ws)
#define xin_ (a.in[0])
#define cvec (a.in[1])
#define ctx (a.in[2])
#define cctx (a.in[3])
#define norm_g (a.in[4])
#define w_ada (a.in[5])
#define b_ada (a.in[6])
#define mod ((float*)(ws + WS_MOD))
#define Hctx ((f32x2*)(ws + WS_HCTX))
#define Win_t ((bf16_t*)(ws + WS_WIN))
#define Wmix_t ((bf16_t*)(ws + WS_WMIX))
#define Wglu_t ((bf16_t*)(ws + WS_WGLU))
#define BB ((f32x2*)(ws + WS_BB))
#define Ktab ((float*)(ws + WS_KTAB))
#define PW ((f32x2*)(ws + WS_PW))
#define W13a ((bf16_t*)(ws + WS_W13A))
#define W2a ((bf16_t*)(ws + WS_W2A))
#define W13b ((bf16_t*)(ws + WS_W13B))
#define W2b ((bf16_t*)(ws + WS_W2B))
#define Wst ((bf16_t*)(ws + WS_WST))
#define Bs5 ((bf16_t*)(ws + WS_BS5))
#define Hn ((bf16_t*)(ws + WS_HN))
#define mixcat ((bf16_t*)(ws + WS_MIX))
#define X1c ((float*)(ws + WS_X1C))
#define Uctx ((float*)(ws + WS_UCTX))
#define Ubuf ((bf16_t*)(ws + WS_UB))
#define poolb ((bf16_t*)(ws + WS_POOL))
#define As5 ((bf16_t*)(ws + WS_AS5))
#define Sbuf ((float*)(ws + WS_S))
#define Ybuf ((bf16_t*)(ws + WS_Y))
#define out (a.out)

    PH(0) {
        LAS float* sc = (LAS float*)lds;
        LAS float* red = (LAS float*)(lds + 16384);
        for (int i = tid; i < 3072; i += 512) { const float v = i < 2048 ? cvec[i] : cctx[i - 2048]; sc[i] = v / (1.f + expf(-v)); }
        __syncthreads();
        for (int strip = bid; strip < 288; strip += G) {
            const int cg4 = tid & 7, kk = tid >> 3;
            f32x4 a0 = {0.f, 0.f, 0.f, 0.f}, a1 = a0, a2 = a0;
#pragma unroll 4
            for (int it = 0; it < 16; ++it) { const int k = kk + 64 * it; const f32x4 w = *(const f32x4*)(w_ada + (size_t)k * NMODW + strip * 32 + cg4 * 4);
                a0 += w * sc[k]; a1 += w * sc[1024 + k]; a2 += w * sc[2048 + k]; }
#pragma unroll
            for (int i = 0; i < 4; ++i) { red[kk * 100 + cg4 * 4 + i] = a0[i]; red[kk * 100 + 32 + cg4 * 4 + i] = a1[i]; red[kk * 100 + 64 + cg4 * 4 + i] = a2[i]; }
            __syncthreads();
            if (tid < 96) { float s = 0.f;
#pragma unroll 8
                for (int k2 = 0; k2 < 64; ++k2) s += red[k2 * 100 + tid]; const int r = tid >> 5, col = strip * 32 + (tid & 31); mod[r * NMODW + col] = s + b_ada[col]; }
            __syncthreads();
        }
        LAS f32x2* pwL = (LAS f32x2*)(lds + 65536);
        LAS f32x2* bbL = (LAS f32x2*)(lds + 65536 + 17408);
        LAS f32x2* cL = (LAS f32x2*)(lds + 65536 + 17408 + 8192);
        const float* a_re = a.in[13]; const float* a_im = a.in[14]; const float* log_dt = a.in[15]; const float* b_re = a.in[16]; const float* b_im = a.in[17];
        const float* c_re = a.in[18]; const float* c_im = a.in[19];
#pragma unroll 1
        for (int it = G - 1 - bid; it < 64; it += G) {
            const int g = it >> 1, dir = it & 1, pd = dir * 32 + g;
            const float dt = expf(log_dt[pd]);
            for (int idx = tid; idx < 33 * 64; idx += 512) { const int tau = idx >> 6, p = idx & 63; const float are = a_re[pd * 64 + p], aim = a_im[pd * 64 + p];
                const float mag = expf(are * dt * (float)tau); double ang = (double)aim * (double)dt * (double)tau; ang -= 6.283185307179586 * rint(ang * 0.15915494309189535);
                float sn, cs; sincosf((float)ang, &sn, &cs); const f32x2 v = {mag * cs, mag * sn}; pwL[idx] = v; PW[(size_t)it * 33 * 64 + idx] = v; }
            for (int idx = tid; idx < 1024; idx += 512) { const f32x2 v = {c_re[(size_t)pd * 1024 + idx], c_im[(size_t)pd * 1024 + idx]}; cL[idx] = v; }
            __syncthreads();
            for (int idx = tid; idx < 1024; idx += 512) { const int p = idx >> 4; const float are = a_re[pd * 64 + p], aim = a_im[pd * 64 + p]; const float zr = are * dt, zi = aim * dt;
                float qr, qi;
                if (zr * zr + zi * zi < 0.25f) { float tr = 1.f, ti = 0.f;
                    for (int k = 12; k >= 2; --k) { const float ik = 1.0f / (float)k, wr_ = zr * ik, wi_ = zi * ik; const float nr = 1.f + (wr_ * tr - wi_ * ti), ni = wr_ * ti + wi_ * tr; tr = nr; ti = ni; }
                    qr = dt * tr; qi = dt * ti; }
                else { const f32x2 ab = pwL[64 + p]; const float nr = ab.x - 1.f, ni = ab.y, den = are * are + aim * aim; qr = (nr * are + ni * aim) / den; qi = (ni * are - nr * aim) / den; }
                const float br = b_re[(size_t)g * 1024 + idx], bi = b_im[(size_t)g * 1024 + idx];
                const f32x2 v = {qr * br - qi * bi, qr * bi + qi * br}; bbL[idx] = v; BB[(size_t)it * 1024 + idx] = v; }
            __syncthreads();
#pragma unroll 1
            for (int j = 0; j < 16; ++j) { const int idx = tid + 512 * j, tau = idx >> 8, c = (idx >> 4) & 15, cc = idx & 15; float s = 0.f;
#pragma unroll 8
                for (int p = 0; p < 64; ++p) { const f32x2 C = cL[c * 64 + p], w = pwL[tau * 64 + p], b = bbL[p * 16 + cc]; const float zr = C.x * w.x - C.y * w.y, zi = C.x * w.y + C.y * w.x; s += zr * b.x - zi * b.y; }
                Ktab[(size_t)it * 8192 + idx] = s; }
            __syncthreads();
        }
    }
    grid.sync();

    PH(1) {
        LAS float* scr = (LAS float*)(lds + wave * 16384);
        constexpr int I_UP = 16 * 88, I_DN = 44 * 32, I_IN = 16 * 32, I_OUT = 8 * 32, I_GLU = 8 * 16;
        constexpr int NITEMS = 4 * I_UP + 2 * I_DN + I_IN + I_OUT + I_GLU;
        for (int it = gw; it < NITEMS; it += NGW) {
            int r = it;
            if (r < I_UP) { transpose_item(a.in[7], FF, W13a, D, 1, scr, r / 88, r % 88, lane); continue; } r -= I_UP;
            if (r < I_UP) { transpose_item(a.in[8], FF, W13a, D, 2, scr, r / 88, r % 88, lane); continue; } r -= I_UP;
            if (r < I_DN) { transpose_item(a.in[9], D, W2a, FF, 0, scr, r / 32, r % 32, lane); continue; } r -= I_DN;
            if (r < I_UP) { transpose_item(a.in[7] + (size_t)D * FF, FF, W13b, D, 1, scr, r / 88, r % 88, lane); continue; } r -= I_UP;
            if (r < I_UP) { transpose_item(a.in[8] + (size_t)D * FF, FF, W13b, D, 2, scr, r / 88, r % 88, lane); continue; } r -= I_UP;
            if (r < I_DN) { transpose_item(a.in[9] + (size_t)D * FF, D, W2b, FF, 0, scr, r / 32, r % 32, lane); continue; } r -= I_DN;
            if (r < I_IN) { transpose_item(a.in[10], D, Win_t, D, 0, scr, r / 32, r % 32, lane); continue; } r -= I_IN;
            if (r < I_OUT) { transpose_item(a.in[22] + (size_t)512 * D, D, Wmix_t + 512, D, 0, scr, r / 32, r % 32, lane); continue; } r -= I_OUT;
            transpose_item(a.in[21], 512, Wglu_t, 512, 0, scr, r / 16, r % 16, lane);
        }
        {
            const float* pool_w = a.in[11]; const float* pool_scale = a.in[12]; const float* w_out = a.in[22];
            for (int it = G - 1 - bid; it < 64; it += G) { const int k = it >> 4, cb = it & 15;
                f32x2 ac[8];
#pragma unroll
                for (int i = 0; i < 8; ++i) ac[i] = (f32x2){0.f, 0.f};
                for (int d = 0; d < 128; ++d) { const f32x2 wo = *(const f32x2*)(w_out + (size_t)(k * 128 + d) * D + 2 * tid) * pool_scale[k * 128 + d];
#pragma unroll
                    for (int i = 0; i < 8; ++i) ac[i] += wo * pool_w[(size_t)(k * 128 + cb * 8 + i) * 128 + d]; }
                u32x4 w0, w1; w0.x = cvt_pk_bf16(ac[0].x, ac[1].x); w0.y = cvt_pk_bf16(ac[2].x, ac[3].x); w0.z = cvt_pk_bf16(ac[4].x, ac[5].x); w0.w = cvt_pk_bf16(ac[6].x, ac[7].x);
                w1.x = cvt_pk_bf16(ac[0].y, ac[1].y); w1.y = cvt_pk_bf16(ac[2].y, ac[3].y); w1.z = cvt_pk_bf16(ac[4].y, ac[5].y); w1.w = cvt_pk_bf16(ac[6].y, ac[7].y);
                *(u32x4*)(Wmix_t + (size_t)(2 * tid) * D + k * 128 + cb * 8) = w0; *(u32x4*)(Wmix_t + (size_t)(2 * tid + 1) * D + k * 128 + cb * 8) = w1; }
        }
        {
            const float* c_re = a.in[18]; const float* c_im = a.in[19]; const float* dskip = a.in[20];
            const int gt = bid * 512 + tid, NT = G * 512;
            for (int e = gt; e < 32 * 512 * 96; e += NT) { const int k8 = e % 96, n = (e / 96) & 511, g = e / (96 * 512), t = n >> 4, c = n & 15; float v[8];
                if (k8 < 64) { const int s = k8 >> 1, c0 = (k8 & 1) * 8;
#pragma unroll
                    for (int i = 0; i < 8; ++i) v[i] = 0.f;
                    if (s <= t) { const float* kp = Ktab + ((size_t)((g * 2 + 0) * 32 + (t - s)) * 256 + c * 16 + c0); const f32x4 k0 = *(const f32x4*)kp, k1 = *(const f32x4*)(kp + 4);
                        v[0] += k0.x; v[1] += k0.y; v[2] += k0.z; v[3] += k0.w; v[4] += k1.x; v[5] += k1.y; v[6] += k1.z; v[7] += k1.w; }
                    if (s >= t) { const float* kp = Ktab + ((size_t)((g * 2 + 1) * 32 + (s - t)) * 256 + c * 16 + c0); const f32x4 k0 = *(const f32x4*)kp, k1 = *(const f32x4*)(kp + 4);
                        v[0] += k0.x; v[1] += k0.y; v[2] += k0.z; v[3] += k0.w; v[4] += k1.x; v[5] += k1.y; v[6] += k1.z; v[7] += k1.w; }
                    if (s == t) { const float dv = dskip[g * 16 + c];
#pragma unroll
                        for (int i = 0; i < 8; ++i) if (c0 + i == c) v[i] += dv; }
                } else { const int j = k8 - 64, part = j >> 3, p0 = (j & 7) * 8, dir = part >> 1, ex = dir == 0 ? t + 1 : 32 - t;
#pragma unroll
                    for (int i = 0; i < 8; ++i) { const int p = p0 + i; const size_t ci = ((size_t)(dir * 32 + g) * 16 + c) * 64 + p; const float cr = c_re[ci], cim = c_im[ci]; const f32x2 w = PW[((size_t)(g * 2 + dir) * 33 + ex) * 64 + p];
                        const float zr = cr * w.x - cim * w.y, zi = cr * w.y + cim * w.x; v[i] = (part & 1) ? -zi : zr; } }
                u32x4 o; o.x = cvt_pk_bf16(v[0], v[1]); o.y = cvt_pk_bf16(v[2], v[3]); o.z = cvt_pk_bf16(v[4], v[5]); o.w = cvt_pk_bf16(v[6], v[7]);
                *(u32x4*)(Bs5 + ((size_t)g * 512 + n) * KS5 + k8 * 8) = o; }
            for (int e = gt; e < 32 * 256 * 64; e += NT) { const int k8 = e & 63, n = (e >> 6) & 255, g = e >> 14, dir = n >> 7, reim = (n >> 6) & 1, p = n & 63, s = k8 >> 1, c0 = (k8 & 1) * 8, ex = dir == 0 ? 31 - s : s;
                const f32x2 w = PW[((size_t)(g * 2 + dir) * 33 + ex) * 64 + p]; float v[8];
#pragma unroll
                for (int i = 0; i < 8; ++i) { const f32x2 b = BB[((size_t)(g * 2 + dir) * 64 + p) * 16 + c0 + i]; v[i] = reim ? (w.x * b.y + w.y * b.x) : (w.x * b.x - w.y * b.y); }
                u32x4 o; o.x = cvt_pk_bf16(v[0], v[1]); o.y = cvt_pk_bf16(v[2], v[3]); o.z = cvt_pk_bf16(v[4], v[5]); o.w = cvt_pk_bf16(v[6], v[7]);
                *(u32x4*)(Wst + ((size_t)g * 256 + n) * 512 + k8 * 8) = o; }
        }
        for (int m = gw; m < MALL; m += NGW) { const int set = m < SEQ ? 0 : (m < ML ? 1 : 2); const float* src = m < ML ? xin_ + (size_t)m * D : ctx + (size_t)(m - ML) * D;
            norm_mod_row(src, norm_g, mod + set * NMODW + 0 * 1024, mod + set * NMODW + 1 * 1024, Hn + (size_t)m * D, lane); }
    }
    grid.sync();

    PH(2) { pg8::Gemm g{Hn, W13a, D, D, D, 0, 0}; pg8::StaticOrder S; S.init(MALL, 2 * FF, G, bid); EpiUp E{Ubuf}; pg8::gemm_phase(lds, g, S, E); }
    grid.sync();
    PH(3) { pg8::Gemm g{Ubuf, W2a, FF, FF, FF, 0, 0}; pg8::StaticOrder S; S.init(MALL, D, G, bid); EpiRes E{xin_, ctx, out, X1c, mod + 2 * 1024, 0.5f}; pg8::gemm_phase(lds, g, S, E); }
    grid.sync();
    PH(4) for (int m = gw; m < MALL; m += NGW) { const int set = m < SEQ ? 0 : (m < ML ? 1 : 2); const float* src = m < ML ? out + (size_t)m * D : X1c + (size_t)(m - ML) * D;
        norm_mod_row(src, norm_g + 1024, mod + set * NMODW + 3 * 1024, mod + set * NMODW + 4 * 1024, Hn + (size_t)m * D, lane); }
    grid.sync();
    PH(5) { pg8::Gemm g{Hn, Win_t, D, D, D, 0, 0}; pg8::StaticOrder S; S.init(MALL, D, G, bid); EpiWin E{poolb, As5, Uctx}; pg8::gemm_phase(lds, g, S, E); }
    grid.sync();
    PH(6) {
        const int Gg = G < 64 ? G : 64;
        { pg8::Gemm g{As5, Wst, KS5, 512, 512, (size_t)ROWS5 * KS5, (size_t)256 * 512}; pg8::GroupOrder S; S.init(2, 1, 32, Gg, bid); EpiState E{Sbuf}; pg8::gemm_phase(lds, g, S, E); }
        const int r1 = (bid + G - Gg % G) % G;
        for (int it = r1; it < 16; it += G) { const int wi = it * 8 + wave, b = wi >> 6, g = (wi >> 1) & 31, dir = wi & 1;
            const f32x2 av = PW[((size_t)(g * 2 + dir) * 33 + 1) * 64 + lane]; f32x2 bb[16];
#pragma unroll
            for (int i = 0; i < 16; ++i) bb[i] = BB[((size_t)(g * 2 + dir) * 64 + lane) * 16 + i];
            float hr = 0.f, hi = 0.f;
#pragma unroll 4
            for (int step = 0; step < CTXL; ++step) { const int t = dir == 0 ? step : CTXL - 1 - step; const f32x4* up = (const f32x4*)(Uctx + (size_t)(b * CTXL + t) * 512 + g * 16);
                const f32x4 u0 = up[0], u1 = up[1], u2 = up[2], u3 = up[3]; float sr = 0.f, si = 0.f;
#pragma unroll
                for (int i = 0; i < 4; ++i) { sr += bb[i].x * u0[i]; si += bb[i].y * u0[i]; }
#pragma unroll
                for (int i = 0; i < 4; ++i) { sr += bb[4 + i].x * u1[i]; si += bb[4 + i].y * u1[i]; }
#pragma unroll
                for (int i = 0; i < 4; ++i) { sr += bb[8 + i].x * u2[i]; si += bb[8 + i].y * u2[i]; }
#pragma unroll
                for (int i = 0; i < 4; ++i) { sr += bb[12 + i].x * u3[i]; si += bb[12 + i].y * u3[i]; }
                const float nr = av.x * hr - av.y * hi + sr, ni = av.x * hi + av.y * hr + si; hr = nr; hi = ni; }
            Hctx[(size_t)wi * 64 + lane] = (f32x2){hr, hi}; }
        const int r2 = (bid + 2 * G - (Gg + 16) % G) % G;
        LAS bf16_t* raw = (LAS bf16_t*)lds;
        LAS float* rowb = (LAS float*)(lds + 131072);
        for (int it = r2; it < 128; it += G) { const int b = it >> 6, k = (it >> 4) & 3, slab = it & 15;
            __syncthreads();
            const bf16_t* src = poolb + (size_t)it * 8192 * 8;
#pragma unroll 4
            for (int i = 0; i < 16; ++i) { const int tok = i * 512 + tid; *(LAS u32x4*)(raw + tok * 8) = *(const u32x4*)(src + (size_t)tok * 8); }
            __syncthreads();
            const int c = tid >> 3, ch = tid & 7, w = 2 << k, lo = w >> 1, hi = w - 1 - lo;
            const int clo = c - lo < 0 ? 0 : c - lo, chi = c + hi > 63 ? 63 : c + hi; const float icc = 1.0f / (float)(chi - clo + 1);
            float vs = 0.f;
            for (int r = 0; r <= hi; ++r) vs += bf2f(raw[(r * 64 + c) * 8 + ch]);
            for (int r = 0; r < 128; ++r) {
                const int rlo = r - lo < 0 ? 0 : r - lo, rhi = r + hi > 127 ? 127 : r + hi;
                LAS float* rb = rowb + (r & 1) * 512;
                rb[c * 8 + ch] = vs / (float)(rhi - rlo + 1);
                __syncthreads();
                float hs = 0.f;
                for (int c2 = clo; c2 <= chi; ++c2) hs += rb[c2 * 8 + ch];
                const float dval = hs * icc - bf2f(raw[(r * 64 + c) * 8 + ch]);
                const float d1 = __shfl_down(dval, 1); unsigned p01 = cvt_pk_bf16(dval, d1);
                const unsigned p23 = __shfl_down(p01, 2); const unsigned q0 = __shfl_down(p01, 4), q1 = __shfl_down(p23, 4);
                if (ch == 0) { u32x4 o; o.x = p01; o.y = p23; o.z = q0; o.w = q1; *(u32x4*)(mixcat + (size_t)(b * SEQ + r * 64 + c) * D + k * 128 + slab * 8) = o; }
                if (r + 1 + hi <= 127) vs += bf2f(raw[((r + 1 + hi) * 64 + c) * 8 + ch]);
                if (r - lo >= 0) vs -= bf2f(raw[((r - lo) * 64 + c) * 8 + ch]);
            }
        }
    }
    grid.sync();
    PH(7) for (int it = bid; it < 16; it += G) { const int wi = it * 8 + wave, b = wi >> 6, g = (wi >> 1) & 31, dir = wi & 1;
        const f32x2 a32 = PW[((size_t)(g * 2 + dir) * 33 + 32) * 64 + lane]; f32x2 h = Hctx[(size_t)wi * 64 + lane];
        const size_t rbase = (size_t)g * ROWS5 + b * 256;
        for (int s0 = 0; s0 < 256; s0 += 16) { float sre[16], sim[16];
#pragma unroll
            for (int i = 0; i < 16; ++i) { const int j = dir == 0 ? s0 + i : 255 - s0 - i; const float* sp = Sbuf + (rbase + j) * 256 + dir * 128 + lane; sre[i] = sp[0]; sim[i] = sp[64]; }
#pragma unroll
            for (int i = 0; i < 16; ++i) { const int j = dir == 0 ? s0 + i : 255 - s0 - i; bf16_t* hp = As5 + (rbase + j) * KS5 + 512 + dir * 128 + lane;
                hp[0] = (bf16_t)(cvt_pk_bf16(h.x, 0.f) & 0xffffu); hp[64] = (bf16_t)(cvt_pk_bf16(h.y, 0.f) & 0xffffu);
                const float nr = a32.x * h.x - a32.y * h.y + sre[i], ni = a32.x * h.y + a32.y * h.x + sim[i]; h.x = nr; h.y = ni; } }
    }
    grid.sync();
    PH(8) { pg8::Gemm g{As5, Bs5, KS5, KS5, KS5, (size_t)ROWS5 * KS5, (size_t)512 * KS5}; pg8::GroupOrder S; S.init(2, 2, 32, G, bid); EpiS5 E{Ybuf}; pg8::gemm_phase(lds, g, S, E); }
    grid.sync();
    PH(9) { pg8::Gemm g{Ybuf, Wglu_t, 512, 512, 512, 0, 0}; pg8::StaticOrder S; S.init(ML, 512, G, bid); EpiGlu E{Ybuf, mixcat}; pg8::gemm_phase(lds, g, S, E); }
    grid.sync();
    PH(10) { pg8::Gemm g{mixcat, Wmix_t, D, D, D, 0, 0}; pg8::StaticOrder S; S.init(ML, D, G, bid); EpiRes E{out, out, out, out, mod + 5 * 1024, 1.0f}; pg8::gemm_phase(lds, g, S, E); }
    grid.sync();
    PH(11) for (int m = gw; m < ML; m += NGW) { const int set = m < SEQ ? 0 : 1;
        norm_mod_row(out + (size_t)m * D, norm_g + 2048, mod + set * NMODW + 6 * 1024, mod + set * NMODW + 7 * 1024, Hn + (size_t)m * D, lane); }
    grid.sync();
    PH(12) { pg8::Gemm g{Hn, W13b, D, D, D, 0, 0}; pg8::StaticOrder S; S.init(ML, 2 * FF, G, bid); EpiUp E{Ubuf}; pg8::gemm_phase(lds, g, S, E); }
    grid.sync();
    PH(13) { pg8::Gemm g{Ubuf, W2b, FF, FF, FF, 0, 0}; pg8::StaticOrder S; S.init(ML, D, G, bid); EpiRes E{out, out, out, out, mod + 8 * 1024, 0.5f}; pg8::gemm_phase(lds, g, S, E); }
    grid.sync();
    PH(14) {
        const float* fg = a.in[23];
        for (int m = gw; m < ML; m += NGW) { f32x4* xr = (f32x4*)(out + (size_t)m * D) + lane; f32x4 v[4]; float s = 0.f;
#pragma unroll
            for (int j = 0; j < 4; ++j) { v[j] = xr[64 * j]; s += (v[j].x * v[j].x + v[j].y * v[j].y) + (v[j].z * v[j].z + v[j].w * v[j].w); }
            const float r = 1.0f / sqrtf(wave_sum(s) * (1.f / D) + EPS);
#pragma unroll
            for (int j = 0; j < 4; ++j) xr[64 * j] = (v[j] * r) * ((const f32x4*)fg)[lane + 64 * j]; }
    }
}

#undef ws
#undef xin_
#undef cvec
#undef ctx
#undef cctx
#undef norm_g
#undef w_ada
#undef b_ada
#undef mod
#undef Hctx
#undef Win_t
#undef Wmix_t
#undef Wglu_t
#undef BB
#undef Ktab
#undef PW
#undef W13a
#undef W2a
#undef W13b
#undef W2b
#undef Wst
#undef Bs5
#undef Hn
#undef mixcat
#undef X1c
#undef Uctx
#undef Ubuf
#undef poolb
#undef As5
#undef Sbuf
#undef Ybuf
#undef out
extern "C" void kernel_launch(void* const* d_in, const int* in_sizes, int n_in, void* d_out, int out_size, void* d_ws, size_t ws_size, hipStream_t stream) {
    static int grid = 0;
    if (grid == 0) {
        if (n_in != 24 || out_size != ML * D || ws_size < WS_END) { fprintf(stderr, "kernel_launch: unexpected shapes (n_in %d out %d ws %zu)\n", n_in, out_size, ws_size); grid = -1; return; }
        int dev = 0, cus = 0, per_cu = 0;
        hipGetDevice(&dev); hipDeviceGetAttribute(&cus, hipDeviceAttributeMultiprocessorCount, dev);
        hipFuncSetAttribute((const void*)fwd_megakernel, hipFuncAttributeMaxDynamicSharedMemorySize, LDS_BYTES);
        if (hipOccupancyMaxActiveBlocksPerMultiprocessor(&per_cu, (const void*)fwd_megakernel, 512, LDS_BYTES) != hipSuccess || per_cu < 1) per_cu = 1;
        (void)hipGetLastError();
        grid = cus * 1;
        if (grid <= 0) grid = 256;
    }
    if (grid < 0) return;
    KArgs a{};
    for (int i = 0; i < 24; ++i) a.in[i] = (const float*)d_in[i];
    a.out = (float*)d_out; a.ws = (unsigned char*)d_ws;
    void* args[] = {&a};
    hipError_t e = hipLaunchCooperativeKernel((const void*)fwd_megakernel, dim3(grid), dim3(512), args, LDS_BYTES, stream);
    if (e != hipSuccess) fprintf(stderr, "cooperative launch failed: %s (grid %d)\n", hipGetErrorString(e), grid);
}
```

```cpp
#include <hip/hip_runtime.h>
#include <hip/hip_cooperative_groups.h>
#include <cstdio>
#include <cstdint>
namespace cg = cooperative_groups;

#define LAS __attribute__((address_space(3)))
typedef unsigned short bf16_t;
typedef short bf16x8 __attribute__((ext_vector_type(8)));
typedef float f32x4 __attribute__((ext_vector_type(4)));
typedef float f32x2 __attribute__((ext_vector_type(2)));
typedef unsigned u32x4 __attribute__((ext_vector_type(4)));
typedef unsigned u32x2 __attribute__((ext_vector_type(2)));

__device__ __forceinline__ unsigned cvt_pk_bf16(float lo, float hi) { unsigned r; asm volatile("v_cvt_pk_bf16_f32 %0, %1, %2" : "=v"(r) : "v"(lo), "v"(hi)); return r; }
__device__ __forceinline__ float bf_lo(unsigned w) { return __builtin_bit_cast(float, w << 16); }
__device__ __forceinline__ float bf_hi(unsigned w) { return __builtin_bit_cast(float, w & 0xffff0000u); }
__device__ __forceinline__ float bf2f(bf16_t h) { return __builtin_bit_cast(float, ((unsigned)h) << 16); }
__device__ __forceinline__ float sigmoid_fast(float x) { return __builtin_amdgcn_rcpf(1.f + __expf(-x)); }
__device__ __forceinline__ float silu_fast(float x) { return x * sigmoid_fast(x); }
__device__ __forceinline__ float gelu_tanh(float x) { const float z = 1.5957691216057308f * (x + 0.044715f * x * x * x); return x * sigmoid_fast(z); }

namespace pg8 {
constexpr int BM = 256, BK = 64, HALF = 128, HTB = HALF * BK * 2, STAGE_BYTES = 8 * HTB, NXCD = 8, WGM = 8;
__host__ __device__ __forceinline__ int lds_byte(int r, int c) { const int st = (r >> 4) * 2 + (c >> 5), rr = r & 15, cc = c & 31, ob = rr * 64 + cc * 2; return st * 1024 + (ob ^ (((ob >> 9) & 1) << 5)); }
__host__ __device__ __forceinline__ void stage_rc(int b, int& R, int& C) { const int st = b / 1024, sb = b % 1024, swz = sb ^ (((sb >> 9) & 1) << 5); R = (st >> 1) * 16 + swz / 64; C = (st & 1) * 32 + (swz % 64) / 2; }
__host__ __device__ __forceinline__ int perm32(int rho) { const int n = rho >> 4, i = rho & 15; return 8 * (i >> 2) + 4 * n + (i & 3); }

struct Unit { int pm, pn, g; };
struct Gemm { const bf16_t* A; const bf16_t* Bt; int lda, ldb, K; size_t gsA, gsB; };

struct StaticOrder {
    int nM, nN, nwg, G, c;
    __device__ void init(int M, int N, int G_, int c_) { nM = M / BM; nN = N / BM; nwg = nM * nN; G = G_; c = c_; }
    __device__ bool next(int i, Unit& u) const {
        const long L = (long)i * G + c; if (L >= nwg) return false;
        int wgid = (int)L; { const int q = nwg / NXCD, r = nwg % NXCD, xcd = wgid % NXCD, off = wgid / NXCD; wgid = (xcd < r ? xcd * (q + 1) : r * (q + 1) + (xcd - r) * q) + off; }
        const int nig = WGM * nN, gid = wgid / nig, fm = gid * WGM, gsz = (nM - fm) < WGM ? (nM - fm) : WGM;
        u.pm = fm + ((wgid % nig) % gsz); u.pn = (wgid % nig) / gsz; u.g = 0; return true;
    }
};
struct GroupOrder {
    int nM, nN, ng, G, c;
    __device__ void init(int nM_, int nN_, int ng_, int G_, int c_) { nM = nM_; nN = nN_; ng = ng_; G = G_; c = c_; }
    __device__ bool next(int i, Unit& u) const {
        if (c >= G) return false;
        const long L = (long)i * G + c; if (L >= (long)ng * nM * nN) return false;
        const int per = nM * nN, l = (int)L; u.g = l / per; const int r = l % per; u.pm = r / nN; u.pn = r % nN; return true;
    }
};

template <class Epi, class Sched>
__device__ __forceinline__ void gemm_phase(LAS unsigned char* lds, const Gemm g, const Sched& S, const Epi& E) {
    int tid_ = threadIdx.x; asm volatile("" : "+v"(tid_));
    const int tid = tid_, wid = __builtin_amdgcn_readfirstlane(tid >> 6), lane = tid & 63, wr = wid >> 2, wc = wid & 3, fr = lane & 15, fq = lane >> 4;
    const int nt = g.K / BK;
    unsigned voffA[2], voffB[2];
#pragma unroll
    for (int i = 0; i < 2; ++i) { int R, C; stage_rc(tid * 16 + i * 8192, R, C); const int Rb = Epi::PERM ? ((R & ~31) + perm32(R & 31)) : R;
        voffA[i] = (unsigned)(R * g.lda + C) * 2u; voffB[i] = (unsigned)(Rb * g.ldb + C) * 2u; }
    const size_t kstep = (size_t)(BK * 2);
    const size_t hstepA = (size_t)HALF * g.lda * 2, hstepB = (size_t)HALF * g.ldb * 2;
    const size_t tstepA = 2 * hstepA, tstepB = 2 * hstepB;
    const unsigned ldsw = (unsigned)wid * 1024u;
    const int aoff = lds_byte(wr * 64 + fr, fq * 8), boff = lds_byte(wc * 32 + fr, fq * 8);
#define PG8_SA(b, h) (((b) * 2 + (h)) * HTB)
#define PG8_SB(b, h) ((4 + (b) * 2 + (h)) * HTB)
#define PG8_STAGE(bufoff, gbase, voff) do { _Pragma("unroll") for (int _i = 0; _i < 2; ++_i) \
        __builtin_amdgcn_global_load_lds((const unsigned*)((const char*)(gbase) + (voff)[_i]), (LAS unsigned*)(lds + (bufoff) + ldsw + _i * 8192), 16, 0, 0); } while (0)
#define PG8_LDA(dst, b, h) do { _Pragma("unroll") for (int m = 0; m < 4; ++m) _Pragma("unroll") for (int k = 0; k < 2; ++k) dst[m][k] = *(const LAS bf16x8*)(lds + PG8_SA(b, h) + aoff + m * 2048 + k * 1024); } while (0)
#define PG8_LDB(dst, b, h) do { _Pragma("unroll") for (int n = 0; n < 2; ++n) _Pragma("unroll") for (int k = 0; k < 2; ++k) dst[n][k] = *(const LAS bf16x8*)(lds + PG8_SB(b, h) + boff + n * 2048 + k * 1024); } while (0)
#define PG8_MMA(ai, bj, At, Bt) do { __builtin_amdgcn_s_setprio(1); _Pragma("unroll") for (int m = 0; m < 4; ++m) _Pragma("unroll") for (int n = 0; n < 2; ++n) _Pragma("unroll") for (int k = 0; k < 2; ++k) \
        acc[ai][bj][m][n] = __builtin_amdgcn_mfma_f32_16x16x32_bf16(Bt[n][k], At[m][k], acc[ai][bj][m][n], 0, 0, 0); __builtin_amdgcn_s_setprio(0); } while (0)
#define PG8_WAIT_V(n) asm volatile("s_waitcnt vmcnt(" #n ")" ::: "memory")
#define PG8_WAIT_L(n) asm volatile("s_waitcnt lgkmcnt(" #n ")" ::: "memory")
#define PG8_BAR __builtin_amdgcn_s_barrier()
#define PG8_SCHED __builtin_amdgcn_sched_barrier(0)
    Unit cur, nxt; int ui = 0;
    if (!S.next(0, cur)) return;
    f32x4 acc[2][2][4][2];
#pragma unroll
    for (int a = 0; a < 2; ++a)
#pragma unroll
        for (int b = 0; b < 2; ++b)
#pragma unroll
            for (int m = 0; m < 4; ++m)
#pragma unroll
                for (int n = 0; n < 2; ++n) acc[a][b][m][n] = (f32x4){0.f, 0.f, 0.f, 0.f};
    bf16x8 At[4][2], B0[2][2], B1[2][2];
    const char* cA = (const char*)(g.A + (size_t)cur.g * g.gsA) + (size_t)cur.pm * tstepA; const char* cB = (const char*)(g.Bt + (size_t)cur.g * g.gsB) + (size_t)cur.pn * tstepB;
    PG8_STAGE(PG8_SB(0, 0), cB, voffB); PG8_STAGE(PG8_SB(0, 1), cB + hstepB, voffB); PG8_STAGE(PG8_SA(0, 0), cA, voffA); PG8_STAGE(PG8_SA(0, 1), cA + hstepA, voffA);
    if (wr == 1) PG8_BAR;
    PG8_WAIT_V(2); PG8_BAR;
    PG8_STAGE(PG8_SB(1, 0), cB + kstep, voffB); PG8_STAGE(PG8_SA(1, 0), cA + kstep, voffA); PG8_STAGE(PG8_SB(1, 1), cB + hstepB + kstep, voffB);
    PG8_WAIT_V(6); PG8_BAR;
    for (;;) {
        const bool has_next = S.next(ui + 1, nxt);
        const char* nA = has_next ? (const char*)(g.A + (size_t)nxt.g * g.gsA) + (size_t)nxt.pm * tstepA : cA;
        const char* nB = has_next ? (const char*)(g.Bt + (size_t)nxt.g * g.gsB) + (size_t)nxt.pn * tstepB : cB;
        for (int t = 0; t < nt; t += 2) {
            const bool last = (t == nt - 2);
            const char* a1 = cA + (size_t)(t + 1) * kstep;
            const char* a2 = last ? nA : cA + (size_t)(t + 2) * kstep; const char* b2 = last ? nB : cB + (size_t)(t + 2) * kstep;
            const char* a3 = a2 + kstep; const char* b3 = b2 + kstep;
            PG8_LDB(B0, 0, 0); PG8_LDB(B1, 0, 1); PG8_SCHED; PG8_LDA(At, 0, 0); PG8_STAGE(PG8_SA(1, 1), a1 + hstepA, voffA);
            PG8_WAIT_V(8); PG8_WAIT_L(0); PG8_BAR; PG8_MMA(0, 0, At, B0); PG8_MMA(0, 1, At, B1); PG8_BAR; PG8_SCHED;
            PG8_LDA(At, 0, 1); PG8_STAGE(PG8_SB(0, 0), b2, voffB); PG8_STAGE(PG8_SB(0, 1), b2 + hstepB, voffB); PG8_STAGE(PG8_SA(0, 0), a2, voffA);
            PG8_WAIT_V(8); PG8_WAIT_L(0); PG8_BAR; PG8_MMA(1, 0, At, B0); PG8_MMA(1, 1, At, B1); PG8_BAR; PG8_SCHED;
            PG8_LDB(B0, 1, 0); PG8_LDB(B1, 1, 1); PG8_SCHED; PG8_LDA(At, 1, 0); PG8_STAGE(PG8_SA(0, 1), a2 + hstepA, voffA);
            PG8_WAIT_V(8); PG8_WAIT_L(0); PG8_BAR; PG8_MMA(0, 0, At, B0); PG8_MMA(0, 1, At, B1); PG8_BAR; PG8_SCHED;
            PG8_LDA(At, 1, 1); PG8_STAGE(PG8_SB(1, 0), b3, voffB); PG8_STAGE(PG8_SB(1, 1), b3 + hstepB, voffB); PG8_STAGE(PG8_SA(1, 0), a3, voffA);
            PG8_WAIT_V(8); PG8_WAIT_L(0); PG8_BAR; PG8_MMA(1, 0, At, B0); PG8_MMA(1, 1, At, B1); PG8_BAR; PG8_SCHED;
        }
        if (wr == 0) PG8_BAR;
        E(acc, cur, wr, wc, fr, fq);
        if (!has_next) break;
#pragma unroll
        for (int a = 0; a < 2; ++a)
#pragma unroll
            for (int b = 0; b < 2; ++b)
#pragma unroll
                for (int m = 0; m < 4; ++m)
#pragma unroll
                    for (int n = 0; n < 2; ++n) acc[a][b][m][n] = (f32x4){0.f, 0.f, 0.f, 0.f};
        cur = nxt; cA = nA; cB = nB; ++ui;
        if (wr == 1) PG8_BAR;
    }
    PG8_WAIT_V(0);
    PG8_BAR;
#undef PG8_SA
#undef PG8_SB
#undef PG8_STAGE
#undef PG8_LDA
#undef PG8_LDB
#undef PG8_MMA
#undef PG8_WAIT_V
#undef PG8_WAIT_L
#undef PG8_BAR
#undef PG8_SCHED
}
}

constexpr int D = 1024, SEQ = 8192, ML = 16384, CTXL = 256, MC = 512, MALL = ML + MC, FF = 2816, NMODW = 9 * 1024;
constexpr int TCH = 32, KS5 = 768, ROWS5 = 512;
constexpr float EPS = 1e-6f;
constexpr size_t MiB = 1u << 20;
constexpr size_t WS_MOD = 128 * 1024, WS_HCTX = 512 * 1024;
constexpr size_t WS_WIN = 1 * MiB, WS_WMIX = 3 * MiB, WS_WGLU = 5 * MiB, WS_BB = 5 * MiB + 512 * 1024, WS_KTAB = 6 * MiB, WS_PW = 8 * MiB;
constexpr size_t WS_W13A = 10 * MiB, WS_W2A = 21 * MiB, WS_W13B = 27 * MiB, WS_W2B = 38 * MiB, WS_WST = 44 * MiB, WS_BS5 = 52 * MiB;
constexpr size_t WS_HN = 76 * MiB, WS_MIX = 109 * MiB, WS_X1C = 141 * MiB, WS_UCTX = 143 * MiB, WS_UB = 144 * MiB;
constexpr size_t WS_POOL = 144 * MiB, WS_AS5 = 160 * MiB, WS_S = 184 * MiB, WS_Y = 200 * MiB, WS_END = 236 * MiB;
constexpr int LDS_BYTES = 147456;

struct KArgs { const float* in[24]; float* out; unsigned char* ws; };

struct EpiUp {
    static constexpr bool PERM = true;
    bf16_t* O;
    __device__ __forceinline__ void operator()(const f32x4 (&acc)[2][2][4][2], const pg8::Unit& u, int wr, int wc, int fr, int fq) const {
        const int row0 = u.pm * 256 + wr * 64 + fr, f0 = u.pn * 128 + wc * 16 + 4 * fq;
#pragma unroll
        for (int ai = 0; ai < 2; ++ai)
#pragma unroll
            for (int m = 0; m < 4; ++m) { bf16_t* rowp = O + (size_t)(row0 + ai * 128 + m * 16) * FF + f0;
#pragma unroll
                for (int bj = 0; bj < 2; ++bj) { const f32x4 a = acc[ai][bj][m][0], b = acc[ai][bj][m][1];
                    u32x2 w; w.x = cvt_pk_bf16(silu_fast(a[0]) * b[0], silu_fast(a[1]) * b[1]); w.y = cvt_pk_bf16(silu_fast(a[2]) * b[2], silu_fast(a[3]) * b[3]);
                    *(u32x2*)(rowp + bj * 64) = w; } }
    }
};
struct EpiRes {
    static constexpr bool PERM = false;
    const float* resid_l; const float* resid_c; float* out_l; float* out_c; const float* gate; float coef;
    __device__ __forceinline__ void operator()(const f32x4 (&acc)[2][2][4][2], const pg8::Unit& u, int wr, int wc, int fr, int fq) const {
        const int set = u.pm < 32 ? 0 : (u.pm < 64 ? 1 : 2);
        const bool isc = u.pm >= 64;
        const float* rb = isc ? resid_c - (size_t)ML * D : resid_l; float* ob = isc ? out_c - (size_t)ML * D : out_l;
        const int row0 = u.pm * 256 + wr * 64 + fr, col0 = u.pn * 256 + wc * 32 + 4 * fq;
        f32x4 gv[2][2];
#pragma unroll
        for (int bj = 0; bj < 2; ++bj)
#pragma unroll
            for (int n = 0; n < 2; ++n) gv[bj][n] = *(const f32x4*)(gate + set * NMODW + col0 + bj * 128 + n * 16) * coef;
#pragma unroll
        for (int ai = 0; ai < 2; ++ai)
#pragma unroll
            for (int m = 0; m < 4; ++m) { const size_t off = (size_t)(row0 + ai * 128 + m * 16) * D + col0;
#pragma unroll
                for (int bj = 0; bj < 2; ++bj)
#pragma unroll
                    for (int n = 0; n < 2; ++n) { const f32x4 r = *(const f32x4*)(rb + off + bj * 128 + n * 16); *(f32x4*)(ob + off + bj * 128 + n * 16) = r + gv[bj][n] * acc[ai][bj][m][n]; }
                asm volatile("" ::: "memory"); }
    }
};
struct EpiWin {
    static constexpr bool PERM = true;
    bf16_t* pool; bf16_t* As5; float* Uctx;
    __device__ __forceinline__ void operator()(const f32x4 (&acc)[2][2][4][2], const pg8::Unit& u, int wr, int wc, int fr, int fq) const {
        const int row0 = u.pm * 256 + wr * 64 + fr;
        const bool isc = u.pm >= 64, ispool = u.pn < 2;
        if (isc && ispool) return;
#pragma unroll
        for (int ai = 0; ai < 2; ++ai)
#pragma unroll
            for (int m = 0; m < 4; ++m) { const int row = row0 + ai * 128 + m * 16;
#pragma unroll
                for (int bj = 0; bj < 2; ++bj) { const int col0 = u.pn * 256 + bj * 128 + wc * 32 + 8 * fq; const f32x4 v0 = acc[ai][bj][m][0], v1 = acc[ai][bj][m][1];
                    if (isc) { float* p = Uctx + (size_t)(row - ML) * 512 + (col0 - 512); *(f32x4*)p = v0; *(f32x4*)(p + 4) = v1; }
                    else { u32x4 w; w.x = cvt_pk_bf16(v0[0], v0[1]); w.y = cvt_pk_bf16(v0[2], v0[3]); w.z = cvt_pk_bf16(v1[0], v1[1]); w.w = cvt_pk_bf16(v1[2], v1[3]);
                        const int b = row >> 13, tok = row & 8191;
                        if (ispool) { const int k = col0 >> 7, slab = (col0 >> 3) & 15; *(u32x4*)(pool + ((size_t)((b * 4 + k) * 16 + slab) * 8192 + tok) * 8) = w; }
                        else { const int cs = col0 - 512, gg = cs >> 4, c0 = cs & 15; *(u32x4*)(As5 + ((size_t)gg * ROWS5 + b * 256 + (tok >> 5)) * KS5 + (tok & 31) * 16 + c0) = w; } } } }
    }
};
struct EpiState {
    static constexpr bool PERM = false;
    float* S;
    __device__ __forceinline__ void operator()(const f32x4 (&acc)[2][2][4][2], const pg8::Unit& u, int wr, int wc, int fr, int fq) const {
        const int row0 = u.pm * 256 + wr * 64 + fr, col0 = wc * 32 + 4 * fq;
#pragma unroll
        for (int ai = 0; ai < 2; ++ai)
#pragma unroll
            for (int m = 0; m < 4; ++m) { float* rowp = S + ((size_t)u.g * ROWS5 + row0 + ai * 128 + m * 16) * 256 + col0;
#pragma unroll
                for (int bj = 0; bj < 2; ++bj)
#pragma unroll
                    for (int n = 0; n < 2; ++n) *(f32x4*)(rowp + bj * 128 + n * 16) = acc[ai][bj][m][n]; }
    }
};
struct EpiS5 {
    static constexpr bool PERM = true;
    bf16_t* Y;
    __device__ __forceinline__ void operator()(const f32x4 (&acc)[2][2][4][2], const pg8::Unit& u, int wr, int wc, int fr, int fq) const {
        const int row0 = u.pm * 256 + wr * 64 + fr;
#pragma unroll
        for (int ai = 0; ai < 2; ++ai)
#pragma unroll
            for (int m = 0; m < 4; ++m) { const int row = row0 + ai * 128 + m * 16, b = row >> 8, chunk = row & 255;
#pragma unroll
                for (int bj = 0; bj < 2; ++bj) { const int n0 = u.pn * 256 + bj * 128 + wc * 32 + 8 * fq, t = n0 >> 4, c0 = n0 & 15; const f32x4 v0 = acc[ai][bj][m][0], v1 = acc[ai][bj][m][1];
                    u32x4 w; w.x = cvt_pk_bf16(gelu_tanh(v0[0]), gelu_tanh(v0[1])); w.y = cvt_pk_bf16(gelu_tanh(v0[2]), gelu_tanh(v0[3]));
                    w.z = cvt_pk_bf16(gelu_tanh(v1[0]), gelu_tanh(v1[1])); w.w = cvt_pk_bf16(gelu_tanh(v1[2]), gelu_tanh(v1[3]));
                    *(u32x4*)(Y + (size_t)(b * SEQ + chunk * TCH + t) * 512 + u.g * 16 + c0) = w; } }
    }
};
struct EpiGlu {
    static constexpr bool PERM = true;
    const bf16_t* Y; bf16_t* mix;
    __device__ __forceinline__ void operator()(const f32x4 (&acc)[2][2][4][2], const pg8::Unit& u, int wr, int wc, int fr, int fq) const {
        const int row0 = u.pm * 256 + wr * 64 + fr;
#pragma unroll
        for (int ai = 0; ai < 2; ++ai)
#pragma unroll
            for (int m = 0; m < 4; ++m) { const int row = row0 + ai * 128 + m * 16;
#pragma unroll
                for (int bj = 0; bj < 2; ++bj) { const int col0 = u.pn * 256 + bj * 128 + wc * 32 + 8 * fq; const f32x4 v0 = acc[ai][bj][m][0], v1 = acc[ai][bj][m][1];
                    const u32x4 y = *(const u32x4*)(Y + (size_t)row * 512 + col0); u32x4 w;
                    w.x = cvt_pk_bf16(bf_lo(y.x) * sigmoid_fast(v0[0]), bf_hi(y.x) * sigmoid_fast(v0[1])); w.y = cvt_pk_bf16(bf_lo(y.y) * sigmoid_fast(v0[2]), bf_hi(y.y) * sigmoid_fast(v0[3]));
                    w.z = cvt_pk_bf16(bf_lo(y.z) * sigmoid_fast(v1[0]), bf_hi(y.z) * sigmoid_fast(v1[1])); w.w = cvt_pk_bf16(bf_lo(y.w) * sigmoid_fast(v1[2]), bf_hi(y.w) * sigmoid_fast(v1[3]));
                    *(u32x4*)(mix + (size_t)row * D + 512 + col0) = w; } }
    }
};

__device__ __forceinline__ float wave_sum(float v) {
#pragma unroll
    for (int o = 1; o < 64; o <<= 1) v += __shfl_xor(v, o);
    return v;
}
__device__ __forceinline__ void transpose_item(const float* W, int ldw, bf16_t* WT, int ldd, int mode, LAS float* scr, int kb, int nb, int lane) {
    const int k0 = 64 * kb, n0 = 32 * nb;
#pragma unroll 8
    for (int i = 0; i < 32; ++i) { const int kk = 2 * i + (lane >> 5); scr[kk * 33 + (lane & 31)] = W[(size_t)(k0 + kk) * ldw + n0 + (lane & 31)]; }
    asm volatile("s_waitcnt lgkmcnt(0)" ::: "memory");
    const int c = lane & 7;
#pragma unroll
    for (int j = 0; j < 4; ++j) { const int n = (lane >> 3) + 8 * j, ncol = n0 + n; const LAS float* s = scr + (8 * c) * 33 + n;
        const int row = mode == 0 ? ncol : (8 * (ncol >> 2) + (ncol & 3) + (mode == 2 ? 4 : 0));
        u32x4 o; o.x = cvt_pk_bf16(s[0 * 33], s[1 * 33]); o.y = cvt_pk_bf16(s[2 * 33], s[3 * 33]); o.z = cvt_pk_bf16(s[4 * 33], s[5 * 33]); o.w = cvt_pk_bf16(s[6 * 33], s[7 * 33]);
        *(u32x4*)(WT + (size_t)row * ldd + k0 + 8 * c) = o; }
    asm volatile("s_waitcnt lgkmcnt(0)" ::: "memory");
}
__device__ __forceinline__ void norm_mod_row(const float* xrow, const float* g, const float* shift, const float* scale, bf16_t* orow, int lane) {
    const f32x4* xr = (const f32x4*)xrow + lane; f32x4 v[4]; float s = 0.f;
#pragma unroll
    for (int j = 0; j < 4; ++j) { v[j] = xr[64 * j]; s += (v[j].x * v[j].x + v[j].y * v[j].y) + (v[j].z * v[j].z + v[j].w * v[j].w); }
    const float r = 1.0f / sqrtf(wave_sum(s) * (1.f / D) + EPS);
    u32x2* o8 = (u32x2*)orow + lane;
#pragma unroll
    for (int j = 0; j < 4; ++j) { const f32x4 gg = ((const f32x4*)g)[lane + 64 * j], sh = ((const f32x4*)shift)[lane + 64 * j], sc = ((const f32x4*)scale)[lane + 64 * j];
        const f32x4 y = (v[j] * r) * gg; const f32x4 h = y * (sc + 1.0f) + sh; u32x2 w; w.x = cvt_pk_bf16(h.x, h.y); w.y = cvt_pk_bf16(h.z, h.w); o8[64 * j] = w; }
}


#define XB_TMO      128
#define XB_XCNT(j)  (256  + 64 * (j))
#define XB_XSUB(j)  (1280 + 64 * (j))
#define XB_XGEN(j)  (2304 + 64 * (j))
#define XB_TOP      3328
#define XB_TOPGEN   3392
#define XCD_BAR_WORDS 3456
#define XB_SPIN_CAP (1u << 22)
__device__ __forceinline__ unsigned xb_ld(unsigned* p)              { return __hip_atomic_load(p, __ATOMIC_RELAXED, __HIP_MEMORY_SCOPE_AGENT); }
__device__ __forceinline__ unsigned xb_add(unsigned* p, unsigned v) { return __hip_atomic_fetch_add(p, v, __ATOMIC_RELAXED, __HIP_MEMORY_SCOPE_AGENT); }
__device__ __forceinline__ unsigned xb_xcc_id() { return (unsigned)__builtin_amdgcn_s_getreg((3 << 11) | 20) & 0xFu; }
#define XB_SPIN(cond, bar) do { unsigned _sp = 0; while (cond) { __builtin_amdgcn_s_sleep(1); \
    if ((++_sp & 255u) == 0u) { if (xb_ld(&(bar)[XB_TMO])) break; if (_sp > XB_SPIN_CAP) { atomicAdd(&(bar)[XB_TMO], 1u); break; } } } } while (0)
struct XcdBarrier { unsigned* bar; unsigned x; volatile LAS unsigned* st; };
__device__ __forceinline__ XcdBarrier xcd_barrier_post(unsigned* bar, volatile LAS unsigned* st) {
    XcdBarrier b; b.bar = bar; b.x = xb_xcc_id(); b.st = st;
    if (threadIdx.x == 0) (void)xb_add(&bar[XB_XCNT(b.x)], 1u);
    return b;
}
__device__ __forceinline__ void xcd_barrier_complete(unsigned* bar, unsigned x, unsigned& nloc, unsigned& nx) {
    const unsigned G = gridDim.x * gridDim.y * gridDim.z;
    unsigned sum, cnt, mine, sp = 0u;
    for (;;) {
        sum = 0u; cnt = 0u; mine = 0u;
#pragma unroll
        for (unsigned j = 0; j < 16; ++j) { const unsigned c = xb_ld(&bar[XB_XCNT(j)]); sum += c; cnt += (c > 0u) ? 1u : 0u; mine = (j == x) ? c : mine; }
        if (sum == G) break;
        __builtin_amdgcn_s_sleep(1);
        if ((++sp & 255u) == 0u) { if (xb_ld(&bar[XB_TMO])) break; if (sp > XB_SPIN_CAP) { atomicAdd(&bar[XB_TMO], 1u); break; } }
    }
    nloc = mine > 0u ? mine : 1u; nx = cnt > 0u ? cnt : 1u;
}
__device__ __forceinline__ void xcd_barrier(const XcdBarrier& b) {
    asm volatile("s_waitcnt vmcnt(0)" ::: "memory");
    __syncthreads();
    if (threadIdx.x == 0) {
        unsigned* bar = b.bar;
        __builtin_amdgcn_s_waitcnt(0);
        unsigned nloc = b.st[0], nx = b.st[1];
        if (nloc == 0u) { xcd_barrier_complete(bar, b.x, nloc, nx); b.st[0] = nloc; b.st[1] = nx; }
        const unsigned old = xb_add(&bar[XB_XSUB(b.x)], 1u);
        const unsigned gen = old / nloc;
        if (old + 1u == (gen + 1u) * nloc) {
            __builtin_amdgcn_fence(__ATOMIC_RELEASE, "agent");
            asm volatile("s_waitcnt vmcnt(0)" ::: "memory");
            const unsigned og = xb_add(&bar[XB_TOP], 1u);
            const unsigned tg = og / nx;
            if (og + 1u == (tg + 1u) * nx) xb_add(&bar[XB_TOPGEN], 1u);
            else XB_SPIN(xb_ld(&bar[XB_TOPGEN]) == tg, bar);
            __builtin_amdgcn_fence(__ATOMIC_ACQUIRE, "agent");
            xb_add(&bar[XB_XGEN(b.x)], 1u);
            asm volatile("s_waitcnt vmcnt(0)" ::: "memory");
        } else {
            XB_SPIN(xb_ld(&bar[XB_XGEN(b.x)]) == gen, bar);
            __builtin_amdgcn_fence(__ATOMIC_ACQUIRE, "agent");
            asm volatile("s_waitcnt vmcnt(0)" ::: "memory");
        }
    }
    __syncthreads();
}
#ifndef PHMASK
#define PHMASK 0xFFFFF
#endif
#ifndef REPMASK
#define REPMASK 0
#endif
#ifndef XSYNC
#define XSYNC 0
#endif
#define PH(k) for (int rep_ = 0; rep_ < 1 + (((REPMASK) >> (k)) & 1); ++rep_) if constexpr (((PHMASK) >> (k)) & 1)
__global__ void __launch_bounds__(512, 2) fwd_megakernel(KArgs a) {
    extern __shared__ __attribute__((aligned(16))) unsigned char lds_raw[];
    LAS unsigned char* lds = (LAS unsigned char*)lds_raw;
    cg::grid_group grid = cg::this_grid();
    const int tid = threadIdx.x, lane = tid & 63, wave = __builtin_amdgcn_readfirstlane(tid >> 6);
    const int G = gridDim.x, bid = blockIdx.x;
    const int gw = bid * 8 + wave, NGW = G * 8;
    volatile LAS unsigned* bst = (volatile LAS unsigned*)(lds + LDS_BYTES - 64);
    if (tid == 0) { bst[0] = 0u; bst[1] = 0u; }
    __syncthreads();
    const XcdBarrier xbar = xcd_barrier_post((unsigned*)a.ws, bst);
#define GSYNC() xcd_barrier(xbar)
#define ws (a.ws)
#define xin_ (a.in[0])
#define cvec (a.in[1])
#define ctx (a.in[2])
#define cctx (a.in[3])
#define norm_g (a.in[4])
#define w_ada (a.in[5])
#define b_ada (a.in[6])
#define mod ((float*)(ws + WS_MOD))
#define Hctx ((f32x2*)(ws + WS_HCTX))
#define Win_t ((bf16_t*)(ws + WS_WIN))
#define Wmix_t ((bf16_t*)(ws + WS_WMIX))
#define Wglu_t ((bf16_t*)(ws + WS_WGLU))
#define BB ((f32x2*)(ws + WS_BB))
#define Ktab ((float*)(ws + WS_KTAB))
#define PW ((f32x2*)(ws + WS_PW))
#define W13a ((bf16_t*)(ws + WS_W13A))
#define W2a ((bf16_t*)(ws + WS_W2A))
#define W13b ((bf16_t*)(ws + WS_W13B))
#define W2b ((bf16_t*)(ws + WS_W2B))
#define Wst ((bf16_t*)(ws + WS_WST))
#define Bs5 ((bf16_t*)(ws + WS_BS5))
#define Hn ((bf16_t*)(ws + WS_HN))
#define mixcat ((bf16_t*)(ws + WS_MIX))
#define X1c ((float*)(ws + WS_X1C))
#define Uctx ((float*)(ws + WS_UCTX))
#define Ubuf ((bf16_t*)(ws + WS_UB))
#define poolb ((bf16_t*)(ws + WS_POOL))
#define As5 ((bf16_t*)(ws + WS_AS5))
#define Sbuf ((float*)(ws + WS_S))
#define Ybuf ((bf16_t*)(ws + WS_Y))
#define out (a.out)

    PH(0) {
        LAS float* sc = (LAS float*)lds;
        LAS float* red = (LAS float*)(lds + 16384);
        for (int i = tid; i < 3072; i += 512) { const float v = i < 2048 ? cvec[i] : cctx[i - 2048]; sc[i] = v / (1.f + expf(-v)); }
        __syncthreads();
        for (int strip = bid; strip < 288; strip += G) {
            const int cg4 = tid & 7, kk = tid >> 3;
            f32x4 a0 = {0.f, 0.f, 0.f, 0.f}, a1 = a0, a2 = a0;
#pragma unroll 4
            for (int it = 0; it < 16; ++it) { const int k = kk + 64 * it; const f32x4 w = *(const f32x4*)(w_ada + (size_t)k * NMODW + strip * 32 + cg4 * 4);
                a0 += w * sc[k]; a1 += w * sc[1024 + k]; a2 += w * sc[2048 + k]; }
#pragma unroll
            for (int i = 0; i < 4; ++i) { red[kk * 100 + cg4 * 4 + i] = a0[i]; red[kk * 100 + 32 + cg4 * 4 + i] = a1[i]; red[kk * 100 + 64 + cg4 * 4 + i] = a2[i]; }
            __syncthreads();
            if (tid < 96) { float s = 0.f;
#pragma unroll 8
                for (int k2 = 0; k2 < 64; ++k2) s += red[k2 * 100 + tid]; const int r = tid >> 5, col = strip * 32 + (tid & 31); mod[r * NMODW + col] = s + b_ada[col]; }
            __syncthreads();
        }
        LAS f32x2* pwL = (LAS f32x2*)(lds + 65536);
        LAS f32x2* bbL = (LAS f32x2*)(lds + 65536 + 17408);
        LAS f32x2* cL = (LAS f32x2*)(lds + 65536 + 17408 + 8192);
        const float* a_re = a.in[13]; const float* a_im = a.in[14]; const float* log_dt = a.in[15]; const float* b_re = a.in[16]; const float* b_im = a.in[17];
        const float* c_re = a.in[18]; const float* c_im = a.in[19];
#pragma unroll 1
        for (int it = G - 1 - bid; it < 64; it += G) {
            const int g = it >> 1, dir = it & 1, pd = dir * 32 + g;
            const float dt = expf(log_dt[pd]);
            for (int idx = tid; idx < 33 * 64; idx += 512) { const int tau = idx >> 6, p = idx & 63; const float are = a_re[pd * 64 + p], aim = a_im[pd * 64 + p];
                const float mag = expf(are * dt * (float)tau); double ang = (double)aim * (double)dt * (double)tau; ang -= 6.283185307179586 * rint(ang * 0.15915494309189535);
                float sn, cs; sincosf((float)ang, &sn, &cs); const f32x2 v = {mag * cs, mag * sn}; pwL[idx] = v; PW[(size_t)it * 33 * 64 + idx] = v; }
            for (int idx = tid; idx < 1024; idx += 512) { const f32x2 v = {c_re[(size_t)pd * 1024 + idx], c_im[(size_t)pd * 1024 + idx]}; cL[idx] = v; }
            __syncthreads();
            for (int idx = tid; idx < 1024; idx += 512) { const int p = idx >> 4; const float are = a_re[pd * 64 + p], aim = a_im[pd * 64 + p]; const float zr = are * dt, zi = aim * dt;
                float qr, qi;
                if (zr * zr + zi * zi < 0.25f) { float tr = 1.f, ti = 0.f;
                    for (int k = 12; k >= 2; --k) { const float ik = 1.0f / (float)k, wr_ = zr * ik, wi_ = zi * ik; const float nr = 1.f + (wr_ * tr - wi_ * ti), ni = wr_ * ti + wi_ * tr; tr = nr; ti = ni; }
                    qr = dt * tr; qi = dt * ti; }
                else { const f32x2 ab = pwL[64 + p]; const float nr = ab.x - 1.f, ni = ab.y, den = are * are + aim * aim; qr = (nr * are + ni * aim) / den; qi = (ni * are - nr * aim) / den; }
                const float br = b_re[(size_t)g * 1024 + idx], bi = b_im[(size_t)g * 1024 + idx];
                const f32x2 v = {qr * br - qi * bi, qr * bi + qi * br}; bbL[idx] = v; BB[(size_t)it * 1024 + idx] = v; }
            __syncthreads();
#pragma unroll 1
            for (int j = 0; j < 16; ++j) { const int idx = tid + 512 * j, tau = idx >> 8, c = (idx >> 4) & 15, cc = idx & 15; float s = 0.f;
#pragma unroll 8
                for (int p = 0; p < 64; ++p) { const f32x2 C = cL[c * 64 + p], w = pwL[tau * 64 + p], b = bbL[p * 16 + cc]; const float zr = C.x * w.x - C.y * w.y, zi = C.x * w.y + C.y * w.x; s += zr * b.x - zi * b.y; }
                Ktab[(size_t)it * 8192 + idx] = s; }
            __syncthreads();
        }
    }
    grid.sync();

    PH(1) {
        LAS float* scr = (LAS float*)(lds + wave * 16384);
        constexpr int I_UP = 16 * 88, I_DN = 44 * 32, I_IN = 16 * 32, I_OUT = 8 * 32, I_GLU = 8 * 16;
        constexpr int NITEMS = 4 * I_UP + 2 * I_DN + I_IN + I_OUT + I_GLU;
        for (int it = gw; it < NITEMS; it += NGW) {
            int r = it;
            if (r < I_UP) { transpose_item(a.in[7], FF, W13a, D, 1, scr, r / 88, r % 88, lane); continue; } r -= I_UP;
            if (r < I_UP) { transpose_item(a.in[8], FF, W13a, D, 2, scr, r / 88, r % 88, lane); continue; } r -= I_UP;
            if (r < I_DN) { transpose_item(a.in[9], D, W2a, FF, 0, scr, r / 32, r % 32, lane); continue; } r -= I_DN;
            if (r < I_UP) { transpose_item(a.in[7] + (size_t)D * FF, FF, W13b, D, 1, scr, r / 88, r % 88, lane); continue; } r -= I_UP;
            if (r < I_UP) { transpose_item(a.in[8] + (size_t)D * FF, FF, W13b, D, 2, scr, r / 88, r % 88, lane); continue; } r -= I_UP;
            if (r < I_DN) { transpose_item(a.in[9] + (size_t)D * FF, D, W2b, FF, 0, scr, r / 32, r % 32, lane); continue; } r -= I_DN;
            if (r < I_IN) { transpose_item(a.in[10], D, Win_t, D, 0, scr, r / 32, r % 32, lane); continue; } r -= I_IN;
            if (r < I_OUT) { transpose_item(a.in[22] + (size_t)512 * D, D, Wmix_t + 512, D, 0, scr, r / 32, r % 32, lane); continue; } r -= I_OUT;
            transpose_item(a.in[21], 512, Wglu_t, 512, 0, scr, r / 16, r % 16, lane);
        }
        {
            const float* pool_w = a.in[11]; const float* pool_scale = a.in[12]; const float* w_out = a.in[22];
            for (int it = G - 1 - bid; it < 64; it += G) { const int k = it >> 4, cb = it & 15;
                f32x2 ac[8];
#pragma unroll
                for (int i = 0; i < 8; ++i) ac[i] = (f32x2){0.f, 0.f};
                for (int d = 0; d < 128; ++d) { const f32x2 wo = *(const f32x2*)(w_out + (size_t)(k * 128 + d) * D + 2 * tid) * pool_scale[k * 128 + d];
#pragma unroll
                    for (int i = 0; i < 8; ++i) ac[i] += wo * pool_w[(size_t)(k * 128 + cb * 8 + i) * 128 + d]; }
                u32x4 w0, w1; w0.x = cvt_pk_bf16(ac[0].x, ac[1].x); w0.y = cvt_pk_bf16(ac[2].x, ac[3].x); w0.z = cvt_pk_bf16(ac[4].x, ac[5].x); w0.w = cvt_pk_bf16(ac[6].x, ac[7].x);
                w1.x = cvt_pk_bf16(ac[0].y, ac[1].y); w1.y = cvt_pk_bf16(ac[2].y, ac[3].y); w1.z = cvt_pk_bf16(ac[4].y, ac[5].y); w1.w = cvt_pk_bf16(ac[6].y, ac[7].y);
                *(u32x4*)(Wmix_t + (size_t)(2 * tid) * D + k * 128 + cb * 8) = w0; *(u32x4*)(Wmix_t + (size_t)(2 * tid + 1) * D + k * 128 + cb * 8) = w1; }
        }
        {
            const float* c_re = a.in[18]; const float* c_im = a.in[19]; const float* dskip = a.in[20];
            const int gt = bid * 512 + tid, NT = G * 512;
            for (int e = gt; e < 32 * 512 * 96; e += NT) { const int k8 = e % 96, n = (e / 96) & 511, g = e / (96 * 512), t = n >> 4, c = n & 15; float v[8];
                if (k8 < 64) { const int s = k8 >> 1, c0 = (k8 & 1) * 8;
#pragma unroll
                    for (int i = 0; i < 8; ++i) v[i] = 0.f;
                    if (s <= t) { const float* kp = Ktab + ((size_t)((g * 2 + 0) * 32 + (t - s)) * 256 + c * 16 + c0); const f32x4 k0 = *(const f32x4*)kp, k1 = *(const f32x4*)(kp + 4);
                        v[0] += k0.x; v[1] += k0.y; v[2] += k0.z; v[3] += k0.w; v[4] += k1.x; v[5] += k1.y; v[6] += k1.z; v[7] += k1.w; }
                    if (s >= t) { const float* kp = Ktab + ((size_t)((g * 2 + 1) * 32 + (s - t)) * 256 + c * 16 + c0); const f32x4 k0 = *(const f32x4*)kp, k1 = *(const f32x4*)(kp + 4);
                        v[0] += k0.x; v[1] += k0.y; v[2] += k0.z; v[3] += k0.w; v[4] += k1.x; v[5] += k1.y; v[6] += k1.z; v[7] += k1.w; }
                    if (s == t) { const float dv = dskip[g * 16 + c];
#pragma unroll
                        for (int i = 0; i < 8; ++i) if (c0 + i == c) v[i] += dv; }
                } else { const int j = k8 - 64, part = j >> 3, p0 = (j & 7) * 8, dir = part >> 1, ex = dir == 0 ? t + 1 : 32 - t;
#pragma unroll
                    for (int i = 0; i < 8; ++i) { const int p = p0 + i; const size_t ci = ((size_t)(dir * 32 + g) * 16 + c) * 64 + p; const float cr = c_re[ci], cim = c_im[ci]; const f32x2 w = PW[((size_t)(g * 2 + dir) * 33 + ex) * 64 + p];
                        const float zr = cr * w.x - cim * w.y, zi = cr * w.y + cim * w.x; v[i] = (part & 1) ? -zi : zr; } }
                u32x4 o; o.x = cvt_pk_bf16(v[0], v[1]); o.y = cvt_pk_bf16(v[2], v[3]); o.z = cvt_pk_bf16(v[4], v[5]); o.w = cvt_pk_bf16(v[6], v[7]);
                *(u32x4*)(Bs5 + ((size_t)g * 512 + n) * KS5 + k8 * 8) = o; }
            for (int e = gt; e < 32 * 256 * 64; e += NT) { const int k8 = e & 63, n = (e >> 6) & 255, g = e >> 14, dir = n >> 7, reim = (n >> 6) & 1, p = n & 63, s = k8 >> 1, c0 = (k8 & 1) * 8, ex = dir == 0 ? 31 - s : s;
                const f32x2 w = PW[((size_t)(g * 2 + dir) * 33 + ex) * 64 + p]; float v[8];
#pragma unroll
                for (int i = 0; i < 8; ++i) { const f32x2 b = BB[((size_t)(g * 2 + dir) * 64 + p) * 16 + c0 + i]; v[i] = reim ? (w.x * b.y + w.y * b.x) : (w.x * b.x - w.y * b.y); }
                u32x4 o; o.x = cvt_pk_bf16(v[0], v[1]); o.y = cvt_pk_bf16(v[2], v[3]); o.z = cvt_pk_bf16(v[4], v[5]); o.w = cvt_pk_bf16(v[6], v[7]);
                *(u32x4*)(Wst + ((size_t)g * 256 + n) * 512 + k8 * 8) = o; }
        }
        for (int m = gw; m < MALL; m += NGW) { const int set = m < SEQ ? 0 : (m < ML ? 1 : 2); const float* src = m < ML ? xin_ + (size_t)m * D : ctx + (size_t)(m - ML) * D;
            norm_mod_row(src, norm_g, mod + set * NMODW + 0 * 1024, mod + set * NMODW + 1 * 1024, Hn + (size_t)m * D, lane); }
    }
    GSYNC();

    PH(2) { pg8::Gemm g{Hn, W13a, D, D, D, 0, 0}; pg8::StaticOrder S; S.init(MALL, 2 * FF, G, bid); EpiUp E{Ubuf}; pg8::gemm_phase(lds, g, S, E); }
    GSYNC();
    PH(3) { pg8::Gemm g{Ubuf, W2a, FF, FF, FF, 0, 0}; pg8::StaticOrder S; S.init(MALL, D, G, bid); EpiRes E{xin_, ctx, out, X1c, mod + 2 * 1024, 0.5f}; pg8::gemm_phase(lds, g, S, E); }
    GSYNC();
    PH(4) for (int m = gw; m < MALL; m += NGW) { const int set = m < SEQ ? 0 : (m < ML ? 1 : 2); const float* src = m < ML ? out + (size_t)m * D : X1c + (size_t)(m - ML) * D;
        norm_mod_row(src, norm_g + 1024, mod + set * NMODW + 3 * 1024, mod + set * NMODW + 4 * 1024, Hn + (size_t)m * D, lane); }
    GSYNC();
    PH(5) { pg8::Gemm g{Hn, Win_t, D, D, D, 0, 0}; pg8::StaticOrder S; S.init(MALL, D, G, bid); EpiWin E{poolb, As5, Uctx}; pg8::gemm_phase(lds, g, S, E); }
    GSYNC();
    PH(6) {
        const int Gg = G < 64 ? G : 64;
        { pg8::Gemm g{As5, Wst, KS5, 512, 512, (size_t)ROWS5 * KS5, (size_t)256 * 512}; pg8::GroupOrder S; S.init(2, 1, 32, Gg, bid); EpiState E{Sbuf}; pg8::gemm_phase(lds, g, S, E); }
        const int r1 = (bid + G - Gg % G) % G;
        for (int it = r1; it < 16; it += G) { const int wi = it * 8 + wave, b = wi >> 6, g = (wi >> 1) & 31, dir = wi & 1;
            const f32x2 av = PW[((size_t)(g * 2 + dir) * 33 + 1) * 64 + lane]; f32x2 bb[16];
#pragma unroll
            for (int i = 0; i < 16; ++i) bb[i] = BB[((size_t)(g * 2 + dir) * 64 + lane) * 16 + i];
            float hr = 0.f, hi = 0.f;
#pragma unroll 4
            for (int step = 0; step < CTXL; ++step) { const int t = dir == 0 ? step : CTXL - 1 - step; const f32x4* up = (const f32x4*)(Uctx + (size_t)(b * CTXL + t) * 512 + g * 16);
                const f32x4 u0 = up[0], u1 = up[1], u2 = up[2], u3 = up[3]; float sr = 0.f, si = 0.f;
#pragma unroll
                for (int i = 0; i < 4; ++i) { sr += bb[i].x * u0[i]; si += bb[i].y * u0[i]; }
#pragma unroll
                for (int i = 0; i < 4; ++i) { sr += bb[4 + i].x * u1[i]; si += bb[4 + i].y * u1[i]; }
#pragma unroll
                for (int i = 0; i < 4; ++i) { sr += bb[8 + i].x * u2[i]; si += bb[8 + i].y * u2[i]; }
#pragma unroll
                for (int i = 0; i < 4; ++i) { sr += bb[12 + i].x * u3[i]; si += bb[12 + i].y * u3[i]; }
                const float nr = av.x * hr - av.y * hi + sr, ni = av.x * hi + av.y * hr + si; hr = nr; hi = ni; }
            Hctx[(size_t)wi * 64 + lane] = (f32x2){hr, hi}; }
        const int r2 = (bid + 2 * G - (Gg + 16) % G) % G;
        LAS bf16_t* raw = (LAS bf16_t*)lds;
        LAS float* rowb = (LAS float*)(lds + 131072);
        for (int it = r2; it < 128; it += G) { const int b = it >> 6, k = (it >> 4) & 3, slab = it & 15;
            __syncthreads();
            const bf16_t* src = poolb + (size_t)it * 8192 * 8;
#pragma unroll 4
            for (int i = 0; i < 16; ++i) { const int tok = i * 512 + tid; *(LAS u32x4*)(raw + tok * 8) = *(const u32x4*)(src + (size_t)tok * 8); }
            __syncthreads();
            const int c = tid >> 3, ch = tid & 7, w = 2 << k, lo = w >> 1, hi = w - 1 - lo;
            const int clo = c - lo < 0 ? 0 : c - lo, chi = c + hi > 63 ? 63 : c + hi; const float icc = 1.0f / (float)(chi - clo + 1);
            float vs = 0.f;
            for (int r = 0; r <= hi; ++r) vs += bf2f(raw[(r * 64 + c) * 8 + ch]);
            for (int r = 0; r < 128; ++r) {
                const int rlo = r - lo < 0 ? 0 : r - lo, rhi = r + hi > 127 ? 127 : r + hi;
                LAS float* rb = rowb + (r & 1) * 512;
                rb[c * 8 + ch] = vs / (float)(rhi - rlo + 1);
                __syncthreads();
                float hs = 0.f;
                for (int c2 = clo; c2 <= chi; ++c2) hs += rb[c2 * 8 + ch];
                const float dval = hs * icc - bf2f(raw[(r * 64 + c) * 8 + ch]);
                const float d1 = __shfl_down(dval, 1); unsigned p01 = cvt_pk_bf16(dval, d1);
                const unsigned p23 = __shfl_down(p01, 2); const unsigned q0 = __shfl_down(p01, 4), q1 = __shfl_down(p23, 4);
                if (ch == 0) { u32x4 o; o.x = p01; o.y = p23; o.z = q0; o.w = q1; *(u32x4*)(mixcat + (size_t)(b * SEQ + r * 64 + c) * D + k * 128 + slab * 8) = o; }
                if (r + 1 + hi <= 127) vs += bf2f(raw[((r + 1 + hi) * 64 + c) * 8 + ch]);
                if (r - lo >= 0) vs -= bf2f(raw[((r - lo) * 64 + c) * 8 + ch]);
            }
        }
    }
    GSYNC();
    PH(7) for (int it = bid; it < 16; it += G) { const int wi = it * 8 + wave, b = wi >> 6, g = (wi >> 1) & 31, dir = wi & 1;
        const f32x2 a32 = PW[((size_t)(g * 2 + dir) * 33 + 32) * 64 + lane]; f32x2 h = Hctx[(size_t)wi * 64 + lane];
        const size_t rbase = (size_t)g * ROWS5 + b * 256;
        for (int s0 = 0; s0 < 256; s0 += 16) { float sre[16], sim[16];
#pragma unroll
            for (int i = 0; i < 16; ++i) { const int j = dir == 0 ? s0 + i : 255 - s0 - i; const float* sp = Sbuf + (rbase + j) * 256 + dir * 128 + lane; sre[i] = sp[0]; sim[i] = sp[64]; }
#pragma unroll
            for (int i = 0; i < 16; ++i) { const int j = dir == 0 ? s0 + i : 255 - s0 - i; bf16_t* hp = As5 + (rbase + j) * KS5 + 512 + dir * 128 + lane;
                hp[0] = (bf16_t)(cvt_pk_bf16(h.x, 0.f) & 0xffffu); hp[64] = (bf16_t)(cvt_pk_bf16(h.y, 0.f) & 0xffffu);
                const float nr = a32.x * h.x - a32.y * h.y + sre[i], ni = a32.x * h.y + a32.y * h.x + sim[i]; h.x = nr; h.y = ni; } }
    }
    GSYNC();
    PH(8) { pg8::Gemm g{As5, Bs5, KS5, KS5, KS5, (size_t)ROWS5 * KS5, (size_t)512 * KS5}; pg8::GroupOrder S; S.init(2, 2, 32, G, bid); EpiS5 E{Ybuf}; pg8::gemm_phase(lds, g, S, E); }
    GSYNC();
    PH(9) { pg8::Gemm g{Ybuf, Wglu_t, 512, 512, 512, 0, 0}; pg8::StaticOrder S; S.init(ML, 512, G, bid); EpiGlu E{Ybuf, mixcat}; pg8::gemm_phase(lds, g, S, E); }
    GSYNC();
    PH(10) { pg8::Gemm g{mixcat, Wmix_t, D, D, D, 0, 0}; pg8::StaticOrder S; S.init(ML, D, G, bid); EpiRes E{out, out, out, out, mod + 5 * 1024, 1.0f}; pg8::gemm_phase(lds, g, S, E); }
    GSYNC();
    PH(11) for (int m = gw; m < ML; m += NGW) { const int set = m < SEQ ? 0 : 1;
        norm_mod_row(out + (size_t)m * D, norm_g + 2048, mod + set * NMODW + 6 * 1024, mod + set * NMODW + 7 * 1024, Hn + (size_t)m * D, lane); }
    GSYNC();
    PH(12) { pg8::Gemm g{Hn, W13b, D, D, D, 0, 0}; pg8::StaticOrder S; S.init(ML, 2 * FF, G, bid); EpiUp E{Ubuf}; pg8::gemm_phase(lds, g, S, E); }
    GSYNC();
    PH(13) { pg8::Gemm g{Ubuf, W2b, FF, FF, FF, 0, 0}; pg8::StaticOrder S; S.init(ML, D, G, bid); EpiRes E{out, out, out, out, mod + 8 * 1024, 0.5f}; pg8::gemm_phase(lds, g, S, E); }
    GSYNC();
    for (int xs_ = 0; xs_ < XSYNC; ++xs_) GSYNC();
    PH(14) {
        const float* fg = a.in[23];
        for (int m = gw; m < ML; m += NGW) { f32x4* xr = (f32x4*)(out + (size_t)m * D) + lane; f32x4 v[4]; float s = 0.f;
#pragma unroll
            for (int j = 0; j < 4; ++j) { v[j] = xr[64 * j]; s += (v[j].x * v[j].x + v[j].y * v[j].y) + (v[j].z * v[j].z + v[j].w * v[j].w); }
            const float r = 1.0f / sqrtf(wave_sum(s) * (1.f / D) + EPS);
#pragma unroll
            for (int j = 0; j < 4; ++j) xr[64 * j] = (v[j] * r) * ((const f32x4*)fg)[lane + 64 * j]; }
    }
}

#undef ws
#undef xin_
#undef cvec
#undef ctx
#undef cctx
#undef norm_g
#undef w_ada
#undef b_ada
#undef mod
#undef Hctx
#undef Win_t
#undef Wmix_t
#undef Wglu_t
#undef BB
#undef Ktab
#undef PW
#undef W13a
#undef W2a
#undef W13b
#undef W2b
#undef Wst
#undef Bs5
#undef Hn
#undef mixcat
#undef X1c
#undef Uctx
#undef Ubuf
#undef poolb
#undef As5
#undef Sbuf
#undef Ybuf
#undef out
extern "C" void kernel_launch(void* const* d_in, const int* in_sizes, int n_in, void* d_out, int out_size, void* d_ws, size_t ws_size, hipStream_t stream) {
    static int grid = 0;
    if (grid == 0) {
        if (n_in != 24 || out_size != ML * D || ws_size < WS_END) { fprintf(stderr, "kernel_launch: unexpected shapes (n_in %d out %d ws %zu)\n", n_in, out_size, ws_size); grid = -1; return; }
        int dev = 0, cus = 0, per_cu = 0;
        hipGetDevice(&dev); hipDeviceGetAttribute(&cus, hipDeviceAttributeMultiprocessorCount, dev);
        hipFuncSetAttribute((const void*)fwd_megakernel, hipFuncAttributeMaxDynamicSharedMemorySize, LDS_BYTES);
        if (hipOccupancyMaxActiveBlocksPerMultiprocessor(&per_cu, (const void*)fwd_megakernel, 512, LDS_BYTES) != hipSuccess || per_cu < 1) per_cu = 1;
        (void)hipGetLastError();
        grid = cus * 1;
        if (grid <= 0) grid = 256;
    }
    if (grid < 0) return;
    if (hipMemsetAsync(d_ws, 0, 16384, stream) != hipSuccess) { fprintf(stderr, "kernel_launch: memset failed\n"); return; }
    KArgs a{};
    for (int i = 0; i < 24; ++i) a.in[i] = (const float*)d_in[i];
    a.out = (float*)d_out; a.ws = (unsigned char*)d_ws;
    void* args[] = {&a};
    hipError_t e = hipLaunchCooperativeKernel((const void*)fwd_megakernel, dim3(grid), dim3(512), args, LDS_BYTES, stream);
    if (e != hipSuccess) fprintf(stderr, "cooperative launch failed: %s (grid %d)\n", hipGetErrorString(e), grid);
}
```

```cpp
#include <hip/hip_runtime.h>
#include <hip/hip_cooperative_groups.h>
#include <cstdio>
#include <cstdint>
namespace cg = cooperative_groups;

#define LAS __attribute__((address_space(3)))
typedef unsigned short bf16_t;
typedef short bf16x8 __attribute__((ext_vector_type(8)));
typedef float f32x4 __attribute__((ext_vector_type(4)));
typedef float f32x2 __attribute__((ext_vector_type(2)));
typedef unsigned u32x4 __attribute__((ext_vector_type(4)));
typedef unsigned u32x2 __attribute__((ext_vector_type(2)));

__device__ __forceinline__ unsigned cvt_pk_bf16(float lo, float hi) { unsigned r; asm volatile("v_cvt_pk_bf16_f32 %0, %1, %2" : "=v"(r) : "v"(lo), "v"(hi)); return r; }
__device__ __forceinline__ float bf_lo(unsigned w) { return __builtin_bit_cast(float, w << 16); }
__device__ __forceinline__ float bf_hi(unsigned w) { return __builtin_bit_cast(float, w & 0xffff0000u); }
__device__ __forceinline__ float bf2f(bf16_t h) { return __builtin_bit_cast(float, ((unsigned)h) << 16); }
__device__ __forceinline__ float sigmoid_fast(float x) { return __builtin_amdgcn_rcpf(1.f + __expf(-x)); }
__device__ __forceinline__ float silu_fast(float x) { return x * sigmoid_fast(x); }
__device__ __forceinline__ float gelu_tanh(float x) { const float z = 1.5957691216057308f * (x + 0.044715f * x * x * x); return x * sigmoid_fast(z); }

namespace pg8 {
constexpr int BM = 256, BK = 64, HALF = 128, HTB = HALF * BK * 2, STAGE_BYTES = 8 * HTB, NXCD = 8, WGM = 8;
__host__ __device__ __forceinline__ int lds_byte(int r, int c) { const int st = (r >> 4) * 2 + (c >> 5), rr = r & 15, cc = c & 31, ob = rr * 64 + cc * 2; return st * 1024 + (ob ^ (((ob >> 9) & 1) << 5)); }
__host__ __device__ __forceinline__ void stage_rc(int b, int& R, int& C) { const int st = b / 1024, sb = b % 1024, swz = sb ^ (((sb >> 9) & 1) << 5); R = (st >> 1) * 16 + swz / 64; C = (st & 1) * 32 + (swz % 64) / 2; }
__host__ __device__ __forceinline__ int perm32(int rho) { const int n = rho >> 4, i = rho & 15; return 8 * (i >> 2) + 4 * n + (i & 3); }

struct Unit { int pm, pn, g, k0, nt; };
struct Gemm { const bf16_t* A; const bf16_t* Bt; int lda, ldb, K; size_t gsA, gsB; };

struct StaticOrder {
    int nM, nN, nwg, G, c, ntf;
    __device__ void init(int M, int N, int K, int G_, int c_) { nM = M / BM; nN = N / BM; nwg = nM * nN; G = G_; c = c_; ntf = K / BK; }
    __device__ bool next(int i, Unit& u) const { const long L = (long)i * G + c; if (L >= nwg) return false; unit_of((int)L, u); return true; }
    __device__ void unit_of(int L, Unit& u) const {
        int wgid = L; { const int q = nwg / NXCD, r = nwg % NXCD, xcd = wgid % NXCD, off = wgid / NXCD; wgid = (xcd < r ? xcd * (q + 1) : r * (q + 1) + (xcd - r) * q) + off; }
        const int nig = WGM * nN, gid = wgid / nig, fm = gid * WGM, gsz = (nM - fm) < WGM ? (nM - fm) : WGM;
        u.pm = fm + ((wgid % nig) % gsz); u.pn = (wgid % nig) / gsz; u.g = 0; u.k0 = 0; u.nt = ntf;
    }
};
struct TailOrder {
    StaticOrder base; int nmini, nks, pn0, npn;
    __device__ void init(int M, int N, int K, int G_, int c_, int nmini_, int nks_, int pn0_, int npn_) { base.init(M, N, K, G_, c_); nmini = nmini_; nks = nks_; pn0 = pn0_; npn = npn_; }
    __device__ bool next(int i, Unit& u) const {
        const long L = (long)i * base.G + base.c; if (L < base.nwg) { base.unit_of((int)L, u); return true; }
        const int idx = (int)(L - base.nwg); if (idx >= nmini) return false;
        const int ks = idx % nks, t = idx / nks; u.pm = 64 + t / npn; u.pn = pn0 + t % npn; u.g = 0; u.k0 = ks * 256; u.nt = 4; return true;
    }
};
struct GroupOrder {
    int nM, nN, ng, G, c, ntf;
    __device__ void init(int nM_, int nN_, int ng_, int K, int G_, int c_) { nM = nM_; nN = nN_; ng = ng_; G = G_; c = c_; ntf = K / BK; }
    __device__ bool next(int i, Unit& u) const {
        if (c >= G) return false;
        const long L = (long)i * G + c; if (L >= (long)ng * nM * nN) return false;
        const int per = nM * nN, l = (int)L; u.g = l / per; const int r = l % per; u.pm = r / nN; u.pn = r % nN; u.k0 = 0; u.nt = ntf; return true;
    }
};

template <class Epi, class Sched>
__device__ __forceinline__ void gemm_phase(LAS unsigned char* lds, const Gemm g, const Sched& S, const Epi& E) {
    int tid_ = threadIdx.x; asm volatile("" : "+v"(tid_));
    const int tid = tid_, wid = __builtin_amdgcn_readfirstlane(tid >> 6), lane = tid & 63, wr = wid >> 2, wc = wid & 3, fr = lane & 15, fq = lane >> 4;
    unsigned voffA[2], voffB[2];
#pragma unroll
    for (int i = 0; i < 2; ++i) { int R, C; stage_rc(tid * 16 + i * 8192, R, C); const int Rb = Epi::PERM ? ((R & ~31) + perm32(R & 31)) : R;
        voffA[i] = (unsigned)(R * g.lda + C) * 2u; voffB[i] = (unsigned)(Rb * g.ldb + C) * 2u; }
    const size_t kstep = (size_t)(BK * 2);
    const size_t hstepA = (size_t)HALF * g.lda * 2, hstepB = (size_t)HALF * g.ldb * 2;
    const size_t tstepA = 2 * hstepA, tstepB = 2 * hstepB;
    const unsigned ldsw = (unsigned)wid * 1024u;
    const int aoff = lds_byte(wr * 64 + fr, fq * 8), boff = lds_byte(wc * 32 + fr, fq * 8);
#define PG8_SA(b, h) (((b) * 2 + (h)) * HTB)
#define PG8_SB(b, h) ((4 + (b) * 2 + (h)) * HTB)
#define PG8_STAGE(bufoff, gbase, voff) do { _Pragma("unroll") for (int _i = 0; _i < 2; ++_i) \
        __builtin_amdgcn_global_load_lds((const unsigned*)((const char*)(gbase) + (voff)[_i]), (LAS unsigned*)(lds + (bufoff) + ldsw + _i * 8192), 16, 0, 0); } while (0)
#define PG8_LDA(dst, b, h) do { _Pragma("unroll") for (int m = 0; m < 4; ++m) _Pragma("unroll") for (int k = 0; k < 2; ++k) dst[m][k] = *(const LAS bf16x8*)(lds + PG8_SA(b, h) + aoff + m * 2048 + k * 1024); } while (0)
#define PG8_LDB(dst, b, h) do { _Pragma("unroll") for (int n = 0; n < 2; ++n) _Pragma("unroll") for (int k = 0; k < 2; ++k) dst[n][k] = *(const LAS bf16x8*)(lds + PG8_SB(b, h) + boff + n * 2048 + k * 1024); } while (0)
#define PG8_MMA(ai, bj, At, Bt) do { __builtin_amdgcn_s_setprio(1); _Pragma("unroll") for (int m = 0; m < 4; ++m) _Pragma("unroll") for (int n = 0; n < 2; ++n) _Pragma("unroll") for (int k = 0; k < 2; ++k) \
        acc[ai][bj][m][n] = __builtin_amdgcn_mfma_f32_16x16x32_bf16(Bt[n][k], At[m][k], acc[ai][bj][m][n], 0, 0, 0); __builtin_amdgcn_s_setprio(0); } while (0)
#define PG8_WAIT_V(n) asm volatile("s_waitcnt vmcnt(" #n ")" ::: "memory")
#define PG8_WAIT_L(n) asm volatile("s_waitcnt lgkmcnt(" #n ")" ::: "memory")
#define PG8_BAR __builtin_amdgcn_s_barrier()
#define PG8_SCHED __builtin_amdgcn_sched_barrier(0)
    Unit cur, nxt; int ui = 0;
    if (!S.next(0, cur)) return;
    f32x4 acc[2][2][4][2];
#pragma unroll
    for (int a = 0; a < 2; ++a)
#pragma unroll
        for (int b = 0; b < 2; ++b)
#pragma unroll
            for (int m = 0; m < 4; ++m)
#pragma unroll
                for (int n = 0; n < 2; ++n) acc[a][b][m][n] = (f32x4){0.f, 0.f, 0.f, 0.f};
    bf16x8 At[4][2], B0[2][2], B1[2][2];
    const char* cA = (const char*)(g.A + (size_t)cur.g * g.gsA + cur.k0) + (size_t)cur.pm * tstepA; const char* cB = (const char*)(g.Bt + (size_t)cur.g * g.gsB + cur.k0) + (size_t)cur.pn * tstepB;
    PG8_STAGE(PG8_SB(0, 0), cB, voffB); PG8_STAGE(PG8_SB(0, 1), cB + hstepB, voffB); PG8_STAGE(PG8_SA(0, 0), cA, voffA); PG8_STAGE(PG8_SA(0, 1), cA + hstepA, voffA);
    if (wr == 1) PG8_BAR;
    PG8_WAIT_V(2); PG8_BAR;
    PG8_STAGE(PG8_SB(1, 0), cB + kstep, voffB); PG8_STAGE(PG8_SA(1, 0), cA + kstep, voffA); PG8_STAGE(PG8_SB(1, 1), cB + hstepB + kstep, voffB);
    PG8_WAIT_V(6); PG8_BAR;
    for (;;) {
        const bool has_next = S.next(ui + 1, nxt);
        const char* nA = has_next ? (const char*)(g.A + (size_t)nxt.g * g.gsA + nxt.k0) + (size_t)nxt.pm * tstepA : cA;
        const char* nB = has_next ? (const char*)(g.Bt + (size_t)nxt.g * g.gsB + nxt.k0) + (size_t)nxt.pn * tstepB : cB;
        const int nt = cur.nt;
        for (int t = 0; t < nt; t += 2) {
            const bool last = (t == nt - 2);
            const char* a1 = cA + (size_t)(t + 1) * kstep;
            const char* a2 = last ? nA : cA + (size_t)(t + 2) * kstep; const char* b2 = last ? nB : cB + (size_t)(t + 2) * kstep;
            const char* a3 = a2 + kstep; const char* b3 = b2 + kstep;
            PG8_LDB(B0, 0, 0); PG8_LDB(B1, 0, 1); PG8_SCHED; PG8_LDA(At, 0, 0); PG8_STAGE(PG8_SA(1, 1), a1 + hstepA, voffA);
            PG8_WAIT_V(8); PG8_WAIT_L(0); PG8_BAR; PG8_MMA(0, 0, At, B0); PG8_MMA(0, 1, At, B1); PG8_BAR; PG8_SCHED;
            PG8_LDA(At, 0, 1); PG8_STAGE(PG8_SB(0, 0), b2, voffB); PG8_STAGE(PG8_SB(0, 1), b2 + hstepB, voffB); PG8_STAGE(PG8_SA(0, 0), a2, voffA);
            PG8_WAIT_V(8); PG8_WAIT_L(0); PG8_BAR; PG8_MMA(1, 0, At, B0); PG8_MMA(1, 1, At, B1); PG8_BAR; PG8_SCHED;
            PG8_LDB(B0, 1, 0); PG8_LDB(B1, 1, 1); PG8_SCHED; PG8_LDA(At, 1, 0); PG8_STAGE(PG8_SA(0, 1), a2 + hstepA, voffA);
            PG8_WAIT_V(8); PG8_WAIT_L(0); PG8_BAR; PG8_MMA(0, 0, At, B0); PG8_MMA(0, 1, At, B1); PG8_BAR; PG8_SCHED;
            PG8_LDA(At, 1, 1); PG8_STAGE(PG8_SB(1, 0), b3, voffB); PG8_STAGE(PG8_SB(1, 1), b3 + hstepB, voffB); PG8_STAGE(PG8_SA(1, 0), a3, voffA);
            PG8_WAIT_V(8); PG8_WAIT_L(0); PG8_BAR; PG8_MMA(1, 0, At, B0); PG8_MMA(1, 1, At, B1); PG8_BAR; PG8_SCHED;
        }
        if (wr == 0) PG8_BAR;
        E(acc, cur, wr, wc, fr, fq);
        if (!has_next) break;
#pragma unroll
        for (int a = 0; a < 2; ++a)
#pragma unroll
            for (int b = 0; b < 2; ++b)
#pragma unroll
                for (int m = 0; m < 4; ++m)
#pragma unroll
                    for (int n = 0; n < 2; ++n) acc[a][b][m][n] = (f32x4){0.f, 0.f, 0.f, 0.f};
        cur = nxt; cA = nA; cB = nB; ++ui;
        if (wr == 1) PG8_BAR;
    }
    PG8_WAIT_V(0);
    PG8_BAR;
#undef PG8_SA
#undef PG8_SB
#undef PG8_STAGE
#undef PG8_LDA
#undef PG8_LDB
#undef PG8_MMA
#undef PG8_WAIT_V
#undef PG8_WAIT_L
#undef PG8_BAR
#undef PG8_SCHED
}
}

constexpr int D = 1024, SEQ = 8192, ML = 16384, CTXL = 256, MC = 512, MALL = ML + MC, FF = 2816, NMODW = 9 * 1024;
constexpr int TCH = 32, KS5 = 768, ROWS5 = 512;
constexpr float EPS = 1e-6f;
constexpr size_t MiB = 1u << 20;
constexpr size_t WS_MOD = 128 * 1024, WS_HCTX = 512 * 1024;
constexpr size_t WS_WIN = 1 * MiB, WS_WMIX = 3 * MiB, WS_WGLU = 5 * MiB, WS_BB = 5 * MiB + 512 * 1024, WS_KTAB = 6 * MiB, WS_PW = 8 * MiB;
constexpr size_t WS_W13A = 10 * MiB, WS_W2A = 21 * MiB, WS_W13B = 27 * MiB, WS_W2B = 38 * MiB, WS_WST = 44 * MiB, WS_BS5 = 52 * MiB;
constexpr size_t WS_HN = 76 * MiB, WS_MIX = 109 * MiB, WS_X1C = 141 * MiB, WS_UCTX = 143 * MiB, WS_UB = 144 * MiB;
constexpr size_t WS_POOL = 144 * MiB, WS_AS5 = 160 * MiB, WS_S = 184 * MiB, WS_Y = 200 * MiB, WS_UCTXP = 216 * MiB, WS_END = 236 * MiB;
constexpr size_t WS_PC = WS_MIX;
constexpr int LDS_BYTES = 147456;

struct KArgs { const float* in[24]; float* out; unsigned char* ws; };

struct EpiUp {
    static constexpr bool PERM = true;
    bf16_t* O;
    __device__ __forceinline__ void operator()(const f32x4 (&acc)[2][2][4][2], const pg8::Unit& u, int wr, int wc, int fr, int fq) const {
        const int row0 = u.pm * 256 + wr * 64 + fr, f0 = u.pn * 128 + wc * 16 + 4 * fq;
#pragma unroll
        for (int ai = 0; ai < 2; ++ai)
#pragma unroll
            for (int m = 0; m < 4; ++m) { bf16_t* rowp = O + (size_t)(row0 + ai * 128 + m * 16) * FF + f0;
#pragma unroll
                for (int bj = 0; bj < 2; ++bj) { const f32x4 a = acc[ai][bj][m][0], b = acc[ai][bj][m][1];
                    u32x2 w; w.x = cvt_pk_bf16(silu_fast(a[0]) * b[0], silu_fast(a[1]) * b[1]); w.y = cvt_pk_bf16(silu_fast(a[2]) * b[2], silu_fast(a[3]) * b[3]);
                    *(u32x2*)(rowp + bj * 64) = w; } }
    }
};
struct EpiRes {
    static constexpr bool PERM = false;
    const float* resid_l; float* out_l; float* part_c; const float* gate; float coef;
    __device__ __forceinline__ void operator()(const f32x4 (&acc)[2][2][4][2], const pg8::Unit& u, int wr, int wc, int fr, int fq) const {
        const int set = u.pm < 32 ? 0 : 1;
        const int row0 = u.pm * 256 + wr * 64 + fr, col0 = u.pn * 256 + wc * 32 + 4 * fq;
        if (u.pm >= 64) { float* pb = part_c + (size_t)(u.k0 >> 8) * MC * D;
#pragma unroll
            for (int ai = 0; ai < 2; ++ai)
#pragma unroll
                for (int m = 0; m < 4; ++m) { const size_t off = (size_t)(row0 - ML + ai * 128 + m * 16) * D + col0;
#pragma unroll
                    for (int bj = 0; bj < 2; ++bj)
#pragma unroll
                        for (int n = 0; n < 2; ++n) *(f32x4*)(pb + off + bj * 128 + n * 16) = acc[ai][bj][m][n]; }
            return; }
        const float* rb = resid_l; float* ob = out_l;
        f32x4 gv[2][2];
#pragma unroll
        for (int bj = 0; bj < 2; ++bj)
#pragma unroll
            for (int n = 0; n < 2; ++n) gv[bj][n] = *(const f32x4*)(gate + set * NMODW + col0 + bj * 128 + n * 16) * coef;
#pragma unroll
        for (int ai = 0; ai < 2; ++ai)
#pragma unroll
            for (int m = 0; m < 4; ++m) { const size_t off = (size_t)(row0 + ai * 128 + m * 16) * D + col0;
#pragma unroll
                for (int bj = 0; bj < 2; ++bj)
#pragma unroll
                    for (int n = 0; n < 2; ++n) { const f32x4 r = *(const f32x4*)(rb + off + bj * 128 + n * 16); *(f32x4*)(ob + off + bj * 128 + n * 16) = r + gv[bj][n] * acc[ai][bj][m][n]; }
                asm volatile("" ::: "memory"); }
    }
};
struct EpiWin {
    static constexpr bool PERM = true;
    bf16_t* pool; bf16_t* As5; float* Uctx;
    __device__ __forceinline__ void operator()(const f32x4 (&acc)[2][2][4][2], const pg8::Unit& u, int wr, int wc, int fr, int fq) const {
        const int row0 = u.pm * 256 + wr * 64 + fr;
        const bool isc = u.pm >= 64, ispool = u.pn < 2;
        if (isc && ispool) return;
#pragma unroll
        for (int ai = 0; ai < 2; ++ai)
#pragma unroll
            for (int m = 0; m < 4; ++m) { const int row = row0 + ai * 128 + m * 16;
#pragma unroll
                for (int bj = 0; bj < 2; ++bj) { const int col0 = u.pn * 256 + bj * 128 + wc * 32 + 8 * fq; const f32x4 v0 = acc[ai][bj][m][0], v1 = acc[ai][bj][m][1];
                    if (isc) { float* p = Uctx + (size_t)(u.k0 >> 8) * MC * 512 + (size_t)(row - ML) * 512 + (col0 - 512); *(f32x4*)p = v0; *(f32x4*)(p + 4) = v1; }
                    else { u32x4 w; w.x = cvt_pk_bf16(v0[0], v0[1]); w.y = cvt_pk_bf16(v0[2], v0[3]); w.z = cvt_pk_bf16(v1[0], v1[1]); w.w = cvt_pk_bf16(v1[2], v1[3]);
                        const int b = row >> 13, tok = row & 8191;
                        if (ispool) { const int k = col0 >> 7, slab = (col0 >> 3) & 15; *(u32x4*)(pool + ((size_t)((b * 4 + k) * 16 + slab) * 8192 + tok) * 8) = w; }
                        else { const int cs = col0 - 512, gg = cs >> 4, c0 = cs & 15; *(u32x4*)(As5 + ((size_t)gg * ROWS5 + b * 256 + (tok >> 5)) * KS5 + (tok & 31) * 16 + c0) = w; } } } }
    }
};
struct EpiState {
    static constexpr bool PERM = false;
    float* S;
    __device__ __forceinline__ void operator()(const f32x4 (&acc)[2][2][4][2], const pg8::Unit& u, int wr, int wc, int fr, int fq) const {
        const int row0 = u.pm * 256 + wr * 64 + fr, col0 = wc * 32 + 4 * fq;
#pragma unroll
        for (int ai = 0; ai < 2; ++ai)
#pragma unroll
            for (int m = 0; m < 4; ++m) { float* rowp = S + ((size_t)u.g * ROWS5 + row0 + ai * 128 + m * 16) * 256 + col0;
#pragma unroll
                for (int bj = 0; bj < 2; ++bj)
#pragma unroll
                    for (int n = 0; n < 2; ++n) *(f32x4*)(rowp + bj * 128 + n * 16) = acc[ai][bj][m][n]; }
    }
};
struct EpiS5 {
    static constexpr bool PERM = true;
    bf16_t* Y;
    __device__ __forceinline__ void operator()(const f32x4 (&acc)[2][2][4][2], const pg8::Unit& u, int wr, int wc, int fr, int fq) const {
        const int row0 = u.pm * 256 + wr * 64 + fr;
#pragma unroll
        for (int ai = 0; ai < 2; ++ai)
#pragma unroll
            for (int m = 0; m < 4; ++m) { const int row = row0 + ai * 128 + m * 16, b = row >> 8, chunk = row & 255;
#pragma unroll
                for (int bj = 0; bj < 2; ++bj) { const int n0 = u.pn * 256 + bj * 128 + wc * 32 + 8 * fq, t = n0 >> 4, c0 = n0 & 15; const f32x4 v0 = acc[ai][bj][m][0], v1 = acc[ai][bj][m][1];
                    u32x4 w; w.x = cvt_pk_bf16(gelu_tanh(v0[0]), gelu_tanh(v0[1])); w.y = cvt_pk_bf16(gelu_tanh(v0[2]), gelu_tanh(v0[3]));
                    w.z = cvt_pk_bf16(gelu_tanh(v1[0]), gelu_tanh(v1[1])); w.w = cvt_pk_bf16(gelu_tanh(v1[2]), gelu_tanh(v1[3]));
                    *(u32x4*)(Y + (size_t)(b * SEQ + chunk * TCH + t) * 512 + u.g * 16 + c0) = w; } }
    }
};
struct EpiGlu {
    static constexpr bool PERM = true;
    const bf16_t* Y; bf16_t* mix;
    __device__ __forceinline__ void operator()(const f32x4 (&acc)[2][2][4][2], const pg8::Unit& u, int wr, int wc, int fr, int fq) const {
        const int row0 = u.pm * 256 + wr * 64 + fr;
#pragma unroll
        for (int ai = 0; ai < 2; ++ai)
#pragma unroll
            for (int m = 0; m < 4; ++m) { const int row = row0 + ai * 128 + m * 16;
#pragma unroll
                for (int bj = 0; bj < 2; ++bj) { const int col0 = u.pn * 256 + bj * 128 + wc * 32 + 8 * fq; const f32x4 v0 = acc[ai][bj][m][0], v1 = acc[ai][bj][m][1];
                    const u32x4 y = *(const u32x4*)(Y + (size_t)row * 512 + col0); u32x4 w;
                    w.x = cvt_pk_bf16(bf_lo(y.x) * sigmoid_fast(v0[0]), bf_hi(y.x) * sigmoid_fast(v0[1])); w.y = cvt_pk_bf16(bf_lo(y.y) * sigmoid_fast(v0[2]), bf_hi(y.y) * sigmoid_fast(v0[3]));
                    w.z = cvt_pk_bf16(bf_lo(y.z) * sigmoid_fast(v1[0]), bf_hi(y.z) * sigmoid_fast(v1[1])); w.w = cvt_pk_bf16(bf_lo(y.w) * sigmoid_fast(v1[2]), bf_hi(y.w) * sigmoid_fast(v1[3]));
                    *(u32x4*)(mix + (size_t)row * D + 512 + col0) = w; } }
    }
};

__device__ __forceinline__ float wave_sum(float v) {
#pragma unroll
    for (int o = 1; o < 64; o <<= 1) v += __shfl_xor(v, o);
    return v;
}
__device__ __forceinline__ void transpose_item(const float* W, int ldw, bf16_t* WT, int ldd, int mode, LAS float* scr, int kb, int nb, int lane) {
    const int k0 = 64 * kb, n0 = 32 * nb;
#pragma unroll 8
    for (int i = 0; i < 32; ++i) { const int kk = 2 * i + (lane >> 5); scr[kk * 33 + (lane & 31)] = W[(size_t)(k0 + kk) * ldw + n0 + (lane & 31)]; }
    asm volatile("s_waitcnt lgkmcnt(0)" ::: "memory");
    const int c = lane & 7;
#pragma unroll
    for (int j = 0; j < 4; ++j) { const int n = (lane >> 3) + 8 * j, ncol = n0 + n; const LAS float* s = scr + (8 * c) * 33 + n;
        const int row = mode == 0 ? ncol : (8 * (ncol >> 2) + (ncol & 3) + (mode == 2 ? 4 : 0));
        u32x4 o; o.x = cvt_pk_bf16(s[0 * 33], s[1 * 33]); o.y = cvt_pk_bf16(s[2 * 33], s[3 * 33]); o.z = cvt_pk_bf16(s[4 * 33], s[5 * 33]); o.w = cvt_pk_bf16(s[6 * 33], s[7 * 33]);
        *(u32x4*)(WT + (size_t)row * ldd + k0 + 8 * c) = o; }
    asm volatile("s_waitcnt lgkmcnt(0)" ::: "memory");
}
__device__ __forceinline__ void norm_mod_row(const float* xrow, const float* g, const float* shift, const float* scale, bf16_t* orow, int lane) {
    const f32x4* xr = (const f32x4*)xrow + lane; f32x4 v[4]; float s = 0.f;
#pragma unroll
    for (int j = 0; j < 4; ++j) { v[j] = xr[64 * j]; s += (v[j].x * v[j].x + v[j].y * v[j].y) + (v[j].z * v[j].z + v[j].w * v[j].w); }
    const float r = 1.0f / sqrtf(wave_sum(s) * (1.f / D) + EPS);
    u32x2* o8 = (u32x2*)orow + lane;
#pragma unroll
    for (int j = 0; j < 4; ++j) { const f32x4 gg = ((const f32x4*)g)[lane + 64 * j], sh = ((const f32x4*)shift)[lane + 64 * j], sc = ((const f32x4*)scale)[lane + 64 * j];
        const f32x4 y = (v[j] * r) * gg; const f32x4 h = y * (sc + 1.0f) + sh; u32x2 w; w.x = cvt_pk_bf16(h.x, h.y); w.y = cvt_pk_bf16(h.z, h.w); o8[64 * j] = w; }
}


#define XB_TMO      128
#define XB_XCNT(j)  (256  + 64 * (j))
#define XB_XSUB(j)  (1280 + 64 * (j))
#define XB_XGEN(j)  (2304 + 64 * (j))
#define XB_TOP      3328
#define XB_TOPGEN   3392
#define XCD_BAR_WORDS 3456
#define XB_SPIN_CAP (1u << 22)
__device__ __forceinline__ unsigned xb_ld(unsigned* p)              { return __hip_atomic_load(p, __ATOMIC_RELAXED, __HIP_MEMORY_SCOPE_AGENT); }
__device__ __forceinline__ unsigned xb_add(unsigned* p, unsigned v) { return __hip_atomic_fetch_add(p, v, __ATOMIC_RELAXED, __HIP_MEMORY_SCOPE_AGENT); }
__device__ __forceinline__ unsigned xb_xcc_id() { return (unsigned)__builtin_amdgcn_s_getreg((3 << 11) | 20) & 0xFu; }
#define XB_SPIN(cond, bar) do { unsigned _sp = 0; while (cond) { __builtin_amdgcn_s_sleep(1); \
    if ((++_sp & 255u) == 0u) { if (xb_ld(&(bar)[XB_TMO])) break; if (_sp > XB_SPIN_CAP) { atomicAdd(&(bar)[XB_TMO], 1u); break; } } } } while (0)
struct XcdBarrier { unsigned* bar; unsigned x; volatile LAS unsigned* st; };
__device__ __forceinline__ XcdBarrier xcd_barrier_post(unsigned* bar, volatile LAS unsigned* st) {
    XcdBarrier b; b.bar = bar; b.x = xb_xcc_id(); b.st = st;
    if (threadIdx.x == 0) (void)xb_add(&bar[XB_XCNT(b.x)], 1u);
    return b;
}
__device__ __forceinline__ void xcd_barrier_complete(unsigned* bar, unsigned x, unsigned& nloc, unsigned& nx) {
    const unsigned G = gridDim.x * gridDim.y * gridDim.z;
    unsigned sum, cnt, mine, sp = 0u;
    for (;;) {
        sum = 0u; cnt = 0u; mine = 0u;
#pragma unroll
        for (unsigned j = 0; j < 16; ++j) { const unsigned c = xb_ld(&bar[XB_XCNT(j)]); sum += c; cnt += (c > 0u) ? 1u : 0u; mine = (j == x) ? c : mine; }
        if (sum == G) break;
        __builtin_amdgcn_s_sleep(1);
        if ((++sp & 255u) == 0u) { if (xb_ld(&bar[XB_TMO])) break; if (sp > XB_SPIN_CAP) { atomicAdd(&bar[XB_TMO], 1u); break; } }
    }
    nloc = mine > 0u ? mine : 1u; nx = cnt > 0u ? cnt : 1u;
}
__device__ __forceinline__ void xcd_barrier(const XcdBarrier& b) {
    asm volatile("s_waitcnt vmcnt(0)" ::: "memory");
    __syncthreads();
    if (threadIdx.x == 0) {
        unsigned* bar = b.bar;
        __builtin_amdgcn_s_waitcnt(0);
        unsigned nloc = b.st[0], nx = b.st[1];
        if (nloc == 0u) { xcd_barrier_complete(bar, b.x, nloc, nx); b.st[0] = nloc; b.st[1] = nx; }
        const unsigned old = xb_add(&bar[XB_XSUB(b.x)], 1u);
        const unsigned gen = old / nloc;
        if (old + 1u == (gen + 1u) * nloc) {
            __builtin_amdgcn_fence(__ATOMIC_RELEASE, "agent");
            asm volatile("s_waitcnt vmcnt(0)" ::: "memory");
            const unsigned og = xb_add(&bar[XB_TOP], 1u);
            const unsigned tg = og / nx;
            if (og + 1u == (tg + 1u) * nx) xb_add(&bar[XB_TOPGEN], 1u);
            else XB_SPIN(xb_ld(&bar[XB_TOPGEN]) == tg, bar);
            __builtin_amdgcn_fence(__ATOMIC_ACQUIRE, "agent");
            xb_add(&bar[XB_XGEN(b.x)], 1u);
            asm volatile("s_waitcnt vmcnt(0)" ::: "memory");
        } else {
            XB_SPIN(xb_ld(&bar[XB_XGEN(b.x)]) == gen, bar);
            __builtin_amdgcn_fence(__ATOMIC_ACQUIRE, "agent");
            asm volatile("s_waitcnt vmcnt(0)" ::: "memory");
        }
    }
    __syncthreads();
}
#ifndef PHMASK
#define PHMASK 0xFFFFF
#endif
#ifndef REPMASK
#define REPMASK 0
#endif
#ifndef XSYNC
#define XSYNC 0
#endif
#define PH(k) for (int rep_ = 0; rep_ < 1 + (((REPMASK) >> (k)) & 1); ++rep_) if constexpr (((PHMASK) >> (k)) & 1)
__global__ void __launch_bounds__(512, 2) fwd_megakernel(KArgs a) {
    extern __shared__ __attribute__((aligned(16))) unsigned char lds_raw[];
    LAS unsigned char* lds = (LAS unsigned char*)lds_raw;
    cg::grid_group grid = cg::this_grid();
    const int tid = threadIdx.x, lane = tid & 63, wave = __builtin_amdgcn_readfirstlane(tid >> 6);
    const int G = gridDim.x, bid = blockIdx.x;
    const int gw = bid * 8 + wave, NGW = G * 8;
    volatile LAS unsigned* bst = (volatile LAS unsigned*)(lds + LDS_BYTES - 64);
    if (tid == 0) { bst[0] = 0u; bst[1] = 0u; }
    __syncthreads();
    if (bid == 0) for (int i = tid; i < XCD_BAR_WORDS; i += 512) ((unsigned*)a.ws)[i] = 0u;
#define GSYNC() xcd_barrier(xbar)
#define ws (a.ws)
#define xin_ (a.in[0])
#define cvec (a.in[1])
#define ctx (a.in[2])
#define cctx (a.in[3])
#define norm_g (a.in[4])
#define w_ada (a.in[5])
#define b_ada (a.in[6])
#define mod ((float*)(ws + WS_MOD))
#define Hctx ((f32x2*)(ws + WS_HCTX))
#define Win_t ((bf16_t*)(ws + WS_WIN))
#define Wmix_t ((bf16_t*)(ws + WS_WMIX))
#define Wglu_t ((bf16_t*)(ws + WS_WGLU))
#define BB ((f32x2*)(ws + WS_BB))
#define Ktab ((float*)(ws + WS_KTAB))
#define PW ((f32x2*)(ws + WS_PW))
#define W13a ((bf16_t*)(ws + WS_W13A))
#define W2a ((bf16_t*)(ws + WS_W2A))
#define W13b ((bf16_t*)(ws + WS_W13B))
#define W2b ((bf16_t*)(ws + WS_W2B))
#define Wst ((bf16_t*)(ws + WS_WST))
#define Bs5 ((bf16_t*)(ws + WS_BS5))
#define Hn ((bf16_t*)(ws + WS_HN))
#define mixcat ((bf16_t*)(ws + WS_MIX))
#define X1c ((float*)(ws + WS_X1C))
#define Uctx ((float*)(ws + WS_UCTXP))
#define Pc ((float*)(ws + WS_PC))
#define Ubuf ((bf16_t*)(ws + WS_UB))
#define poolb ((bf16_t*)(ws + WS_POOL))
#define As5 ((bf16_t*)(ws + WS_AS5))
#define Sbuf ((float*)(ws + WS_S))
#define Ybuf ((bf16_t*)(ws + WS_Y))
#define out (a.out)

    PH(0) {
        LAS float* sc = (LAS float*)lds;
        LAS float* red = (LAS float*)(lds + 16384);
        for (int i = tid; i < 3072; i += 512) { const float v = i < 2048 ? cvec[i] : cctx[i - 2048]; sc[i] = v / (1.f + expf(-v)); }
        __syncthreads();
        for (int strip = bid; strip < 288; strip += G) {
            const int cg4 = tid & 7, kk = tid >> 3;
            f32x4 a0 = {0.f, 0.f, 0.f, 0.f}, a1 = a0, a2 = a0;
#pragma unroll 4
            for (int it = 0; it < 16; ++it) { const int k = kk + 64 * it; const f32x4 w = *(const f32x4*)(w_ada + (size_t)k * NMODW + strip * 32 + cg4 * 4);
                a0 += w * sc[k]; a1 += w * sc[1024 + k]; a2 += w * sc[2048 + k]; }
#pragma unroll
            for (int i = 0; i < 4; ++i) { red[kk * 100 + cg4 * 4 + i] = a0[i]; red[kk * 100 + 32 + cg4 * 4 + i] = a1[i]; red[kk * 100 + 64 + cg4 * 4 + i] = a2[i]; }
            __syncthreads();
            if (tid < 96) { float s = 0.f;
#pragma unroll 8
                for (int k2 = 0; k2 < 64; ++k2) s += red[k2 * 100 + tid]; const int r = tid >> 5, col = strip * 32 + (tid & 31); mod[r * NMODW + col] = s + b_ada[col]; }
            __syncthreads();
        }
        LAS f32x2* pwL = (LAS f32x2*)(lds + 65536);
        LAS f32x2* bbL = (LAS f32x2*)(lds + 65536 + 17408);
        LAS f32x2* cL = (LAS f32x2*)(lds + 65536 + 17408 + 8192);
        const float* a_re = a.in[13]; const float* a_im = a.in[14]; const float* log_dt = a.in[15]; const float* b_re = a.in[16]; const float* b_im = a.in[17];
        const float* c_re = a.in[18]; const float* c_im = a.in[19];
#pragma unroll 1
        for (int it2 = G - 1 - bid; it2 < 256; it2 += G) {
            const int it = it2 >> 2, qq = it2 & 3; const bool wr_tab = qq == 0;
            const int g = it >> 1, dir = it & 1, pd = dir * 32 + g;
            const float dt = expf(log_dt[pd]);
            for (int idx = tid; idx < 33 * 64; idx += 512) { const int tau = idx >> 6, p = idx & 63; const float are = a_re[pd * 64 + p], aim = a_im[pd * 64 + p];
                const float mag = expf(are * dt * (float)tau); double ang = (double)aim * (double)dt * (double)tau; ang -= 6.283185307179586 * rint(ang * 0.15915494309189535);
                float sn, cs; sincosf((float)ang, &sn, &cs); const f32x2 v = {mag * cs, mag * sn}; pwL[idx] = v; if (wr_tab) PW[(size_t)it * 33 * 64 + idx] = v; }
            for (int idx = tid; idx < 1024; idx += 512) { const f32x2 v = {c_re[(size_t)pd * 1024 + idx], c_im[(size_t)pd * 1024 + idx]}; cL[idx] = v; }
            __syncthreads();
            for (int idx = tid; idx < 1024; idx += 512) { const int p = idx >> 4; const float are = a_re[pd * 64 + p], aim = a_im[pd * 64 + p]; const float zr = are * dt, zi = aim * dt;
                float qr, qi;
                if (zr * zr + zi * zi < 0.25f) { float tr = 1.f, ti = 0.f;
                    for (int k = 12; k >= 2; --k) { const float ik = 1.0f / (float)k, wr_ = zr * ik, wi_ = zi * ik; const float nr = 1.f + (wr_ * tr - wi_ * ti), ni = wr_ * ti + wi_ * tr; tr = nr; ti = ni; }
                    qr = dt * tr; qi = dt * ti; }
                else { const f32x2 ab = pwL[64 + p]; const float nr = ab.x - 1.f, ni = ab.y, den = are * are + aim * aim; qr = (nr * are + ni * aim) / den; qi = (ni * are - nr * aim) / den; }
                const float br = b_re[(size_t)g * 1024 + idx], bi = b_im[(size_t)g * 1024 + idx];
                const f32x2 v = {qr * br - qi * bi, qr * bi + qi * br}; bbL[idx] = v; if (wr_tab) BB[(size_t)it * 1024 + idx] = v; }
            __syncthreads();
#pragma unroll 1
            for (int j = 0; j < 4; ++j) { const int idx = qq * 2048 + tid + 512 * j, tau = idx >> 8, c = (idx >> 4) & 15, cc = idx & 15; float s = 0.f;
#pragma unroll 8
                for (int p = 0; p < 64; ++p) { const f32x2 C = cL[c * 64 + p], w = pwL[tau * 64 + p], b = bbL[p * 16 + cc]; const float zr = C.x * w.x - C.y * w.y, zi = C.x * w.y + C.y * w.x; s += zr * b.x - zi * b.y; }
                Ktab[(size_t)it * 8192 + idx] = s; }
            __syncthreads();
        }
    }
    grid.sync();
    const XcdBarrier xbar = xcd_barrier_post((unsigned*)ws, bst);

    PH(1) {
        LAS float* scr = (LAS float*)(lds + wave * 16384);
        constexpr int I_UP = 16 * 88, I_DN = 44 * 32, I_IN = 16 * 32, I_OUT = 8 * 32, I_GLU = 8 * 16;
        constexpr int NITEMS = 4 * I_UP + 2 * I_DN + I_IN + I_OUT + I_GLU;
        for (int it = gw; it < NITEMS; it += NGW) {
            int r = it;
            if (r < I_UP) { transpose_item(a.in[7], FF, W13a, D, 1, scr, r / 88, r % 88, lane); continue; } r -= I_UP;
            if (r < I_UP) { transpose_item(a.in[8], FF, W13a, D, 2, scr, r / 88, r % 88, lane); continue; } r -= I_UP;
            if (r < I_DN) { transpose_item(a.in[9], D, W2a, FF, 0, scr, r / 32, r % 32, lane); continue; } r -= I_DN;
            if (r < I_UP) { transpose_item(a.in[7] + (size_t)D * FF, FF, W13b, D, 1, scr, r / 88, r % 88, lane); continue; } r -= I_UP;
            if (r < I_UP) { transpose_item(a.in[8] + (size_t)D * FF, FF, W13b, D, 2, scr, r / 88, r % 88, lane); continue; } r -= I_UP;
            if (r < I_DN) { transpose_item(a.in[9] + (size_t)D * FF, D, W2b, FF, 0, scr, r / 32, r % 32, lane); continue; } r -= I_DN;
            if (r < I_IN) { transpose_item(a.in[10], D, Win_t, D, 0, scr, r / 32, r % 32, lane); continue; } r -= I_IN;
            if (r < I_OUT) { transpose_item(a.in[22] + (size_t)512 * D, D, Wmix_t + 512, D, 0, scr, r / 32, r % 32, lane); continue; } r -= I_OUT;
            transpose_item(a.in[21], 512, Wglu_t, 512, 0, scr, r / 16, r % 16, lane);
        }
        {
            const float* pool_w = a.in[11]; const float* pool_scale = a.in[12]; const float* w_out = a.in[22];
            for (int it = G - 1 - bid; it < 64; it += G) { const int k = it >> 4, cb = it & 15;
                f32x2 ac[8];
#pragma unroll
                for (int i = 0; i < 8; ++i) ac[i] = (f32x2){0.f, 0.f};
                for (int d = 0; d < 128; ++d) { const f32x2 wo = *(const f32x2*)(w_out + (size_t)(k * 128 + d) * D + 2 * tid) * pool_scale[k * 128 + d];
#pragma unroll
                    for (int i = 0; i < 8; ++i) ac[i] += wo * pool_w[(size_t)(k * 128 + cb * 8 + i) * 128 + d]; }
                u32x4 w0, w1; w0.x = cvt_pk_bf16(ac[0].x, ac[1].x); w0.y = cvt_pk_bf16(ac[2].x, ac[3].x); w0.z = cvt_pk_bf16(ac[4].x, ac[5].x); w0.w = cvt_pk_bf16(ac[6].x, ac[7].x);
                w1.x = cvt_pk_bf16(ac[0].y, ac[1].y); w1.y = cvt_pk_bf16(ac[2].y, ac[3].y); w1.z = cvt_pk_bf16(ac[4].y, ac[5].y); w1.w = cvt_pk_bf16(ac[6].y, ac[7].y);
                *(u32x4*)(Wmix_t + (size_t)(2 * tid) * D + k * 128 + cb * 8) = w0; *(u32x4*)(Wmix_t + (size_t)(2 * tid + 1) * D + k * 128 + cb * 8) = w1; }
        }
        {
            const float* c_re = a.in[18]; const float* c_im = a.in[19]; const float* dskip = a.in[20];
            const int gt = bid * 512 + tid, NT = G * 512;
            for (int e = gt; e < 32 * 512 * 96; e += NT) { const int k8 = e % 96, n = (e / 96) & 511, g = e / (96 * 512), t = n >> 4, c = n & 15; float v[8];
                if (k8 < 64) { const int s = k8 >> 1, c0 = (k8 & 1) * 8;
#pragma unroll
                    for (int i = 0; i < 8; ++i) v[i] = 0.f;
                    if (s <= t) { const float* kp = Ktab + ((size_t)((g * 2 + 0) * 32 + (t - s)) * 256 + c * 16 + c0); const f32x4 k0 = *(const f32x4*)kp, k1 = *(const f32x4*)(kp + 4);
                        v[0] += k0.x; v[1] += k0.y; v[2] += k0.z; v[3] += k0.w; v[4] += k1.x; v[5] += k1.y; v[6] += k1.z; v[7] += k1.w; }
                    if (s >= t) { const float* kp = Ktab + ((size_t)((g * 2 + 1) * 32 + (s - t)) * 256 + c * 16 + c0); const f32x4 k0 = *(const f32x4*)kp, k1 = *(const f32x4*)(kp + 4);
                        v[0] += k0.x; v[1] += k0.y; v[2] += k0.z; v[3] += k0.w; v[4] += k1.x; v[5] += k1.y; v[6] += k1.z; v[7] += k1.w; }
                    if (s == t) { const float dv = dskip[g * 16 + c];
#pragma unroll
                        for (int i = 0; i < 8; ++i) if (c0 + i == c) v[i] += dv; }
                } else { const int j = k8 - 64, part = j >> 3, p0 = (j & 7) * 8, dir = part >> 1, ex = dir == 0 ? t + 1 : 32 - t;
#pragma unroll
                    for (int i = 0; i < 8; ++i) { const int p = p0 + i; const size_t ci = ((size_t)(dir * 32 + g) * 16 + c) * 64 + p; const float cr = c_re[ci], cim = c_im[ci]; const f32x2 w = PW[((size_t)(g * 2 + dir) * 33 + ex) * 64 + p];
                        const float zr = cr * w.x - cim * w.y, zi = cr * w.y + cim * w.x; v[i] = (part & 1) ? -zi : zr; } }
                u32x4 o; o.x = cvt_pk_bf16(v[0], v[1]); o.y = cvt_pk_bf16(v[2], v[3]); o.z = cvt_pk_bf16(v[4], v[5]); o.w = cvt_pk_bf16(v[6], v[7]);
                *(u32x4*)(Bs5 + ((size_t)g * 512 + n) * KS5 + k8 * 8) = o; }
            for (int e = gt; e < 32 * 256 * 64; e += NT) { const int k8 = e & 63, n = (e >> 6) & 255, g = e >> 14, dir = n >> 7, reim = (n >> 6) & 1, p = n & 63, s = k8 >> 1, c0 = (k8 & 1) * 8, ex = dir == 0 ? 31 - s : s;
                const f32x2 w = PW[((size_t)(g * 2 + dir) * 33 + ex) * 64 + p]; float v[8];
#pragma unroll
                for (int i = 0; i < 8; ++i) { const f32x2 b = BB[((size_t)(g * 2 + dir) * 64 + p) * 16 + c0 + i]; v[i] = reim ? (w.x * b.y + w.y * b.x) : (w.x * b.x - w.y * b.y); }
                u32x4 o; o.x = cvt_pk_bf16(v[0], v[1]); o.y = cvt_pk_bf16(v[2], v[3]); o.z = cvt_pk_bf16(v[4], v[5]); o.w = cvt_pk_bf16(v[6], v[7]);
                *(u32x4*)(Wst + ((size_t)g * 256 + n) * 512 + k8 * 8) = o; }
        }
        for (int m = gw; m < MALL; m += NGW) { const int set = m < SEQ ? 0 : (m < ML ? 1 : 2); const float* src = m < ML ? xin_ + (size_t)m * D : ctx + (size_t)(m - ML) * D;
            norm_mod_row(src, norm_g, mod + set * NMODW + 0 * 1024, mod + set * NMODW + 1 * 1024, Hn + (size_t)m * D, lane); }
    }
    GSYNC();

    PH(2) { pg8::Gemm g{Hn, W13a, D, D, D, 0, 0}; pg8::StaticOrder S; S.init(MALL, 2 * FF, D, G, bid); EpiUp E{Ubuf}; pg8::gemm_phase(lds, g, S, E); }
    GSYNC();
    PH(3) { pg8::Gemm g{Ubuf, W2a, FF, FF, FF, 0, 0}; pg8::TailOrder S; S.init(ML, D, FF, G, bid, 88, 11, 0, 4); EpiRes E{xin_, out, Pc, mod + 2 * 1024, 0.5f}; pg8::gemm_phase(lds, g, S, E); }
    GSYNC();
    PH(4) {
        for (int m = gw; m < ML; m += NGW) { const int set = m < SEQ ? 0 : 1;
            norm_mod_row(out + (size_t)m * D, norm_g + 1024, mod + set * NMODW + 3 * 1024, mod + set * NMODW + 4 * 1024, Hn + (size_t)m * D, lane); }
        for (int m = gw; m < MC; m += NGW) {
            const f32x4* xr = (const f32x4*)(ctx + (size_t)m * D) + lane; f32x4 v[4]; float ss = 0.f;
#pragma unroll
            for (int j = 0; j < 4; ++j) { f32x4 p = {0.f, 0.f, 0.f, 0.f};
#pragma unroll
                for (int ks = 0; ks < 11; ++ks) p += ((const f32x4*)(Pc + (size_t)ks * MC * D + (size_t)m * D))[lane + 64 * j];
                v[j] = xr[64 * j] + (((const f32x4*)(mod + 2 * NMODW + 2 * 1024))[lane + 64 * j] * 0.5f) * p;
                ss += (v[j].x * v[j].x + v[j].y * v[j].y) + (v[j].z * v[j].z + v[j].w * v[j].w); }
            const float r = 1.0f / sqrtf(wave_sum(ss) * (1.f / D) + EPS);
            u32x2* o8 = (u32x2*)(Hn + (size_t)(ML + m) * D) + lane;
#pragma unroll
            for (int j = 0; j < 4; ++j) { const f32x4 gg = ((const f32x4*)(norm_g + 1024))[lane + 64 * j], sh = ((const f32x4*)(mod + 2 * NMODW + 3 * 1024))[lane + 64 * j], sc = ((const f32x4*)(mod + 2 * NMODW + 4 * 1024))[lane + 64 * j];
                const f32x4 y = (v[j] * r) * gg; const f32x4 h = y * (sc + 1.0f) + sh; u32x2 w; w.x = cvt_pk_bf16(h.x, h.y); w.y = cvt_pk_bf16(h.z, h.w); o8[64 * j] = w; }
        }
    }
    GSYNC();
    PH(5) { pg8::Gemm g{Hn, Win_t, D, D, D, 0, 0}; pg8::TailOrder S; S.init(ML, D, D, G, bid, 16, 4, 2, 2); EpiWin E{poolb, As5, Uctx}; pg8::gemm_phase(lds, g, S, E); }
    GSYNC();
    PH(6) {
        const int Gg = G < 64 ? G : 64;
        { pg8::Gemm g{As5, Wst, KS5, 512, 512, (size_t)ROWS5 * KS5, (size_t)256 * 512}; pg8::GroupOrder S; S.init(2, 1, 32, 512, Gg, bid); EpiState E{Sbuf}; pg8::gemm_phase(lds, g, S, E); }
        const int r1 = (bid + G - Gg % G) % G;
        for (int it = r1; it < 16; it += G) { const int wi = it * 8 + wave, b = wi >> 6, g = (wi >> 1) & 31, dir = wi & 1, g0 = (it & 7) * 4;
            LAS float* ul = (LAS float*)lds;
            __syncthreads();
#pragma unroll 2
            for (int i = 0; i < 8; ++i) { const int idx = i * 512 + tid, t = idx >> 4, q = idx & 15; const size_t off = (size_t)(b * CTXL + t) * 512 + g0 * 16 + q * 4;
                const f32x4 s4 = (*(const f32x4*)(Uctx + off) + *(const f32x4*)(Uctx + (size_t)MC * 512 + off)) + (*(const f32x4*)(Uctx + (size_t)2 * MC * 512 + off) + *(const f32x4*)(Uctx + (size_t)3 * MC * 512 + off));
                *(LAS f32x4*)(ul + t * 64 + q * 4) = s4; }
            const f32x2 av = PW[((size_t)(g * 2 + dir) * 33 + 1) * 64 + lane]; f32x2 bb[16];
#pragma unroll
            for (int i = 0; i < 16; ++i) bb[i] = BB[((size_t)(g * 2 + dir) * 64 + lane) * 16 + i];
            __syncthreads();
            float hr = 0.f, hi = 0.f; const int gl = (wave >> 1) * 16;
#pragma unroll 4
            for (int step = 0; step < CTXL; ++step) { const int t = dir == 0 ? step : CTXL - 1 - step; const LAS f32x4* up = (const LAS f32x4*)(ul + t * 64 + gl);
                const f32x4 u0 = up[0], u1 = up[1], u2 = up[2], u3 = up[3]; float sr = 0.f, si = 0.f;
#pragma unroll
                for (int i = 0; i < 4; ++i) { sr += bb[i].x * u0[i]; si += bb[i].y * u0[i]; }
#pragma unroll
                for (int i = 0; i < 4; ++i) { sr += bb[4 + i].x * u1[i]; si += bb[4 + i].y * u1[i]; }
#pragma unroll
                for (int i = 0; i < 4; ++i) { sr += bb[8 + i].x * u2[i]; si += bb[8 + i].y * u2[i]; }
#pragma unroll
                for (int i = 0; i < 4; ++i) { sr += bb[12 + i].x * u3[i]; si += bb[12 + i].y * u3[i]; }
                const float nr = av.x * hr - av.y * hi + sr, ni = av.x * hi + av.y * hr + si; hr = nr; hi = ni; }
            Hctx[(size_t)wi * 64 + lane] = (f32x2){hr, hi}; }
        const int r2 = (bid + 2 * G - (Gg + 16) % G) % G;
        LAS bf16_t* raw = (LAS bf16_t*)lds;
        LAS float* rowb = (LAS float*)(lds + 131072);
        for (int it = r2; it < 128; it += G) { const int b = it >> 6, k = (it >> 4) & 3, slab = it & 15;
            __syncthreads();
            const bf16_t* src = poolb + (size_t)it * 8192 * 8;
#pragma unroll 4
            for (int i = 0; i < 16; ++i) { const int tok = i * 512 + tid; *(LAS u32x4*)(raw + tok * 8) = *(const u32x4*)(src + (size_t)tok * 8); }
            __syncthreads();
            const int c = tid >> 3, ch = tid & 7, w = 2 << k, lo = w >> 1, hi = w - 1 - lo;
            const int clo = c - lo < 0 ? 0 : c - lo, chi = c + hi > 63 ? 63 : c + hi; const float icc = 1.0f / (float)(chi - clo + 1);
            float vs = 0.f;
            for (int r = 0; r <= hi; ++r) vs += bf2f(raw[(r * 64 + c) * 8 + ch]);
            for (int r = 0; r < 128; ++r) {
                const int rlo = r - lo < 0 ? 0 : r - lo, rhi = r + hi > 127 ? 127 : r + hi;
                LAS float* rb = rowb + (r & 1) * 512;
                rb[c * 8 + ch] = vs / (float)(rhi - rlo + 1);
                __syncthreads();
                float hs = 0.f;
                for (int c2 = clo; c2 <= chi; ++c2) hs += rb[c2 * 8 + ch];
                const float dval = hs * icc - bf2f(raw[(r * 64 + c) * 8 + ch]);
                const float d1 = __shfl_down(dval, 1); unsigned p01 = cvt_pk_bf16(dval, d1);
                const unsigned p23 = __shfl_down(p01, 2); const unsigned q0 = __shfl_down(p01, 4), q1 = __shfl_down(p23, 4);
                if (ch == 0) { u32x4 o; o.x = p01; o.y = p23; o.z = q0; o.w = q1; *(u32x4*)(mixcat + (size_t)(b * SEQ + r * 64 + c) * D + k * 128 + slab * 8) = o; }
                if (r + 1 + hi <= 127) vs += bf2f(raw[((r + 1 + hi) * 64 + c) * 8 + ch]);
                if (r - lo >= 0) vs -= bf2f(raw[((r - lo) * 64 + c) * 8 + ch]);
            }
        }
    }
    GSYNC();
    PH(7) for (int it = bid; it < 16; it += G) { const int wi = it * 8 + wave, b = wi >> 6, g = (wi >> 1) & 31, dir = wi & 1;
        const f32x2 a32 = PW[((size_t)(g * 2 + dir) * 33 + 32) * 64 + lane]; f32x2 h = Hctx[(size_t)wi * 64 + lane];
        const size_t rbase = (size_t)g * ROWS5 + b * 256;
        for (int s0 = 0; s0 < 256; s0 += 16) { float sre[16], sim[16];
#pragma unroll
            for (int i = 0; i < 16; ++i) { const int j = dir == 0 ? s0 + i : 255 - s0 - i; const float* sp = Sbuf + (rbase + j) * 256 + dir * 128 + lane; sre[i] = sp[0]; sim[i] = sp[64]; }
#pragma unroll
            for (int i = 0; i < 16; ++i) { const int j = dir == 0 ? s0 + i : 255 - s0 - i; bf16_t* hp = As5 + (rbase + j) * KS5 + 512 + dir * 128 + lane;
                hp[0] = (bf16_t)(cvt_pk_bf16(h.x, 0.f) & 0xffffu); hp[64] = (bf16_t)(cvt_pk_bf16(h.y, 0.f) & 0xffffu);
                const float nr = a32.x * h.x - a32.y * h.y + sre[i], ni = a32.x * h.y + a32.y * h.x + sim[i]; h.x = nr; h.y = ni; } }
    }
    GSYNC();
    PH(8) { pg8::Gemm g{As5, Bs5, KS5, KS5, KS5, (size_t)ROWS5 * KS5, (size_t)512 * KS5}; pg8::GroupOrder S; S.init(2, 2, 32, KS5, G, bid); EpiS5 E{Ybuf}; pg8::gemm_phase(lds, g, S, E); }
    GSYNC();
    PH(9) { pg8::Gemm g{Ybuf, Wglu_t, 512, 512, 512, 0, 0}; pg8::StaticOrder S; S.init(ML, 512, 512, G, bid); EpiGlu E{Ybuf, mixcat}; pg8::gemm_phase(lds, g, S, E); }
    GSYNC();
    PH(10) { pg8::Gemm g{mixcat, Wmix_t, D, D, D, 0, 0}; pg8::StaticOrder S; S.init(ML, D, D, G, bid); EpiRes E{out, out, Pc, mod + 5 * 1024, 1.0f}; pg8::gemm_phase(lds, g, S, E); }
    GSYNC();
    PH(11) for (int m = gw; m < ML; m += NGW) { const int set = m < SEQ ? 0 : 1;
        norm_mod_row(out + (size_t)m * D, norm_g + 2048, mod + set * NMODW + 6 * 1024, mod + set * NMODW + 7 * 1024, Hn + (size_t)m * D, lane); }
    GSYNC();
    PH(12) { pg8::Gemm g{Hn, W13b, D, D, D, 0, 0}; pg8::StaticOrder S; S.init(ML, 2 * FF, D, G, bid); EpiUp E{Ubuf}; pg8::gemm_phase(lds, g, S, E); }
    GSYNC();
    PH(13) { pg8::Gemm g{Ubuf, W2b, FF, FF, FF, 0, 0}; pg8::StaticOrder S; S.init(ML, D, FF, G, bid); EpiRes E{out, out, Pc, mod + 8 * 1024, 0.5f}; pg8::gemm_phase(lds, g, S, E); }
    GSYNC();
    for (int xs_ = 0; xs_ < XSYNC; ++xs_) GSYNC();
    PH(14) {
        const float* fg = a.in[23];
        for (int m = gw; m < ML; m += NGW) { f32x4* xr = (f32x4*)(out + (size_t)m * D) + lane; f32x4 v[4]; float s = 0.f;
#pragma unroll
            for (int j = 0; j < 4; ++j) { v[j] = xr[64 * j]; s += (v[j].x * v[j].x + v[j].y * v[j].y) + (v[j].z * v[j].z + v[j].w * v[j].w); }
            const float r = 1.0f / sqrtf(wave_sum(s) * (1.f / D) + EPS);
#pragma unroll
            for (int j = 0; j < 4; ++j) xr[64 * j] = (v[j] * r) * ((const f32x4*)fg)[lane + 64 * j]; }
    }
}

#undef ws
#undef xin_
#undef cvec
#undef ctx
#undef cctx
#undef norm_g
#undef w_ada
#undef b_ada
#undef mod
#undef Hctx
#undef Win_t
#undef Wmix_t
#undef Wglu_t
#undef BB
#undef Ktab
#undef PW
#undef W13a
#undef W2a
#undef W13b
#undef W2b
#undef Wst
#undef Bs5
#undef Hn
#undef mixcat
#undef X1c
#undef Uctx
#undef Pc
#undef Ubuf
#undef poolb
#undef As5
#undef Sbuf
#undef Ybuf
#undef out
extern "C" void kernel_launch(void* const* d_in, const int* in_sizes, int n_in, void* d_out, int out_size, void* d_ws, size_t ws_size, hipStream_t stream) {
    static int grid = 0;
    if (grid == 0) {
        if (n_in != 24 || out_size != ML * D || ws_size < WS_END) { fprintf(stderr, "kernel_launch: unexpected shapes (n_in %d out %d ws %zu)\n", n_in, out_size, ws_size); grid = -1; return; }
        int dev = 0, cus = 0, per_cu = 0;
        hipGetDevice(&dev); hipDeviceGetAttribute(&cus, hipDeviceAttributeMultiprocessorCount, dev);
        hipFuncSetAttribute((const void*)fwd_megakernel, hipFuncAttributeMaxDynamicSharedMemorySize, LDS_BYTES);
        if (hipOccupancyMaxActiveBlocksPerMultiprocessor(&per_cu, (const void*)fwd_megakernel, 512, LDS_BYTES) != hipSuccess || per_cu < 1) per_cu = 1;
        (void)hipGetLastError();
        grid = cus * 1;
        if (grid <= 0) grid = 256;
    }
    if (grid < 0) return;
    KArgs a{};
    for (int i = 0; i < 24; ++i) a.in[i] = (const float*)d_in[i];
    a.out = (float*)d_out; a.ws = (unsigned char*)d_ws;
    void* args[] = {&a};
    hipError_t e = hipLaunchCooperativeKernel((const void*)fwd_megakernel, dim3(grid), dim3(512), args, LDS_BYTES, stream);
    if (e != hipSuccess) fprintf(stderr, "cooperative launch failed: %s (grid %d)\n", hipGetErrorString(e), grid);
}
```

```cpp
#include <hip/hip_runtime.h>
#include <hip/hip_cooperative_groups.h>
#include <cstdio>
#include <cstdint>
namespace cg = cooperative_groups;

#define LAS __attribute__((address_space(3)))
typedef unsigned short bf16_t;
typedef short bf16x8 __attribute__((ext_vector_type(8)));
typedef float f32x4 __attribute__((ext_vector_type(4)));
typedef float f32x2 __attribute__((ext_vector_type(2)));
typedef unsigned u32x4 __attribute__((ext_vector_type(4)));
typedef unsigned u32x2 __attribute__((ext_vector_type(2)));

__device__ __forceinline__ unsigned cvt_pk_bf16(float lo, float hi) { unsigned r; asm volatile("v_cvt_pk_bf16_f32 %0, %1, %2" : "=v"(r) : "v"(lo), "v"(hi)); return r; }
__device__ __forceinline__ float bf_lo(unsigned w) { return __builtin_bit_cast(float, w << 16); }
__device__ __forceinline__ float bf_hi(unsigned w) { return __builtin_bit_cast(float, w & 0xffff0000u); }
__device__ __forceinline__ float bf2f(bf16_t h) { return __builtin_bit_cast(float, ((unsigned)h) << 16); }
__device__ __forceinline__ float sigmoid_fast(float x) { return __builtin_amdgcn_rcpf(1.f + __expf(-x)); }
__device__ __forceinline__ float silu_fast(float x) { return x * sigmoid_fast(x); }
__device__ __forceinline__ float gelu_tanh(float x) { const float z = 1.5957691216057308f * (x + 0.044715f * x * x * x); return x * sigmoid_fast(z); }

namespace pg8 {
constexpr int BM = 256, BK = 64, HALF = 128, HTB = HALF * BK * 2, STAGE_BYTES = 8 * HTB, NXCD = 8, WGM = 8;
__host__ __device__ __forceinline__ int lds_byte(int r, int c) { const int st = (r >> 4) * 2 + (c >> 5), rr = r & 15, cc = c & 31, ob = rr * 64 + cc * 2; return st * 1024 + (ob ^ (((ob >> 9) & 1) << 5)); }
__host__ __device__ __forceinline__ void stage_rc(int b, int& R, int& C) { const int st = b / 1024, sb = b % 1024, swz = sb ^ (((sb >> 9) & 1) << 5); R = (st >> 1) * 16 + swz / 64; C = (st & 1) * 32 + (swz % 64) / 2; }
__host__ __device__ __forceinline__ int perm32(int rho) { const int n = rho >> 4, i = rho & 15; return 8 * (i >> 2) + 4 * n + (i & 3); }

struct Unit { int pm, pn, g, k0, nt; };
struct Gemm { const bf16_t* A; const bf16_t* Bt; int lda, ldb, K; size_t gsA, gsB; };

struct StaticOrder {
    int nM, nN, nwg, G, c, ntf;
    __device__ void init(int M, int N, int K, int G_, int c_) { nM = M / BM; nN = N / BM; nwg = nM * nN; G = G_; c = c_; ntf = K / BK; }
    __device__ bool next(int i, Unit& u) const { const long L = (long)i * G + c; if (L >= nwg) return false; unit_of((int)L, u); return true; }
    __device__ void unit_of(int L, Unit& u) const {
        int wgid = L; { const int q = nwg / NXCD, r = nwg % NXCD, xcd = wgid % NXCD, off = wgid / NXCD; wgid = (xcd < r ? xcd * (q + 1) : r * (q + 1) + (xcd - r) * q) + off; }
        const int nig = WGM * nN, gid = wgid / nig, fm = gid * WGM, gsz = (nM - fm) < WGM ? (nM - fm) : WGM;
        u.pm = fm + ((wgid % nig) % gsz); u.pn = (wgid % nig) / gsz; u.g = 0; u.k0 = 0; u.nt = ntf;
    }
};
struct TailOrder {
    StaticOrder base; int nmini, nks, pn0, npn;
    __device__ void init(int M, int N, int K, int G_, int c_, int nmini_, int nks_, int pn0_, int npn_) { base.init(M, N, K, G_, c_); nmini = nmini_; nks = nks_; pn0 = pn0_; npn = npn_; }
    __device__ bool next(int i, Unit& u) const {
        const long L = (long)i * base.G + base.c; if (L < base.nwg) { base.unit_of((int)L, u); return true; }
        const int idx = (int)(L - base.nwg); if (idx >= nmini) return false;
        const int ks = idx % nks, t = idx / nks; u.pm = 64 + t / npn; u.pn = pn0 + t % npn; u.g = 0; u.k0 = ks * 256; u.nt = 4; return true;
    }
};
struct GroupOrder {
    int nM, nN, ng, G, c, ntf;
    __device__ void init(int nM_, int nN_, int ng_, int K, int G_, int c_) { nM = nM_; nN = nN_; ng = ng_; G = G_; c = c_; ntf = K / BK; }
    __device__ bool next(int i, Unit& u) const {
        if (c >= G) return false;
        const long L = (long)i * G + c; if (L >= (long)ng * nM * nN) return false;
        const int per = nM * nN, l = (int)L; u.g = l / per; const int r = l % per; u.pm = r / nN; u.pn = r % nN; u.k0 = 0; u.nt = ntf; return true;
    }
};

template <class Epi, class Sched>
__device__ __forceinline__ void gemm_phase(LAS unsigned char* lds, const Gemm g, const Sched& S, const Epi& E) {
    int tid_ = threadIdx.x; asm volatile("" : "+v"(tid_));
    const int tid = tid_, wid = __builtin_amdgcn_readfirstlane(tid >> 6), lane = tid & 63, wr = wid >> 2, wc = wid & 3, fr = lane & 15, fq = lane >> 4;
    unsigned voffA[2], voffB[2];
#pragma unroll
    for (int i = 0; i < 2; ++i) { int R, C; stage_rc(tid * 16 + i * 8192, R, C); const int Rb = Epi::PERM ? ((R & ~31) + perm32(R & 31)) : R;
        voffA[i] = (unsigned)(R * g.lda + C) * 2u; voffB[i] = (unsigned)(Rb * g.ldb + C) * 2u; }
    const size_t kstep = (size_t)(BK * 2);
    const size_t hstepA = (size_t)HALF * g.lda * 2, hstepB = (size_t)HALF * g.ldb * 2;
    const size_t tstepA = 2 * hstepA, tstepB = 2 * hstepB;
    const unsigned ldsw = (unsigned)wid * 1024u;
    const int aoff = lds_byte(wr * 64 + fr, fq * 8), boff = lds_byte(wc * 32 + fr, fq * 8);
#define PG8_SA(b, h) (((b) * 2 + (h)) * HTB)
#define PG8_SB(b, h) ((4 + (b) * 2 + (h)) * HTB)
#define PG8_STAGE(bufoff, gbase, voff) do { _Pragma("unroll") for (int _i = 0; _i < 2; ++_i) \
        __builtin_amdgcn_global_load_lds((const unsigned*)((const char*)(gbase) + (voff)[_i]), (LAS unsigned*)(lds + (bufoff) + ldsw + _i * 8192), 16, 0, 0); } while (0)
#define PG8_LDA(dst, b, h) do { _Pragma("unroll") for (int m = 0; m < 4; ++m) _Pragma("unroll") for (int k = 0; k < 2; ++k) dst[m][k] = *(const LAS bf16x8*)(lds + PG8_SA(b, h) + aoff + m * 2048 + k * 1024); } while (0)
#define PG8_LDB(dst, b, h) do { _Pragma("unroll") for (int n = 0; n < 2; ++n) _Pragma("unroll") for (int k = 0; k < 2; ++k) dst[n][k] = *(const LAS bf16x8*)(lds + PG8_SB(b, h) + boff + n * 2048 + k * 1024); } while (0)
#define PG8_MMA(ai, bj, At, Bt) do { __builtin_amdgcn_s_setprio(1); _Pragma("unroll") for (int m = 0; m < 4; ++m) _Pragma("unroll") for (int n = 0; n < 2; ++n) _Pragma("unroll") for (int k = 0; k < 2; ++k) \
        acc[ai][bj][m][n] = __builtin_amdgcn_mfma_f32_16x16x32_bf16(Bt[n][k], At[m][k], acc[ai][bj][m][n], 0, 0, 0); __builtin_amdgcn_s_setprio(0); } while (0)
#define PG8_WAIT_V(n) asm volatile("s_waitcnt vmcnt(" #n ")" ::: "memory")
#define PG8_WAIT_L(n) asm volatile("s_waitcnt lgkmcnt(" #n ")" ::: "memory")
#define PG8_BAR __builtin_amdgcn_s_barrier()
#define PG8_SCHED __builtin_amdgcn_sched_barrier(0)
    Unit cur, nxt; int ui = 0;
    if (!S.next(0, cur)) return;
    f32x4 acc[2][2][4][2];
#pragma unroll
    for (int a = 0; a < 2; ++a)
#pragma unroll
        for (int b = 0; b < 2; ++b)
#pragma unroll
            for (int m = 0; m < 4; ++m)
#pragma unroll
                for (int n = 0; n < 2; ++n) acc[a][b][m][n] = (f32x4){0.f, 0.f, 0.f, 0.f};
    bf16x8 At[4][2], B0[2][2], B1[2][2];
    const char* cA = (const char*)(g.A + (size_t)cur.g * g.gsA + cur.k0) + (size_t)cur.pm * tstepA; const char* cB = (const char*)(g.Bt + (size_t)cur.g * g.gsB + cur.k0) + (size_t)cur.pn * tstepB;
    PG8_STAGE(PG8_SB(0, 0), cB, voffB); PG8_STAGE(PG8_SB(0, 1), cB + hstepB, voffB); PG8_STAGE(PG8_SA(0, 0), cA, voffA); PG8_STAGE(PG8_SA(0, 1), cA + hstepA, voffA);
    if (wr == 1) PG8_BAR;
    PG8_WAIT_V(2); PG8_BAR;
    PG8_STAGE(PG8_SB(1, 0), cB + kstep, voffB); PG8_STAGE(PG8_SA(1, 0), cA + kstep, voffA); PG8_STAGE(PG8_SB(1, 1), cB + hstepB + kstep, voffB);
    PG8_WAIT_V(6); PG8_BAR;
    for (;;) {
        const bool has_next = S.next(ui + 1, nxt);
        const char* nA = has_next ? (const char*)(g.A + (size_t)nxt.g * g.gsA + nxt.k0) + (size_t)nxt.pm * tstepA : cA;
        const char* nB = has_next ? (const char*)(g.Bt + (size_t)nxt.g * g.gsB + nxt.k0) + (size_t)nxt.pn * tstepB : cB;
        const int nt = cur.nt;
        for (int t = 0; t < nt; t += 2) {
            const bool last = (t == nt - 2);
            const char* a1 = cA + (size_t)(t + 1) * kstep;
            const char* a2 = last ? nA : cA + (size_t)(t + 2) * kstep; const char* b2 = last ? nB : cB + (size_t)(t + 2) * kstep;
            const char* a3 = a2 + kstep; const char* b3 = b2 + kstep;
            PG8_LDB(B0, 0, 0); PG8_LDB(B1, 0, 1); PG8_SCHED; PG8_LDA(At, 0, 0); PG8_STAGE(PG8_SA(1, 1), a1 + hstepA, voffA);
            PG8_WAIT_V(8); PG8_WAIT_L(0); PG8_BAR; PG8_MMA(0, 0, At, B0); PG8_MMA(0, 1, At, B1); PG8_BAR; PG8_SCHED;
            PG8_LDA(At, 0, 1); PG8_STAGE(PG8_SB(0, 0), b2, voffB); PG8_STAGE(PG8_SB(0, 1), b2 + hstepB, voffB); PG8_STAGE(PG8_SA(0, 0), a2, voffA);
            PG8_WAIT_V(8); PG8_WAIT_L(0); PG8_BAR; PG8_MMA(1, 0, At, B0); PG8_MMA(1, 1, At, B1); PG8_BAR; PG8_SCHED;
            PG8_LDB(B0, 1, 0); PG8_LDB(B1, 1, 1); PG8_SCHED; PG8_LDA(At, 1, 0); PG8_STAGE(PG8_SA(0, 1), a2 + hstepA, voffA);
            PG8_WAIT_V(8); PG8_WAIT_L(0); PG8_BAR; PG8_MMA(0, 0, At, B0); PG8_MMA(0, 1, At, B1); PG8_BAR; PG8_SCHED;
            PG8_LDA(At, 1, 1); PG8_STAGE(PG8_SB(1, 0), b3, voffB); PG8_STAGE(PG8_SB(1, 1), b3 + hstepB, voffB); PG8_STAGE(PG8_SA(1, 0), a3, voffA);
            PG8_WAIT_V(8); PG8_WAIT_L(0); PG8_BAR; PG8_MMA(1, 0, At, B0); PG8_MMA(1, 1, At, B1); PG8_BAR; PG8_SCHED;
        }
        if (wr == 0) PG8_BAR;
        E(acc, cur, wr, wc, fr, fq);
        if (!has_next) break;
#pragma unroll
        for (int a = 0; a < 2; ++a)
#pragma unroll
            for (int b = 0; b < 2; ++b)
#pragma unroll
                for (int m = 0; m < 4; ++m)
#pragma unroll
                    for (int n = 0; n < 2; ++n) acc[a][b][m][n] = (f32x4){0.f, 0.f, 0.f, 0.f};
        cur = nxt; cA = nA; cB = nB; ++ui;
        if (wr == 1) PG8_BAR;
    }
    PG8_WAIT_V(0);
    PG8_BAR;
#undef PG8_SA
#undef PG8_SB
#undef PG8_STAGE
#undef PG8_LDA
#undef PG8_LDB
#undef PG8_MMA
#undef PG8_WAIT_V
#undef PG8_WAIT_L
#undef PG8_BAR
#undef PG8_SCHED
}
}

constexpr int D = 1024, SEQ = 8192, ML = 16384, CTXL = 256, MC = 512, MALL = ML + MC, FF = 2816, NMODW = 9 * 1024;
constexpr int TCH = 32, KS5 = 768, ROWS5 = 512;
constexpr float EPS = 1e-6f;
constexpr size_t MiB = 1u << 20;
constexpr size_t WS_MOD = 128 * 1024, WS_HCTX = 512 * 1024;
constexpr size_t WS_WIN = 1 * MiB, WS_WMIX = 3 * MiB, WS_WGLU = 5 * MiB, WS_BB = 5 * MiB + 512 * 1024, WS_KTAB = 6 * MiB, WS_PW = 8 * MiB;
constexpr size_t WS_W13A = 10 * MiB, WS_W2A = 21 * MiB, WS_W13B = 27 * MiB, WS_W2B = 38 * MiB, WS_WST = 44 * MiB, WS_BS5 = 52 * MiB;
constexpr size_t WS_HN = 76 * MiB, WS_MIX = 109 * MiB, WS_X1C = 141 * MiB, WS_UCTX = 143 * MiB, WS_UB = 144 * MiB;
constexpr size_t WS_POOL = 144 * MiB, WS_AS5 = 160 * MiB, WS_S = 184 * MiB, WS_Y = 200 * MiB, WS_UCTXP = 216 * MiB, WS_END = 236 * MiB;
constexpr size_t WS_PC = WS_MIX;
constexpr int LDS_BYTES = 147456;

struct KArgs { const float* in[24]; float* out; unsigned char* ws; };

struct EpiUp {
    static constexpr bool PERM = true;
    bf16_t* O;
    __device__ __forceinline__ void operator()(const f32x4 (&acc)[2][2][4][2], const pg8::Unit& u, int wr, int wc, int fr, int fq) const {
        const int row0 = u.pm * 256 + wr * 64 + fr, f0 = u.pn * 128 + wc * 16 + 4 * fq;
#pragma unroll
        for (int ai = 0; ai < 2; ++ai)
#pragma unroll
            for (int m = 0; m < 4; ++m) { bf16_t* rowp = O + (size_t)(row0 + ai * 128 + m * 16) * FF + f0;
#pragma unroll
                for (int bj = 0; bj < 2; ++bj) { const f32x4 a = acc[ai][bj][m][0], b = acc[ai][bj][m][1];
                    u32x2 w; w.x = cvt_pk_bf16(silu_fast(a[0]) * b[0], silu_fast(a[1]) * b[1]); w.y = cvt_pk_bf16(silu_fast(a[2]) * b[2], silu_fast(a[3]) * b[3]);
                    *(u32x2*)(rowp + bj * 64) = w; } }
    }
};
struct EpiRes {
    static constexpr bool PERM = false;
    const float* resid_l; float* out_l; float* part_c; const float* gate; float coef;
    __device__ __forceinline__ void operator()(const f32x4 (&acc)[2][2][4][2], const pg8::Unit& u, int wr, int wc, int fr, int fq) const {
        const int set = u.pm < 32 ? 0 : 1;
        const int row0 = u.pm * 256 + wr * 64 + fr, col0 = u.pn * 256 + wc * 32 + 4 * fq;
        if (u.pm >= 64) { float* pb = part_c + (size_t)(u.k0 >> 8) * MC * D;
#pragma unroll
            for (int ai = 0; ai < 2; ++ai)
#pragma unroll
                for (int m = 0; m < 4; ++m) { const size_t off = (size_t)(row0 - ML + ai * 128 + m * 16) * D + col0;
#pragma unroll
                    for (int bj = 0; bj < 2; ++bj)
#pragma unroll
                        for (int n = 0; n < 2; ++n) *(f32x4*)(pb + off + bj * 128 + n * 16) = acc[ai][bj][m][n]; }
            return; }
        const float* rb = resid_l; float* ob = out_l;
        f32x4 gv[2][2];
#pragma unroll
        for (int bj = 0; bj < 2; ++bj)
#pragma unroll
            for (int n = 0; n < 2; ++n) gv[bj][n] = *(const f32x4*)(gate + set * NMODW + col0 + bj * 128 + n * 16) * coef;
#pragma unroll
        for (int ai = 0; ai < 2; ++ai)
#pragma unroll
            for (int m = 0; m < 4; ++m) { const size_t off = (size_t)(row0 + ai * 128 + m * 16) * D + col0;
#pragma unroll
                for (int bj = 0; bj < 2; ++bj)
#pragma unroll
                    for (int n = 0; n < 2; ++n) { const f32x4 r = *(const f32x4*)(rb + off + bj * 128 + n * 16); *(f32x4*)(ob + off + bj * 128 + n * 16) = r + gv[bj][n] * acc[ai][bj][m][n]; }
                asm volatile("" ::: "memory"); }
    }
};
struct EpiWin {
    static constexpr bool PERM = true;
    bf16_t* pool; bf16_t* As5; float* Uctx;
    __device__ __forceinline__ void operator()(const f32x4 (&acc)[2][2][4][2], const pg8::Unit& u, int wr, int wc, int fr, int fq) const {
        const int row0 = u.pm * 256 + wr * 64 + fr;
        const bool isc = u.pm >= 64, ispool = u.pn < 2;
        if (isc && ispool) return;
#pragma unroll
        for (int ai = 0; ai < 2; ++ai)
#pragma unroll
            for (int m = 0; m < 4; ++m) { const int row = row0 + ai * 128 + m * 16;
#pragma unroll
                for (int bj = 0; bj < 2; ++bj) { const int col0 = u.pn * 256 + bj * 128 + wc * 32 + 8 * fq; const f32x4 v0 = acc[ai][bj][m][0], v1 = acc[ai][bj][m][1];
                    if (isc) { float* p = Uctx + (size_t)(u.k0 >> 8) * MC * 512 + (size_t)(row - ML) * 512 + (col0 - 512); *(f32x4*)p = v0; *(f32x4*)(p + 4) = v1; }
                    else { u32x4 w; w.x = cvt_pk_bf16(v0[0], v0[1]); w.y = cvt_pk_bf16(v0[2], v0[3]); w.z = cvt_pk_bf16(v1[0], v1[1]); w.w = cvt_pk_bf16(v1[2], v1[3]);
                        const int b = row >> 13, tok = row & 8191;
                        if (ispool) { const int k = col0 >> 7, slab = (col0 >> 3) & 15; *(u32x4*)(pool + ((size_t)((b * 4 + k) * 16 + slab) * 8192 + tok) * 8) = w; }
                        else { const int cs = col0 - 512, gg = cs >> 4, c0 = cs & 15; *(u32x4*)(As5 + ((size_t)gg * ROWS5 + b * 256 + (tok >> 5)) * KS5 + (tok & 31) * 16 + c0) = w; } } } }
    }
};
struct EpiState {
    static constexpr bool PERM = false;
    float* S;
    __device__ __forceinline__ void operator()(const f32x4 (&acc)[2][2][4][2], const pg8::Unit& u, int wr, int wc, int fr, int fq) const {
        const int row0 = u.pm * 256 + wr * 64 + fr, col0 = wc * 32 + 4 * fq;
#pragma unroll
        for (int ai = 0; ai < 2; ++ai)
#pragma unroll
            for (int m = 0; m < 4; ++m) { float* rowp = S + ((size_t)u.g * ROWS5 + row0 + ai * 128 + m * 16) * 256 + col0;
#pragma unroll
                for (int bj = 0; bj < 2; ++bj)
#pragma unroll
                    for (int n = 0; n < 2; ++n) *(f32x4*)(rowp + bj * 128 + n * 16) = acc[ai][bj][m][n]; }
    }
};
struct EpiS5 {
    static constexpr bool PERM = true;
    bf16_t* Y;
    __device__ __forceinline__ void operator()(const f32x4 (&acc)[2][2][4][2], const pg8::Unit& u, int wr, int wc, int fr, int fq) const {
        const int row0 = u.pm * 256 + wr * 64 + fr;
#pragma unroll
        for (int ai = 0; ai < 2; ++ai)
#pragma unroll
            for (int m = 0; m < 4; ++m) { const int row = row0 + ai * 128 + m * 16, b = row >> 8, chunk = row & 255;
#pragma unroll
                for (int bj = 0; bj < 2; ++bj) { const int n0 = u.pn * 256 + bj * 128 + wc * 32 + 8 * fq, t = n0 >> 4, c0 = n0 & 15; const f32x4 v0 = acc[ai][bj][m][0], v1 = acc[ai][bj][m][1];
                    u32x4 w; w.x = cvt_pk_bf16(gelu_tanh(v0[0]), gelu_tanh(v0[1])); w.y = cvt_pk_bf16(gelu_tanh(v0[2]), gelu_tanh(v0[3]));
                    w.z = cvt_pk_bf16(gelu_tanh(v1[0]), gelu_tanh(v1[1])); w.w = cvt_pk_bf16(gelu_tanh(v1[2]), gelu_tanh(v1[3]));
                    *(u32x4*)(Y + (size_t)(b * SEQ + chunk * TCH + t) * 512 + u.g * 16 + c0) = w; } }
    }
};
struct EpiGlu {
    static constexpr bool PERM = true;
    const bf16_t* Y; bf16_t* mix;
    __device__ __forceinline__ void operator()(const f32x4 (&acc)[2][2][4][2], const pg8::Unit& u, int wr, int wc, int fr, int fq) const {
        const int row0 = u.pm * 256 + wr * 64 + fr;
#pragma unroll
        for (int ai = 0; ai < 2; ++ai)
#pragma unroll
            for (int m = 0; m < 4; ++m) { const int row = row0 + ai * 128 + m * 16;
#pragma unroll
                for (int bj = 0; bj < 2; ++bj) { const int col0 = u.pn * 256 + bj * 128 + wc * 32 + 8 * fq; const f32x4 v0 = acc[ai][bj][m][0], v1 = acc[ai][bj][m][1];
                    const u32x4 y = *(const u32x4*)(Y + (size_t)row * 512 + col0); u32x4 w;
                    w.x = cvt_pk_bf16(bf_lo(y.x) * sigmoid_fast(v0[0]), bf_hi(y.x) * sigmoid_fast(v0[1])); w.y = cvt_pk_bf16(bf_lo(y.y) * sigmoid_fast(v0[2]), bf_hi(y.y) * sigmoid_fast(v0[3]));
                    w.z = cvt_pk_bf16(bf_lo(y.z) * sigmoid_fast(v1[0]), bf_hi(y.z) * sigmoid_fast(v1[1])); w.w = cvt_pk_bf16(bf_lo(y.w) * sigmoid_fast(v1[2]), bf_hi(y.w) * sigmoid_fast(v1[3]));
                    *(u32x4*)(mix + (size_t)row * D + 512 + col0) = w; } }
    }
};

__device__ __forceinline__ float wave_sum(float v) {
#pragma unroll
    for (int o = 1; o < 64; o <<= 1) v += __shfl_xor(v, o);
    return v;
}
__device__ __forceinline__ void transpose_item(const float* W, int ldw, bf16_t* WT, int ldd, int mode, LAS float* scr, int kb, int nb, int lane) {
    const int k0 = 64 * kb, n0 = 32 * nb;
#pragma unroll 8
    for (int i = 0; i < 32; ++i) { const int kk = 2 * i + (lane >> 5); scr[kk * 33 + (lane & 31)] = W[(size_t)(k0 + kk) * ldw + n0 + (lane & 31)]; }
    asm volatile("s_waitcnt lgkmcnt(0)" ::: "memory");
    const int c = lane & 7;
#pragma unroll
    for (int j = 0; j < 4; ++j) { const int n = (lane >> 3) + 8 * j, ncol = n0 + n; const LAS float* s = scr + (8 * c) * 33 + n;
        const int row = mode == 0 ? ncol : (8 * (ncol >> 2) + (ncol & 3) + (mode == 2 ? 4 : 0));
        u32x4 o; o.x = cvt_pk_bf16(s[0 * 33], s[1 * 33]); o.y = cvt_pk_bf16(s[2 * 33], s[3 * 33]); o.z = cvt_pk_bf16(s[4 * 33], s[5 * 33]); o.w = cvt_pk_bf16(s[6 * 33], s[7 * 33]);
        *(u32x4*)(WT + (size_t)row * ldd + k0 + 8 * c) = o; }
    asm volatile("s_waitcnt lgkmcnt(0)" ::: "memory");
}
__device__ __forceinline__ void norm_mod_row(const float* xrow, const float* g, const float* shift, const float* scale, bf16_t* orow, int lane) {
    const f32x4* xr = (const f32x4*)xrow + lane; f32x4 v[4]; float s = 0.f;
#pragma unroll
    for (int j = 0; j < 4; ++j) { v[j] = xr[64 * j]; s += (v[j].x * v[j].x + v[j].y * v[j].y) + (v[j].z * v[j].z + v[j].w * v[j].w); }
    const float r = 1.0f / sqrtf(wave_sum(s) * (1.f / D) + EPS);
    u32x2* o8 = (u32x2*)orow + lane;
#pragma unroll
    for (int j = 0; j < 4; ++j) { const f32x4 gg = ((const f32x4*)g)[lane + 64 * j], sh = ((const f32x4*)shift)[lane + 64 * j], sc = ((const f32x4*)scale)[lane + 64 * j];
        const f32x4 y = (v[j] * r) * gg; const f32x4 h = y * (sc + 1.0f) + sh; u32x2 w; w.x = cvt_pk_bf16(h.x, h.y); w.y = cvt_pk_bf16(h.z, h.w); o8[64 * j] = w; }
}


#define XB_TMO      128
#define XB_XCNT(j)  (256  + 64 * (j))
#define XB_XSUB(j)  (1280 + 64 * (j))
#define XB_XGEN(j)  (2304 + 64 * (j))
#define XB_TOP      3328
#define XB_TOPGEN   3392
#define XCD_BAR_WORDS 3456
#define XB_SPIN_CAP (1u << 22)
__device__ __forceinline__ unsigned xb_ld(unsigned* p)              { return __hip_atomic_load(p, __ATOMIC_RELAXED, __HIP_MEMORY_SCOPE_AGENT); }
__device__ __forceinline__ unsigned xb_add(unsigned* p, unsigned v) { return __hip_atomic_fetch_add(p, v, __ATOMIC_RELAXED, __HIP_MEMORY_SCOPE_AGENT); }
__device__ __forceinline__ unsigned xb_xcc_id() { return (unsigned)__builtin_amdgcn_s_getreg((3 << 11) | 20) & 0xFu; }
#define XB_SPIN(cond, bar) do { unsigned _sp = 0; while (cond) { __builtin_amdgcn_s_sleep(1); \
    if ((++_sp & 255u) == 0u) { if (xb_ld(&(bar)[XB_TMO])) break; if (_sp > XB_SPIN_CAP) { atomicAdd(&(bar)[XB_TMO], 1u); break; } } } } while (0)
struct XcdBarrier { unsigned* bar; unsigned x; volatile LAS unsigned* st; };
__device__ __forceinline__ XcdBarrier xcd_barrier_post(unsigned* bar, volatile LAS unsigned* st) {
    XcdBarrier b; b.bar = bar; b.x = xb_xcc_id(); b.st = st;
    if (threadIdx.x == 0) (void)xb_add(&bar[XB_XCNT(b.x)], 1u);
    return b;
}
__device__ __forceinline__ void xcd_barrier_complete(unsigned* bar, unsigned x, unsigned& nloc, unsigned& nx) {
    const unsigned G = gridDim.x * gridDim.y * gridDim.z;
    unsigned sum, cnt, mine, sp = 0u;
    for (;;) {
        sum = 0u; cnt = 0u; mine = 0u;
#pragma unroll
        for (unsigned j = 0; j < 16; ++j) { const unsigned c = xb_ld(&bar[XB_XCNT(j)]); sum += c; cnt += (c > 0u) ? 1u : 0u; mine = (j == x) ? c : mine; }
        if (sum == G) break;
        __builtin_amdgcn_s_sleep(1);
        if ((++sp & 255u) == 0u) { if (xb_ld(&bar[XB_TMO])) break; if (sp > XB_SPIN_CAP) { atomicAdd(&bar[XB_TMO], 1u); break; } }
    }
    nloc = mine > 0u ? mine : 1u; nx = cnt > 0u ? cnt : 1u;
}
__device__ __forceinline__ void xcd_barrier(const XcdBarrier& b) {
    asm volatile("s_waitcnt vmcnt(0)" ::: "memory");
    __syncthreads();
    if (threadIdx.x == 0) {
        unsigned* bar = b.bar;
        __builtin_amdgcn_s_waitcnt(0);
        unsigned nloc = b.st[0], nx = b.st[1];
        if (nloc == 0u) { xcd_barrier_complete(bar, b.x, nloc, nx); b.st[0] = nloc; b.st[1] = nx; }
        const unsigned old = xb_add(&bar[XB_XSUB(b.x)], 1u);
        const unsigned gen = old / nloc;
        if (old + 1u == (gen + 1u) * nloc) {
            __builtin_amdgcn_fence(__ATOMIC_RELEASE, "agent");
            asm volatile("s_waitcnt vmcnt(0)" ::: "memory");
            const unsigned og = xb_add(&bar[XB_TOP], 1u);
            const unsigned tg = og / nx;
            if (og + 1u == (tg + 1u) * nx) xb_add(&bar[XB_TOPGEN], 1u);
            else XB_SPIN(xb_ld(&bar[XB_TOPGEN]) == tg, bar);
            __builtin_amdgcn_fence(__ATOMIC_ACQUIRE, "agent");
            xb_add(&bar[XB_XGEN(b.x)], 1u);
            asm volatile("s_waitcnt vmcnt(0)" ::: "memory");
        } else {
            XB_SPIN(xb_ld(&bar[XB_XGEN(b.x)]) == gen, bar);
            __builtin_amdgcn_fence(__ATOMIC_ACQUIRE, "agent");
            asm volatile("s_waitcnt vmcnt(0)" ::: "memory");
        }
    }
    __syncthreads();
}
#ifndef PHMASK
#define PHMASK 0xFFFFF
#endif
#ifndef REPMASK
#define REPMASK 0
#endif
#ifndef XSYNC
#define XSYNC 0
#endif
#define PH(k) for (int rep_ = 0; rep_ < 1 + (((REPMASK) >> (k)) & 1); ++rep_) if constexpr (((PHMASK) >> (k)) & 1)

template <int W>
__device__ __forceinline__ void pool_rows(LAS bf16_t* raw, LAS float* rowb, LAS bf16_t* ob, bf16_t* dst  , int tid) {
    constexpr int lo = W / 2, hi = W - 1 - lo;
    const int c = tid >> 3, ch = tid & 7;
    const int clo = c - lo < 0 ? 0 : c - lo, chi = c + hi > 63 ? 63 : c + hi; const float icc = 1.0f / (float)(chi - clo + 1);
    float vs = 0.f;
#pragma unroll
    for (int r = 0; r <= hi; ++r) vs += bf2f(raw[(r * 64 + c) * 8 + ch]);
#pragma unroll 1
    for (int r = 0; r < 128; ++r) {
        const int rlo = r - lo < 0 ? 0 : r - lo, rhi = r + hi > 127 ? 127 : r + hi;
        LAS float* rb = rowb + (r & 1) * 512;
        rb[c * 8 + ch] = vs * __builtin_amdgcn_rcpf((float)(rhi - rlo + 1));
        __syncthreads();
        float hv[W];
#pragma unroll
        for (int i = 0; i < W; ++i) { int c2 = c - lo + i; c2 = c2 < 0 ? 0 : (c2 > 63 ? 63 : c2); hv[i] = rb[c2 * 8 + ch]; }
        float hs = 0.f;
#pragma unroll
        for (int i = 0; i < W; ++i) { const int c2 = c - lo + i; hs += (c2 >= 0 && c2 <= 63) ? hv[i] : 0.f; }
        const float dval = hs * icc - bf2f(raw[(r * 64 + c) * 8 + ch]);
        ob[(r & 1) * 512 + tid] = (bf16_t)(cvt_pk_bf16(dval, 0.f) & 0xffffu);
        if (r > 0 && tid < 64) *(u32x4*)(dst + (size_t)((r - 1) * 64 + tid) * D) = *(const LAS u32x4*)(ob + ((r - 1) & 1) * 512 + tid * 8);
        if (r + 1 + hi <= 127) vs += bf2f(raw[((r + 1 + hi) * 64 + c) * 8 + ch]);
        if (r - lo >= 0) vs -= bf2f(raw[((r - lo) * 64 + c) * 8 + ch]);
    }
    __syncthreads();
    if (tid < 64) *(u32x4*)(dst + (size_t)(127 * 64 + tid) * D) = *(const LAS u32x4*)(ob + 512 + tid * 8);
}
__global__ void __launch_bounds__(512, 2) fwd_megakernel(KArgs a) {
    extern __shared__ __attribute__((aligned(16))) unsigned char lds_raw[];
    LAS unsigned char* lds = (LAS unsigned char*)lds_raw;
    cg::grid_group grid = cg::this_grid();
    const int tid = threadIdx.x, lane = tid & 63, wave = __builtin_amdgcn_readfirstlane(tid >> 6);
    const int G = gridDim.x, bid = blockIdx.x;
    const int gw = bid * 8 + wave, NGW = G * 8;
    volatile LAS unsigned* bst = (volatile LAS unsigned*)(lds + LDS_BYTES - 64);
    if (tid == 0) { bst[0] = 0u; bst[1] = 0u; }
    __syncthreads();
    if (bid == 0) for (int i = tid; i < XCD_BAR_WORDS; i += 512) ((unsigned*)a.ws)[i] = 0u;
#define GSYNC() xcd_barrier(xbar)
#define ws (a.ws)
#define xin_ (a.in[0])
#define cvec (a.in[1])
#define ctx (a.in[2])
#define cctx (a.in[3])
#define norm_g (a.in[4])
#define w_ada (a.in[5])
#define b_ada (a.in[6])
#define mod ((float*)(ws + WS_MOD))
#define Hctx ((f32x2*)(ws + WS_HCTX))
#define Win_t ((bf16_t*)(ws + WS_WIN))
#define Wmix_t ((bf16_t*)(ws + WS_WMIX))
#define Wglu_t ((bf16_t*)(ws + WS_WGLU))
#define BB ((f32x2*)(ws + WS_BB))
#define Ktab ((float*)(ws + WS_KTAB))
#define PW ((f32x2*)(ws + WS_PW))
#define W13a ((bf16_t*)(ws + WS_W13A))
#define W2a ((bf16_t*)(ws + WS_W2A))
#define W13b ((bf16_t*)(ws + WS_W13B))
#define W2b ((bf16_t*)(ws + WS_W2B))
#define Wst ((bf16_t*)(ws + WS_WST))
#define Bs5 ((bf16_t*)(ws + WS_BS5))
#define Hn ((bf16_t*)(ws + WS_HN))
#define mixcat ((bf16_t*)(ws + WS_MIX))
#define X1c ((float*)(ws + WS_X1C))
#define Uctx ((float*)(ws + WS_UCTXP))
#define Pc ((float*)(ws + WS_PC))
#define Ubuf ((bf16_t*)(ws + WS_UB))
#define poolb ((bf16_t*)(ws + WS_POOL))
#define As5 ((bf16_t*)(ws + WS_AS5))
#define Sbuf ((float*)(ws + WS_S))
#define Ybuf ((bf16_t*)(ws + WS_Y))
#define out (a.out)

    PH(0) {
        LAS float* sc = (LAS float*)lds;
        LAS float* red = (LAS float*)(lds + 16384);
        for (int i = tid; i < 3072; i += 512) { const float v = i < 2048 ? cvec[i] : cctx[i - 2048]; sc[i] = v / (1.f + expf(-v)); }
        __syncthreads();
        for (int strip = bid; strip < 288; strip += G) {
            const int cg4 = tid & 7, kk = tid >> 3;
            f32x4 a0 = {0.f, 0.f, 0.f, 0.f}, a1 = a0, a2 = a0;
#pragma unroll 4
            for (int it = 0; it < 16; ++it) { const int k = kk + 64 * it; const f32x4 w = *(const f32x4*)(w_ada + (size_t)k * NMODW + strip * 32 + cg4 * 4);
                a0 += w * sc[k]; a1 += w * sc[1024 + k]; a2 += w * sc[2048 + k]; }
#pragma unroll
            for (int i = 0; i < 4; ++i) { red[kk * 100 + cg4 * 4 + i] = a0[i]; red[kk * 100 + 32 + cg4 * 4 + i] = a1[i]; red[kk * 100 + 64 + cg4 * 4 + i] = a2[i]; }
            __syncthreads();
            if (tid < 96) { float s = 0.f;
#pragma unroll 8
                for (int k2 = 0; k2 < 64; ++k2) s += red[k2 * 100 + tid]; const int r = tid >> 5, col = strip * 32 + (tid & 31); mod[r * NMODW + col] = s + b_ada[col]; }
            __syncthreads();
        }
        LAS f32x2* pwL = (LAS f32x2*)(lds + 65536);
        LAS f32x2* bbL = (LAS f32x2*)(lds + 65536 + 17408);
        LAS f32x2* cL = (LAS f32x2*)(lds + 65536 + 17408 + 8192);
        const float* a_re = a.in[13]; const float* a_im = a.in[14]; const float* log_dt = a.in[15]; const float* b_re = a.in[16]; const float* b_im = a.in[17];
        const float* c_re = a.in[18]; const float* c_im = a.in[19];
#pragma unroll 1
        for (int it2 = G - 1 - bid; it2 < 256; it2 += G) {
            const int it = it2 >> 2, qq = it2 & 3; const bool wr_tab = qq == 0;
            const int g = it >> 1, dir = it & 1, pd = dir * 32 + g;
            const float dt = expf(log_dt[pd]);
            for (int idx = tid; idx < 33 * 64; idx += 512) { const int tau = idx >> 6, p = idx & 63; const float are = a_re[pd * 64 + p], aim = a_im[pd * 64 + p];
                const float mag = expf(are * dt * (float)tau); double ang = (double)aim * (double)dt * (double)tau; ang -= 6.283185307179586 * rint(ang * 0.15915494309189535);
                float sn, cs; sincosf((float)ang, &sn, &cs); const f32x2 v = {mag * cs, mag * sn}; pwL[idx] = v; if (wr_tab) PW[(size_t)it * 33 * 64 + idx] = v; }
            for (int idx = tid; idx < 1024; idx += 512) { const f32x2 v = {c_re[(size_t)pd * 1024 + idx], c_im[(size_t)pd * 1024 + idx]}; cL[idx] = v; }
            __syncthreads();
            for (int idx = tid; idx < 1024; idx += 512) { const int p = idx >> 4; const float are = a_re[pd * 64 + p], aim = a_im[pd * 64 + p]; const float zr = are * dt, zi = aim * dt;
                float qr, qi;
                if (zr * zr + zi * zi < 0.25f) { float tr = 1.f, ti = 0.f;
                    for (int k = 12; k >= 2; --k) { const float ik = 1.0f / (float)k, wr_ = zr * ik, wi_ = zi * ik; const float nr = 1.f + (wr_ * tr - wi_ * ti), ni = wr_ * ti + wi_ * tr; tr = nr; ti = ni; }
                    qr = dt * tr; qi = dt * ti; }
                else { const f32x2 ab = pwL[64 + p]; const float nr = ab.x - 1.f, ni = ab.y, den = are * are + aim * aim; qr = (nr * are + ni * aim) / den; qi = (ni * are - nr * aim) / den; }
                const float br = b_re[(size_t)g * 1024 + idx], bi = b_im[(size_t)g * 1024 + idx];
                const f32x2 v = {qr * br - qi * bi, qr * bi + qi * br}; bbL[idx] = v; if (wr_tab) BB[(size_t)it * 1024 + idx] = v; }
            __syncthreads();
#pragma unroll 1
            for (int j = 0; j < 4; ++j) { const int idx = qq * 2048 + tid + 512 * j, tau = idx >> 8, c = (idx >> 4) & 15, cc = idx & 15; float s = 0.f;
#pragma unroll 8
                for (int p = 0; p < 64; ++p) { const f32x2 C = cL[c * 64 + p], w = pwL[tau * 64 + p], b = bbL[p * 16 + cc]; const float zr = C.x * w.x - C.y * w.y, zi = C.x * w.y + C.y * w.x; s += zr * b.x - zi * b.y; }
                Ktab[(size_t)it * 8192 + idx] = s; }
            __syncthreads();
        }
    }
    grid.sync();
    const XcdBarrier xbar = xcd_barrier_post((unsigned*)ws, bst);

    PH(1) {
        LAS float* scr = (LAS float*)(lds + wave * 16384);
        constexpr int I_UP = 16 * 88, I_DN = 44 * 32, I_IN = 16 * 32, I_OUT = 8 * 32, I_GLU = 8 * 16;
        constexpr int NITEMS = 4 * I_UP + 2 * I_DN + I_IN + I_OUT + I_GLU;
        for (int it = gw; it < NITEMS; it += NGW) {
            int r = it;
            if (r < I_UP) { transpose_item(a.in[7], FF, W13a, D, 1, scr, r / 88, r % 88, lane); continue; } r -= I_UP;
            if (r < I_UP) { transpose_item(a.in[8], FF, W13a, D, 2, scr, r / 88, r % 88, lane); continue; } r -= I_UP;
            if (r < I_DN) { transpose_item(a.in[9], D, W2a, FF, 0, scr, r / 32, r % 32, lane); continue; } r -= I_DN;
            if (r < I_UP) { transpose_item(a.in[7] + (size_t)D * FF, FF, W13b, D, 1, scr, r / 88, r % 88, lane); continue; } r -= I_UP;
            if (r < I_UP) { transpose_item(a.in[8] + (size_t)D * FF, FF, W13b, D, 2, scr, r / 88, r % 88, lane); continue; } r -= I_UP;
            if (r < I_DN) { transpose_item(a.in[9] + (size_t)D * FF, D, W2b, FF, 0, scr, r / 32, r % 32, lane); continue; } r -= I_DN;
            if (r < I_IN) { transpose_item(a.in[10], D, Win_t, D, 0, scr, r / 32, r % 32, lane); continue; } r -= I_IN;
            if (r < I_OUT) { transpose_item(a.in[22] + (size_t)512 * D, D, Wmix_t + 512, D, 0, scr, r / 32, r % 32, lane); continue; } r -= I_OUT;
            transpose_item(a.in[21], 512, Wglu_t, 512, 0, scr, r / 16, r % 16, lane);
        }
        {
            const float* pool_w = a.in[11]; const float* pool_scale = a.in[12]; const float* w_out = a.in[22];
            for (int it = G - 1 - bid; it < 64; it += G) { const int k = it >> 4, cb = it & 15;
                f32x2 ac[8];
#pragma unroll
                for (int i = 0; i < 8; ++i) ac[i] = (f32x2){0.f, 0.f};
                for (int d = 0; d < 128; ++d) { const f32x2 wo = *(const f32x2*)(w_out + (size_t)(k * 128 + d) * D + 2 * tid) * pool_scale[k * 128 + d];
#pragma unroll
                    for (int i = 0; i < 8; ++i) ac[i] += wo * pool_w[(size_t)(k * 128 + cb * 8 + i) * 128 + d]; }
                u32x4 w0, w1; w0.x = cvt_pk_bf16(ac[0].x, ac[1].x); w0.y = cvt_pk_bf16(ac[2].x, ac[3].x); w0.z = cvt_pk_bf16(ac[4].x, ac[5].x); w0.w = cvt_pk_bf16(ac[6].x, ac[7].x);
                w1.x = cvt_pk_bf16(ac[0].y, ac[1].y); w1.y = cvt_pk_bf16(ac[2].y, ac[3].y); w1.z = cvt_pk_bf16(ac[4].y, ac[5].y); w1.w = cvt_pk_bf16(ac[6].y, ac[7].y);
                *(u32x4*)(Wmix_t + (size_t)(2 * tid) * D + k * 128 + cb * 8) = w0; *(u32x4*)(Wmix_t + (size_t)(2 * tid + 1) * D + k * 128 + cb * 8) = w1; }
        }
        {
            const float* c_re = a.in[18]; const float* c_im = a.in[19]; const float* dskip = a.in[20];
            const int gt = bid * 512 + tid, NT = G * 512;
            for (int e = gt; e < 32 * 512 * 96; e += NT) { const int k8 = e % 96, n = (e / 96) & 511, g = e / (96 * 512), t = n >> 4, c = n & 15; float v[8];
                if (k8 < 64) { const int s = k8 >> 1, c0 = (k8 & 1) * 8;
#pragma unroll
                    for (int i = 0; i < 8; ++i) v[i] = 0.f;
                    if (s <= t) { const float* kp = Ktab + ((size_t)((g * 2 + 0) * 32 + (t - s)) * 256 + c * 16 + c0); const f32x4 k0 = *(const f32x4*)kp, k1 = *(const f32x4*)(kp + 4);
                        v[0] += k0.x; v[1] += k0.y; v[2] += k0.z; v[3] += k0.w; v[4] += k1.x; v[5] += k1.y; v[6] += k1.z; v[7] += k1.w; }
                    if (s >= t) { const float* kp = Ktab + ((size_t)((g * 2 + 1) * 32 + (s - t)) * 256 + c * 16 + c0); const f32x4 k0 = *(const f32x4*)kp, k1 = *(const f32x4*)(kp + 4);
                        v[0] += k0.x; v[1] += k0.y; v[2] += k0.z; v[3] += k0.w; v[4] += k1.x; v[5] += k1.y; v[6] += k1.z; v[7] += k1.w; }
                    if (s == t) { const float dv = dskip[g * 16 + c];
#pragma unroll
                        for (int i = 0; i < 8; ++i) if (c0 + i == c) v[i] += dv; }
                } else { const int j = k8 - 64, part = j >> 3, p0 = (j & 7) * 8, dir = part >> 1, ex = dir == 0 ? t + 1 : 32 - t;
#pragma unroll
                    for (int i = 0; i < 8; ++i) { const int p = p0 + i; const size_t ci = ((size_t)(dir * 32 + g) * 16 + c) * 64 + p; const float cr = c_re[ci], cim = c_im[ci]; const f32x2 w = PW[((size_t)(g * 2 + dir) * 33 + ex) * 64 + p];
                        const float zr = cr * w.x - cim * w.y, zi = cr * w.y + cim * w.x; v[i] = (part & 1) ? -zi : zr; } }
                u32x4 o; o.x = cvt_pk_bf16(v[0], v[1]); o.y = cvt_pk_bf16(v[2], v[3]); o.z = cvt_pk_bf16(v[4], v[5]); o.w = cvt_pk_bf16(v[6], v[7]);
                *(u32x4*)(Bs5 + ((size_t)g * 512 + n) * KS5 + k8 * 8) = o; }
            for (int e = gt; e < 32 * 256 * 64; e += NT) { const int k8 = e & 63, n = (e >> 6) & 255, g = e >> 14, dir = n >> 7, reim = (n >> 6) & 1, p = n & 63, s = k8 >> 1, c0 = (k8 & 1) * 8, ex = dir == 0 ? 31 - s : s;
                const f32x2 w = PW[((size_t)(g * 2 + dir) * 33 + ex) * 64 + p]; float v[8];
#pragma unroll
                for (int i = 0; i < 8; ++i) { const f32x2 b = BB[((size_t)(g * 2 + dir) * 64 + p) * 16 + c0 + i]; v[i] = reim ? (w.x * b.y + w.y * b.x) : (w.x * b.x - w.y * b.y); }
                u32x4 o; o.x = cvt_pk_bf16(v[0], v[1]); o.y = cvt_pk_bf16(v[2], v[3]); o.z = cvt_pk_bf16(v[4], v[5]); o.w = cvt_pk_bf16(v[6], v[7]);
                *(u32x4*)(Wst + ((size_t)g * 256 + n) * 512 + k8 * 8) = o; }
        }
        for (int m = gw; m < MALL; m += NGW) { const int set = m < SEQ ? 0 : (m < ML ? 1 : 2); const float* src = m < ML ? xin_ + (size_t)m * D : ctx + (size_t)(m - ML) * D;
            norm_mod_row(src, norm_g, mod + set * NMODW + 0 * 1024, mod + set * NMODW + 1 * 1024, Hn + (size_t)m * D, lane); }
    }
    GSYNC();

    PH(2) { pg8::Gemm g{Hn, W13a, D, D, D, 0, 0}; pg8::StaticOrder S; S.init(MALL, 2 * FF, D, G, bid); EpiUp E{Ubuf}; pg8::gemm_phase(lds, g, S, E); }
    GSYNC();
    PH(3) { pg8::Gemm g{Ubuf, W2a, FF, FF, FF, 0, 0}; pg8::TailOrder S; S.init(ML, D, FF, G, bid, 88, 11, 0, 4); EpiRes E{xin_, out, Pc, mod + 2 * 1024, 0.5f}; pg8::gemm_phase(lds, g, S, E); }
    GSYNC();
    PH(4) {
        for (int m = gw; m < ML; m += NGW) { const int set = m < SEQ ? 0 : 1;
            norm_mod_row(out + (size_t)m * D, norm_g + 1024, mod + set * NMODW + 3 * 1024, mod + set * NMODW + 4 * 1024, Hn + (size_t)m * D, lane); }
        for (int m = gw; m < MC; m += NGW) {
            const f32x4* xr = (const f32x4*)(ctx + (size_t)m * D) + lane; f32x4 v[4]; float ss = 0.f;
#pragma unroll
            for (int j = 0; j < 4; ++j) { f32x4 p = {0.f, 0.f, 0.f, 0.f};
#pragma unroll
                for (int ks = 0; ks < 11; ++ks) p += ((const f32x4*)(Pc + (size_t)ks * MC * D + (size_t)m * D))[lane + 64 * j];
                v[j] = xr[64 * j] + (((const f32x4*)(mod + 2 * NMODW + 2 * 1024))[lane + 64 * j] * 0.5f) * p;
                ss += (v[j].x * v[j].x + v[j].y * v[j].y) + (v[j].z * v[j].z + v[j].w * v[j].w); }
            const float r = 1.0f / sqrtf(wave_sum(ss) * (1.f / D) + EPS);
            u32x2* o8 = (u32x2*)(Hn + (size_t)(ML + m) * D) + lane;
#pragma unroll
            for (int j = 0; j < 4; ++j) { const f32x4 gg = ((const f32x4*)(norm_g + 1024))[lane + 64 * j], sh = ((const f32x4*)(mod + 2 * NMODW + 3 * 1024))[lane + 64 * j], sc = ((const f32x4*)(mod + 2 * NMODW + 4 * 1024))[lane + 64 * j];
                const f32x4 y = (v[j] * r) * gg; const f32x4 h = y * (sc + 1.0f) + sh; u32x2 w; w.x = cvt_pk_bf16(h.x, h.y); w.y = cvt_pk_bf16(h.z, h.w); o8[64 * j] = w; }
        }
    }
    GSYNC();
    PH(5) { pg8::Gemm g{Hn, Win_t, D, D, D, 0, 0}; pg8::TailOrder S; S.init(ML, D, D, G, bid, 16, 4, 2, 2); EpiWin E{poolb, As5, Uctx}; pg8::gemm_phase(lds, g, S, E); }
    GSYNC();
    PH(6) {
        const int Gg = G < 64 ? G : 64;
        { pg8::Gemm g{As5, Wst, KS5, 512, 512, (size_t)ROWS5 * KS5, (size_t)256 * 512}; pg8::GroupOrder S; S.init(2, 1, 32, 512, Gg, bid); EpiState E{Sbuf}; pg8::gemm_phase(lds, g, S, E); }
        const int r1 = (bid + G - Gg % G) % G;
        for (int it = r1; it < 16; it += G) { const int wi = it * 8 + wave, b = wi >> 6, g = (wi >> 1) & 31, dir = wi & 1, g0 = (it & 7) * 4;
            LAS float* ul = (LAS float*)lds;
            __syncthreads();
#pragma unroll 2
            for (int i = 0; i < 8; ++i) { const int idx = i * 512 + tid, t = idx >> 4, q = idx & 15; const size_t off = (size_t)(b * CTXL + t) * 512 + g0 * 16 + q * 4;
                const f32x4 s4 = (*(const f32x4*)(Uctx + off) + *(const f32x4*)(Uctx + (size_t)MC * 512 + off)) + (*(const f32x4*)(Uctx + (size_t)2 * MC * 512 + off) + *(const f32x4*)(Uctx + (size_t)3 * MC * 512 + off));
                *(LAS f32x4*)(ul + t * 64 + q * 4) = s4; }
            const f32x2 av = PW[((size_t)(g * 2 + dir) * 33 + 1) * 64 + lane]; f32x2 bb[16];
#pragma unroll
            for (int i = 0; i < 16; ++i) bb[i] = BB[((size_t)(g * 2 + dir) * 64 + lane) * 16 + i];
            __syncthreads();
            float hr = 0.f, hi = 0.f; const int gl = (wave >> 1) * 16;
#pragma unroll 4
            for (int step = 0; step < CTXL; ++step) { const int t = dir == 0 ? step : CTXL - 1 - step; const LAS f32x4* up = (const LAS f32x4*)(ul + t * 64 + gl);
                const f32x4 u0 = up[0], u1 = up[1], u2 = up[2], u3 = up[3]; f32x2 sa = {0.f, 0.f}, sb = {0.f, 0.f};
#pragma unroll
                for (int i = 0; i < 4; ++i) { sa += bb[i] * u0[i]; sb += bb[4 + i] * u1[i]; }
#pragma unroll
                for (int i = 0; i < 4; ++i) { sa += bb[8 + i] * u2[i]; sb += bb[12 + i] * u3[i]; }
                const f32x2 sv = sa + sb;
                const float nr = av.x * hr - av.y * hi + sv.x, ni = av.x * hi + av.y * hr + sv.y; hr = nr; hi = ni; }
            Hctx[(size_t)wi * 64 + lane] = (f32x2){hr, hi}; }
        const int r2 = (bid + 2 * G - (Gg + 16) % G) % G;
        LAS bf16_t* raw = (LAS bf16_t*)lds;
        LAS float* rowb = (LAS float*)(lds + 131072);
        for (int it = r2; it < 128; it += G) { const int b = it >> 6, k = (it >> 4) & 3, slab = it & 15;
            __syncthreads();
            const bf16_t* src = poolb + (size_t)it * 8192 * 8;
#pragma unroll 4
            for (int i = 0; i < 16; ++i) { const int tok = i * 512 + tid; *(LAS u32x4*)(raw + tok * 8) = *(const u32x4*)(src + (size_t)tok * 8); }
            __syncthreads();
            LAS bf16_t* ob = (LAS bf16_t*)(lds + 131072 + 4096);
            bf16_t* dst = mixcat + (size_t)b * SEQ * D + k * 128 + slab * 8;
            if (k == 0) pool_rows<2>(raw, rowb, ob, dst, tid); else if (k == 1) pool_rows<4>(raw, rowb, ob, dst, tid); else if (k == 2) pool_rows<8>(raw, rowb, ob, dst, tid); else pool_rows<16>(raw, rowb, ob, dst, tid);
        }
    }
    GSYNC();
    PH(7) for (int it = bid; it < 16; it += G) { const int wi = it * 8 + wave, b = wi >> 6, g = (wi >> 1) & 31, dir = wi & 1;
        const f32x2 a32 = PW[((size_t)(g * 2 + dir) * 33 + 32) * 64 + lane]; f32x2 h = Hctx[(size_t)wi * 64 + lane];
        const size_t rbase = (size_t)g * ROWS5 + b * 256;
        for (int s0 = 0; s0 < 256; s0 += 16) { float sre[16], sim[16];
#pragma unroll
            for (int i = 0; i < 16; ++i) { const int j = dir == 0 ? s0 + i : 255 - s0 - i; const float* sp = Sbuf + (rbase + j) * 256 + dir * 128 + lane; sre[i] = sp[0]; sim[i] = sp[64]; }
#pragma unroll
            for (int i = 0; i < 16; ++i) { const int j = dir == 0 ? s0 + i : 255 - s0 - i; bf16_t* hp = As5 + (rbase + j) * KS5 + 512 + dir * 128 + lane;
                hp[0] = (bf16_t)(cvt_pk_bf16(h.x, 0.f) & 0xffffu); hp[64] = (bf16_t)(cvt_pk_bf16(h.y, 0.f) & 0xffffu);
                const float nr = a32.x * h.x - a32.y * h.y + sre[i], ni = a32.x * h.y + a32.y * h.x + sim[i]; h.x = nr; h.y = ni; } }
    }
    GSYNC();
    PH(8) { pg8::Gemm g{As5, Bs5, KS5, KS5, KS5, (size_t)ROWS5 * KS5, (size_t)512 * KS5}; pg8::GroupOrder S; S.init(2, 2, 32, KS5, G, bid); EpiS5 E{Ybuf}; pg8::gemm_phase(lds, g, S, E); }
    GSYNC();
    PH(9) { pg8::Gemm g{Ybuf, Wglu_t, 512, 512, 512, 0, 0}; pg8::StaticOrder S; S.init(ML, 512, 512, G, bid); EpiGlu E{Ybuf, mixcat}; pg8::gemm_phase(lds, g, S, E); }
    GSYNC();
    PH(10) { pg8::Gemm g{mixcat, Wmix_t, D, D, D, 0, 0}; pg8::StaticOrder S; S.init(ML, D, D, G, bid); EpiRes E{out, out, Pc, mod + 5 * 1024, 1.0f}; pg8::gemm_phase(lds, g, S, E); }
    GSYNC();
    PH(11) for (int m = gw; m < ML; m += NGW) { const int set = m < SEQ ? 0 : 1;
        norm_mod_row(out + (size_t)m * D, norm_g + 2048, mod + set * NMODW + 6 * 1024, mod + set * NMODW + 7 * 1024, Hn + (size_t)m * D, lane); }
    GSYNC();
    PH(12) { pg8::Gemm g{Hn, W13b, D, D, D, 0, 0}; pg8::StaticOrder S; S.init(ML, 2 * FF, D, G, bid); EpiUp E{Ubuf}; pg8::gemm_phase(lds, g, S, E); }
    GSYNC();
    PH(13) { pg8::Gemm g{Ubuf, W2b, FF, FF, FF, 0, 0}; pg8::StaticOrder S; S.init(ML, D, FF, G, bid); EpiRes E{out, out, Pc, mod + 8 * 1024, 0.5f}; pg8::gemm_phase(lds, g, S, E); }
    GSYNC();
    for (int xs_ = 0; xs_ < XSYNC; ++xs_) GSYNC();
    PH(14) {
        const float* fg = a.in[23];
        for (int m = gw; m < ML; m += NGW) { f32x4* xr = (f32x4*)(out + (size_t)m * D) + lane; f32x4 v[4]; float s = 0.f;
#pragma unroll
            for (int j = 0; j < 4; ++j) { v[j] = xr[64 * j]; s += (v[j].x * v[j].x + v[j].y * v[j].y) + (v[j].z * v[j].z + v[j].w * v[j].w); }
            const float r = 1.0f / sqrtf(wave_sum(s) * (1.f / D) + EPS);
#pragma unroll
            for (int j = 0; j < 4; ++j) xr[64 * j] = (v[j] * r) * ((const f32x4*)fg)[lane + 64 * j]; }
    }
}

#undef ws
#undef xin_
#undef cvec
#undef ctx
#undef cctx
#undef norm_g
#undef w_ada
#undef b_ada
#undef mod
#undef Hctx
#undef Win_t
#undef Wmix_t
#undef Wglu_t
#undef BB
#undef Ktab
#undef PW
#undef W13a
#undef W2a
#undef W13b
#undef W2b
#undef Wst
#undef Bs5
#undef Hn
#undef mixcat
#undef X1c
#undef Uctx
#undef Pc
#undef Ubuf
#undef poolb
#undef As5
#undef Sbuf
#undef Ybuf
#undef out
extern "C" void kernel_launch(void* const* d_in, const int* in_sizes, int n_in, void* d_out, int out_size, void* d_ws, size_t ws_size, hipStream_t stream) {
    static int grid = 0;
    if (grid == 0) {
        if (n_in != 24 || out_size != ML * D || ws_size < WS_END) { fprintf(stderr, "kernel_launch: unexpected shapes (n_in %d out %d ws %zu)\n", n_in, out_size, ws_size); grid = -1; return; }
        int dev = 0, cus = 0, per_cu = 0;
        hipGetDevice(&dev); hipDeviceGetAttribute(&cus, hipDeviceAttributeMultiprocessorCount, dev);
        hipFuncSetAttribute((const void*)fwd_megakernel, hipFuncAttributeMaxDynamicSharedMemorySize, LDS_BYTES);
        if (hipOccupancyMaxActiveBlocksPerMultiprocessor(&per_cu, (const void*)fwd_megakernel, 512, LDS_BYTES) != hipSuccess || per_cu < 1) per_cu = 1;
        (void)hipGetLastError();
        grid = cus * 1;
        if (grid <= 0) grid = 256;
    }
    if (grid < 0) return;
    KArgs a{};
    for (int i = 0; i < 24; ++i) a.in[i] = (const float*)d_in[i];
    a.out = (float*)d_out; a.ws = (unsigned char*)d_ws;
    void* args[] = {&a};
    hipError_t e = hipLaunchCooperativeKernel((const void*)fwd_megakernel, dim3(grid), dim3(512), args, LDS_BYTES, stream);
    if (e != hipSuccess) fprintf(stderr, "cooperative launch failed: %s (grid %d)\n", hipGetErrorString(e), grid);
}
```

```cpp
#include <hip/hip_runtime.h>
#include <hip/hip_cooperative_groups.h>
#include <cstdio>
#include <cstdint>
namespace cg = cooperative_groups;

#define LAS __attribute__((address_space(3)))
typedef unsigned short bf16_t;
typedef short bf16x8 __attribute__((ext_vector_type(8)));
typedef float f32x4 __attribute__((ext_vector_type(4)));
typedef float f32x2 __attribute__((ext_vector_type(2)));
typedef unsigned u32x4 __attribute__((ext_vector_type(4)));
typedef unsigned u32x2 __attribute__((ext_vector_type(2)));

__device__ __forceinline__ unsigned cvt_pk_bf16(float lo, float hi) { unsigned r; asm volatile("v_cvt_pk_bf16_f32 %0, %1, %2" : "=v"(r) : "v"(lo), "v"(hi)); return r; }
__device__ __forceinline__ float bf_lo(unsigned w) { return __builtin_bit_cast(float, w << 16); }
__device__ __forceinline__ float bf_hi(unsigned w) { return __builtin_bit_cast(float, w & 0xffff0000u); }
__device__ __forceinline__ float bf2f(bf16_t h) { return __builtin_bit_cast(float, ((unsigned)h) << 16); }
__device__ __forceinline__ float sigmoid_fast(float x) { return __builtin_amdgcn_rcpf(1.f + __expf(-x)); }
__device__ __forceinline__ float silu_fast(float x) { return x * sigmoid_fast(x); }
__device__ __forceinline__ float gelu_tanh(float x) { const float z = 1.5957691216057308f * (x + 0.044715f * x * x * x); return x * sigmoid_fast(z); }

namespace pg8 {
constexpr int BM = 256, BK = 64, HALF = 128, HTB = HALF * BK * 2, STAGE_BYTES = 8 * HTB, NXCD = 8, WGM = 8;
__host__ __device__ __forceinline__ int lds_byte(int r, int c) { const int st = (r >> 4) * 2 + (c >> 5), rr = r & 15, cc = c & 31, ob = rr * 64 + cc * 2; return st * 1024 + (ob ^ (((ob >> 9) & 1) << 5)); }
__host__ __device__ __forceinline__ void stage_rc(int b, int& R, int& C) { const int st = b / 1024, sb = b % 1024, swz = sb ^ (((sb >> 9) & 1) << 5); R = (st >> 1) * 16 + swz / 64; C = (st & 1) * 32 + (swz % 64) / 2; }
__host__ __device__ __forceinline__ int perm32(int rho) { const int n = rho >> 4, i = rho & 15; return 8 * (i >> 2) + 4 * n + (i & 3); }

struct Unit { int pm, pn, g, k0, nt; };
struct Gemm { const bf16_t* A; const bf16_t* Bt; int lda, ldb, K; size_t gsA, gsB; };

struct StaticOrder {
    int nM, nN, nwg, G, c, ntf;
    __device__ void init(int M, int N, int K, int G_, int c_) { nM = M / BM; nN = N / BM; nwg = nM * nN; G = G_; c = c_; ntf = K / BK; }
    __device__ bool next(int i, Unit& u) const { const long L = (long)i * G + c; if (L >= nwg) return false; unit_of((int)L, u); return true; }
    __device__ void unit_of(int L, Unit& u) const {
        int wgid = L; { const int q = nwg / NXCD, r = nwg % NXCD, xcd = wgid % NXCD, off = wgid / NXCD; wgid = (xcd < r ? xcd * (q + 1) : r * (q + 1) + (xcd - r) * q) + off; }
        const int nig = WGM * nN, gid = wgid / nig, fm = gid * WGM, gsz = (nM - fm) < WGM ? (nM - fm) : WGM;
        u.pm = fm + ((wgid % nig) % gsz); u.pn = (wgid % nig) / gsz; u.g = 0; u.k0 = 0; u.nt = ntf;
    }
};
struct TailOrder {
    StaticOrder base; int nmini, nks, pn0, npn;
    __device__ void init(int M, int N, int K, int G_, int c_, int nmini_, int nks_, int pn0_, int npn_) { base.init(M, N, K, G_, c_); nmini = nmini_; nks = nks_; pn0 = pn0_; npn = npn_; }
    __device__ bool next(int i, Unit& u) const {
        const long L = (long)i * base.G + base.c; if (L < base.nwg) { base.unit_of((int)L, u); return true; }
        const int idx = (int)(L - base.nwg); if (idx >= nmini) return false;
        const int ks = idx % nks, t = idx / nks; u.pm = 64 + t / npn; u.pn = pn0 + t % npn; u.g = 0; u.k0 = ks * 256; u.nt = 4; return true;
    }
};
struct GroupOrder {
    int nM, nN, ng, G, c, ntf;
    __device__ void init(int nM_, int nN_, int ng_, int K, int G_, int c_) { nM = nM_; nN = nN_; ng = ng_; G = G_; c = c_; ntf = K / BK; }
    __device__ bool next(int i, Unit& u) const {
        if (c >= G) return false;
        const long L = (long)i * G + c; if (L >= (long)ng * nM * nN) return false;
        const int per = nM * nN, l = (int)L; u.g = l / per; const int r = l % per; u.pm = r / nN; u.pn = r % nN; u.k0 = 0; u.nt = ntf; return true;
    }
};

template <class Epi, class Sched>
__device__ __forceinline__ void gemm_phase(LAS unsigned char* lds, const Gemm g, const Sched& S, const Epi& E) {
    int tid_ = threadIdx.x; asm volatile("" : "+v"(tid_));
    const int tid = tid_, wid = __builtin_amdgcn_readfirstlane(tid >> 6), lane = tid & 63, wr = wid >> 2, wc = wid & 3, fr = lane & 15, fq = lane >> 4;
    unsigned voffA[2], voffB[2];
#pragma unroll
    for (int i = 0; i < 2; ++i) { int R, C; stage_rc(tid * 16 + i * 8192, R, C); const int Rb = Epi::PERM ? ((R & ~31) + perm32(R & 31)) : R;
        voffA[i] = (unsigned)(R * g.lda + C) * 2u; voffB[i] = (unsigned)(Rb * g.ldb + C) * 2u; }
    const size_t kstep = (size_t)(BK * 2);
    const size_t hstepA = (size_t)HALF * g.lda * 2, hstepB = (size_t)HALF * g.ldb * 2;
    const size_t tstepA = 2 * hstepA, tstepB = 2 * hstepB;
    const unsigned ldsw = (unsigned)wid * 1024u;
    const int aoff = lds_byte(wr * 64 + fr, fq * 8), boff = lds_byte(wc * 32 + fr, fq * 8);
#define PG8_SA(b, h) (((b) * 2 + (h)) * HTB)
#define PG8_SB(b, h) ((4 + (b) * 2 + (h)) * HTB)
#define PG8_STAGE(bufoff, gbase, voff) do { _Pragma("unroll") for (int _i = 0; _i < 2; ++_i) \
        __builtin_amdgcn_global_load_lds((const unsigned*)((const char*)(gbase) + (voff)[_i]), (LAS unsigned*)(lds + (bufoff) + ldsw + _i * 8192), 16, 0, 0); } while (0)
#define PG8_LDA(dst, b, h) do { _Pragma("unroll") for (int m = 0; m < 4; ++m) _Pragma("unroll") for (int k = 0; k < 2; ++k) dst[m][k] = *(const LAS bf16x8*)(lds + PG8_SA(b, h) + aoff + m * 2048 + k * 1024); } while (0)
#define PG8_LDB(dst, b, h) do { _Pragma("unroll") for (int n = 0; n < 2; ++n) _Pragma("unroll") for (int k = 0; k < 2; ++k) dst[n][k] = *(const LAS bf16x8*)(lds + PG8_SB(b, h) + boff + n * 2048 + k * 1024); } while (0)
#define PG8_MMA(ai, bj, At, Bt) do { __builtin_amdgcn_s_setprio(1); _Pragma("unroll") for (int m = 0; m < 4; ++m) _Pragma("unroll") for (int n = 0; n < 2; ++n) _Pragma("unroll") for (int k = 0; k < 2; ++k) \
        acc[ai][bj][m][n] = __builtin_amdgcn_mfma_f32_16x16x32_bf16(Bt[n][k], At[m][k], acc[ai][bj][m][n], 0, 0, 0); __builtin_amdgcn_s_setprio(0); } while (0)
#define PG8_WAIT_V(n) asm volatile("s_waitcnt vmcnt(" #n ")" ::: "memory")
#define PG8_WAIT_L(n) asm volatile("s_waitcnt lgkmcnt(" #n ")" ::: "memory")
#define PG8_BAR __builtin_amdgcn_s_barrier()
#define PG8_SCHED __builtin_amdgcn_sched_barrier(0)
    Unit cur, nxt; int ui = 0;
    if (!S.next(0, cur)) return;
    f32x4 acc[2][2][4][2];
#pragma unroll
    for (int a = 0; a < 2; ++a)
#pragma unroll
        for (int b = 0; b < 2; ++b)
#pragma unroll
            for (int m = 0; m < 4; ++m)
#pragma unroll
                for (int n = 0; n < 2; ++n) acc[a][b][m][n] = (f32x4){0.f, 0.f, 0.f, 0.f};
    bf16x8 At[4][2], B0[2][2], B1[2][2];
    const char* cA = (const char*)(g.A + (size_t)cur.g * g.gsA + cur.k0) + (size_t)cur.pm * tstepA; const char* cB = (const char*)(g.Bt + (size_t)cur.g * g.gsB + cur.k0) + (size_t)cur.pn * tstepB;
    PG8_STAGE(PG8_SB(0, 0), cB, voffB); PG8_STAGE(PG8_SB(0, 1), cB + hstepB, voffB); PG8_STAGE(PG8_SA(0, 0), cA, voffA); PG8_STAGE(PG8_SA(0, 1), cA + hstepA, voffA);
    if (wr == 1) PG8_BAR;
    PG8_WAIT_V(2); PG8_BAR;
    PG8_STAGE(PG8_SB(1, 0), cB + kstep, voffB); PG8_STAGE(PG8_SA(1, 0), cA + kstep, voffA); PG8_STAGE(PG8_SB(1, 1), cB + hstepB + kstep, voffB);
    PG8_WAIT_V(6); PG8_BAR;
    for (;;) {
        const bool has_next = S.next(ui + 1, nxt);
        const char* nA = has_next ? (const char*)(g.A + (size_t)nxt.g * g.gsA + nxt.k0) + (size_t)nxt.pm * tstepA : cA;
        const char* nB = has_next ? (const char*)(g.Bt + (size_t)nxt.g * g.gsB + nxt.k0) + (size_t)nxt.pn * tstepB : cB;
        const int nt = cur.nt;
        for (int t = 0; t < nt; t += 2) {
            const bool last = (t == nt - 2);
            const char* a1 = cA + (size_t)(t + 1) * kstep;
            const char* a2 = last ? nA : cA + (size_t)(t + 2) * kstep; const char* b2 = last ? nB : cB + (size_t)(t + 2) * kstep;
            const char* a3 = a2 + kstep; const char* b3 = b2 + kstep;
            PG8_LDB(B0, 0, 0); PG8_LDB(B1, 0, 1); PG8_SCHED; PG8_LDA(At, 0, 0); PG8_STAGE(PG8_SA(1, 1), a1 + hstepA, voffA);
            PG8_WAIT_V(8); PG8_WAIT_L(0); PG8_BAR; PG8_MMA(0, 0, At, B0); PG8_MMA(0, 1, At, B1); PG8_BAR; PG8_SCHED;
            PG8_LDA(At, 0, 1); PG8_STAGE(PG8_SB(0, 0), b2, voffB); PG8_STAGE(PG8_SB(0, 1), b2 + hstepB, voffB); PG8_STAGE(PG8_SA(0, 0), a2, voffA);
            PG8_WAIT_V(8); PG8_WAIT_L(0); PG8_BAR; PG8_MMA(1, 0, At, B0); PG8_MMA(1, 1, At, B1); PG8_BAR; PG8_SCHED;
            PG8_LDB(B0, 1, 0); PG8_LDB(B1, 1, 1); PG8_SCHED; PG8_LDA(At, 1, 0); PG8_STAGE(PG8_SA(0, 1), a2 + hstepA, voffA);
            PG8_WAIT_V(8); PG8_WAIT_L(0); PG8_BAR; PG8_MMA(0, 0, At, B0); PG8_MMA(0, 1, At, B1); PG8_BAR; PG8_SCHED;
            PG8_LDA(At, 1, 1); PG8_STAGE(PG8_SB(1, 0), b3, voffB); PG8_STAGE(PG8_SB(1, 1), b3 + hstepB, voffB); PG8_STAGE(PG8_SA(1, 0), a3, voffA);
            PG8_WAIT_V(8); PG8_WAIT_L(0); PG8_BAR; PG8_MMA(1, 0, At, B0); PG8_MMA(1, 1, At, B1); PG8_BAR; PG8_SCHED;
        }
        if (wr == 0) PG8_BAR;
        E(acc, cur, wr, wc, fr, fq);
        if (!has_next) break;
#pragma unroll
        for (int a = 0; a < 2; ++a)
#pragma unroll
            for (int b = 0; b < 2; ++b)
#pragma unroll
                for (int m = 0; m < 4; ++m)
#pragma unroll
                    for (int n = 0; n < 2; ++n) acc[a][b][m][n] = (f32x4){0.f, 0.f, 0.f, 0.f};
        cur = nxt; cA = nA; cB = nB; ++ui;
        if (wr == 1) PG8_BAR;
    }
    PG8_WAIT_V(0);
    PG8_BAR;
#undef PG8_SA
#undef PG8_SB
#undef PG8_STAGE
#undef PG8_LDA
#undef PG8_LDB
#undef PG8_MMA
#undef PG8_WAIT_V
#undef PG8_WAIT_L
#undef PG8_BAR
#undef PG8_SCHED
}
}

constexpr int D = 1024, SEQ = 8192, ML = 16384, CTXL = 256, MC = 512, MALL = ML + MC, FF = 2816, NMODW = 9 * 1024;
constexpr int TCH = 32, KS5 = 768, ROWS5 = 512;
constexpr float EPS = 1e-6f;
constexpr size_t MiB = 1u << 20;
constexpr size_t WS_MOD = 128 * 1024, WS_HCTX = 512 * 1024;
constexpr size_t WS_WIN = 1 * MiB, WS_WMIX = 3 * MiB, WS_WGLU = 5 * MiB, WS_BB = 5 * MiB + 512 * 1024, WS_KTAB = 6 * MiB, WS_PW = 8 * MiB;
constexpr size_t WS_W13A = 10 * MiB, WS_W2A = 21 * MiB, WS_W13B = 27 * MiB, WS_W2B = 38 * MiB, WS_WST = 44 * MiB, WS_BS5 = 52 * MiB;
constexpr size_t WS_HN = 76 * MiB, WS_MIX = 109 * MiB, WS_X1C = 141 * MiB, WS_UCTX = 143 * MiB, WS_UB = 144 * MiB;
constexpr size_t WS_POOL = 144 * MiB, WS_AS5 = 160 * MiB, WS_S = 184 * MiB, WS_Y = 200 * MiB, WS_UCTXP = 216 * MiB, WS_END = 236 * MiB;
constexpr size_t WS_PC = WS_MIX;
constexpr int LDS_BYTES = 147456;

struct KArgs { const float* in[24]; float* out; unsigned char* ws; };

struct EpiUp {
    static constexpr bool PERM = true;
    bf16_t* O;
    __device__ __forceinline__ void operator()(const f32x4 (&acc)[2][2][4][2], const pg8::Unit& u, int wr, int wc, int fr, int fq) const {
        const int row0 = u.pm * 256 + wr * 64 + fr, f0 = u.pn * 128 + wc * 16 + 4 * fq;
#pragma unroll
        for (int ai = 0; ai < 2; ++ai)
#pragma unroll
            for (int m = 0; m < 4; ++m) { bf16_t* rowp = O + (size_t)(row0 + ai * 128 + m * 16) * FF + f0;
#pragma unroll
                for (int bj = 0; bj < 2; ++bj) { const f32x4 a = acc[ai][bj][m][0], b = acc[ai][bj][m][1];
                    u32x2 w; w.x = cvt_pk_bf16(silu_fast(a[0]) * b[0], silu_fast(a[1]) * b[1]); w.y = cvt_pk_bf16(silu_fast(a[2]) * b[2], silu_fast(a[3]) * b[3]);
                    *(u32x2*)(rowp + bj * 64) = w; } }
    }
};
struct EpiRes {
    static constexpr bool PERM = false;
    const float* resid_l; float* out_l; float* part_c; const float* gate; float coef;
    __device__ __forceinline__ void operator()(const f32x4 (&acc)[2][2][4][2], const pg8::Unit& u, int wr, int wc, int fr, int fq) const {
        const int set = u.pm < 32 ? 0 : 1;
        const int row0 = u.pm * 256 + wr * 64 + fr, col0 = u.pn * 256 + wc * 32 + 4 * fq;
        if (u.pm >= 64) { float* pb = part_c + (size_t)(u.k0 >> 8) * MC * D;
#pragma unroll
            for (int ai = 0; ai < 2; ++ai)
#pragma unroll
                for (int m = 0; m < 4; ++m) { const size_t off = (size_t)(row0 - ML + ai * 128 + m * 16) * D + col0;
#pragma unroll
                    for (int bj = 0; bj < 2; ++bj)
#pragma unroll
                        for (int n = 0; n < 2; ++n) *(f32x4*)(pb + off + bj * 128 + n * 16) = acc[ai][bj][m][n]; }
            return; }
        const float* rb = resid_l; float* ob = out_l;
        f32x4 gv[2][2];
#pragma unroll
        for (int bj = 0; bj < 2; ++bj)
#pragma unroll
            for (int n = 0; n < 2; ++n) gv[bj][n] = *(const f32x4*)(gate + set * NMODW + col0 + bj * 128 + n * 16) * coef;
#pragma unroll
        for (int am = 0; am < 4; ++am) { f32x4 rv[2][2][2];
#pragma unroll
            for (int mm = 0; mm < 2; ++mm) { const int ai = am >> 1, m = (am & 1) * 2 + mm; const size_t off = (size_t)(row0 + ai * 128 + m * 16) * D + col0;
#pragma unroll
                for (int bj = 0; bj < 2; ++bj)
#pragma unroll
                    for (int n = 0; n < 2; ++n) rv[mm][bj][n] = *(const f32x4*)(rb + off + bj * 128 + n * 16); }
            asm volatile("" ::: "memory");
#pragma unroll
            for (int mm = 0; mm < 2; ++mm) { const int ai = am >> 1, m = (am & 1) * 2 + mm; const size_t off = (size_t)(row0 + ai * 128 + m * 16) * D + col0;
#pragma unroll
                for (int bj = 0; bj < 2; ++bj)
#pragma unroll
                    for (int n = 0; n < 2; ++n) *(f32x4*)(ob + off + bj * 128 + n * 16) = rv[mm][bj][n] + gv[bj][n] * acc[ai][bj][m][n]; }
            asm volatile("" ::: "memory"); }
    }
};
struct EpiWin {
    static constexpr bool PERM = true;
    bf16_t* pool; bf16_t* As5; float* Uctx;
    __device__ __forceinline__ void operator()(const f32x4 (&acc)[2][2][4][2], const pg8::Unit& u, int wr, int wc, int fr, int fq) const {
        const int row0 = u.pm * 256 + wr * 64 + fr;
        const bool isc = u.pm >= 64, ispool = u.pn < 2;
        if (isc && ispool) return;
#pragma unroll
        for (int ai = 0; ai < 2; ++ai)
#pragma unroll
            for (int m = 0; m < 4; ++m) { const int row = row0 + ai * 128 + m * 16;
#pragma unroll
                for (int bj = 0; bj < 2; ++bj) { const int col0 = u.pn * 256 + bj * 128 + wc * 32 + 8 * fq; const f32x4 v0 = acc[ai][bj][m][0], v1 = acc[ai][bj][m][1];
                    if (isc) { float* p = Uctx + (size_t)(u.k0 >> 8) * MC * 512 + (size_t)(row - ML) * 512 + (col0 - 512); *(f32x4*)p = v0; *(f32x4*)(p + 4) = v1; }
                    else { u32x4 w; w.x = cvt_pk_bf16(v0[0], v0[1]); w.y = cvt_pk_bf16(v0[2], v0[3]); w.z = cvt_pk_bf16(v1[0], v1[1]); w.w = cvt_pk_bf16(v1[2], v1[3]);
                        const int b = row >> 13, tok = row & 8191;
                        if (ispool) { const int k = col0 >> 7, slab = (col0 >> 3) & 15; *(u32x4*)(pool + ((size_t)((b * 4 + k) * 16 + slab) * 8192 + tok) * 8) = w; }
                        else { const int cs = col0 - 512, gg = cs >> 4, c0 = cs & 15; *(u32x4*)(As5 + ((size_t)gg * ROWS5 + b * 256 + (tok >> 5)) * KS5 + (tok & 31) * 16 + c0) = w; } } } }
    }
};
struct EpiState {
    static constexpr bool PERM = false;
    float* S;
    __device__ __forceinline__ void operator()(const f32x4 (&acc)[2][2][4][2], const pg8::Unit& u, int wr, int wc, int fr, int fq) const {
        const int row0 = u.pm * 256 + wr * 64 + fr, col0 = wc * 32 + 4 * fq;
#pragma unroll
        for (int ai = 0; ai < 2; ++ai)
#pragma unroll
            for (int m = 0; m < 4; ++m) { float* rowp = S + ((size_t)u.g * ROWS5 + row0 + ai * 128 + m * 16) * 256 + col0;
#pragma unroll
                for (int bj = 0; bj < 2; ++bj)
#pragma unroll
                    for (int n = 0; n < 2; ++n) *(f32x4*)(rowp + bj * 128 + n * 16) = acc[ai][bj][m][n]; }
    }
};
struct EpiS5 {
    static constexpr bool PERM = true;
    bf16_t* Y;
    __device__ __forceinline__ void operator()(const f32x4 (&acc)[2][2][4][2], const pg8::Unit& u, int wr, int wc, int fr, int fq) const {
        const int row0 = u.pm * 256 + wr * 64 + fr;
#pragma unroll
        for (int ai = 0; ai < 2; ++ai)
#pragma unroll
            for (int m = 0; m < 4; ++m) { const int row = row0 + ai * 128 + m * 16, b = row >> 8, chunk = row & 255;
#pragma unroll
                for (int bj = 0; bj < 2; ++bj) { const int n0 = u.pn * 256 + bj * 128 + wc * 32 + 8 * fq, t = n0 >> 4, c0 = n0 & 15; const f32x4 v0 = acc[ai][bj][m][0], v1 = acc[ai][bj][m][1];
                    u32x4 w; w.x = cvt_pk_bf16(gelu_tanh(v0[0]), gelu_tanh(v0[1])); w.y = cvt_pk_bf16(gelu_tanh(v0[2]), gelu_tanh(v0[3]));
                    w.z = cvt_pk_bf16(gelu_tanh(v1[0]), gelu_tanh(v1[1])); w.w = cvt_pk_bf16(gelu_tanh(v1[2]), gelu_tanh(v1[3]));
                    *(u32x4*)(Y + (size_t)(b * SEQ + chunk * TCH + t) * 512 + u.g * 16 + c0) = w; } }
    }
};
struct EpiGlu {
    static constexpr bool PERM = true;
    const bf16_t* Y; bf16_t* mix;
    __device__ __forceinline__ void operator()(const f32x4 (&acc)[2][2][4][2], const pg8::Unit& u, int wr, int wc, int fr, int fq) const {
        const int row0 = u.pm * 256 + wr * 64 + fr;
#pragma unroll
        for (int ai = 0; ai < 2; ++ai)
#pragma unroll
            for (int m = 0; m < 4; ++m) { const int row = row0 + ai * 128 + m * 16;
#pragma unroll
                for (int bj = 0; bj < 2; ++bj) { const int col0 = u.pn * 256 + bj * 128 + wc * 32 + 8 * fq; const f32x4 v0 = acc[ai][bj][m][0], v1 = acc[ai][bj][m][1];
                    const u32x4 y = *(const u32x4*)(Y + (size_t)row * 512 + col0); u32x4 w;
                    w.x = cvt_pk_bf16(bf_lo(y.x) * sigmoid_fast(v0[0]), bf_hi(y.x) * sigmoid_fast(v0[1])); w.y = cvt_pk_bf16(bf_lo(y.y) * sigmoid_fast(v0[2]), bf_hi(y.y) * sigmoid_fast(v0[3]));
                    w.z = cvt_pk_bf16(bf_lo(y.z) * sigmoid_fast(v1[0]), bf_hi(y.z) * sigmoid_fast(v1[1])); w.w = cvt_pk_bf16(bf_lo(y.w) * sigmoid_fast(v1[2]), bf_hi(y.w) * sigmoid_fast(v1[3]));
                    *(u32x4*)(mix + (size_t)row * D + 512 + col0) = w; } }
    }
};

__device__ __forceinline__ float wave_sum(float v) {
#pragma unroll
    for (int o = 1; o < 64; o <<= 1) v += __shfl_xor(v, o);
    return v;
}
__device__ __forceinline__ void transpose_item(const float* W, int ldw, bf16_t* WT, int ldd, int mode, LAS float* scr, int kb, int nb, int lane) {
    const int k0 = 64 * kb, n0 = 32 * nb;
#pragma unroll 8
    for (int i = 0; i < 32; ++i) { const int kk = 2 * i + (lane >> 5); scr[kk * 33 + (lane & 31)] = W[(size_t)(k0 + kk) * ldw + n0 + (lane & 31)]; }
    asm volatile("s_waitcnt lgkmcnt(0)" ::: "memory");
    const int c = lane & 7;
#pragma unroll
    for (int j = 0; j < 4; ++j) { const int n = (lane >> 3) + 8 * j, ncol = n0 + n; const LAS float* s = scr + (8 * c) * 33 + n;
        const int row = mode == 0 ? ncol : (8 * (ncol >> 2) + (ncol & 3) + (mode == 2 ? 4 : 0));
        u32x4 o; o.x = cvt_pk_bf16(s[0 * 33], s[1 * 33]); o.y = cvt_pk_bf16(s[2 * 33], s[3 * 33]); o.z = cvt_pk_bf16(s[4 * 33], s[5 * 33]); o.w = cvt_pk_bf16(s[6 * 33], s[7 * 33]);
        *(u32x4*)(WT + (size_t)row * ldd + k0 + 8 * c) = o; }
    asm volatile("s_waitcnt lgkmcnt(0)" ::: "memory");
}
__device__ __forceinline__ void norm_mod_row(const float* xrow, const float* g, const float* shift, const float* scale, bf16_t* orow, int lane) {
    const f32x4* xr = (const f32x4*)xrow + lane; f32x4 v[4]; float s = 0.f;
#pragma unroll
    for (int j = 0; j < 4; ++j) { v[j] = xr[64 * j]; s += (v[j].x * v[j].x + v[j].y * v[j].y) + (v[j].z * v[j].z + v[j].w * v[j].w); }
    const float r = 1.0f / sqrtf(wave_sum(s) * (1.f / D) + EPS);
    u32x2* o8 = (u32x2*)orow + lane;
#pragma unroll
    for (int j = 0; j < 4; ++j) { const f32x4 gg = ((const f32x4*)g)[lane + 64 * j], sh = ((const f32x4*)shift)[lane + 64 * j], sc = ((const f32x4*)scale)[lane + 64 * j];
        const f32x4 y = (v[j] * r) * gg; const f32x4 h = y * (sc + 1.0f) + sh; u32x2 w; w.x = cvt_pk_bf16(h.x, h.y); w.y = cvt_pk_bf16(h.z, h.w); o8[64 * j] = w; }
}


#define XB_TMO      128
#define XB_XCNT(j)  (256  + 64 * (j))
#define XB_XSUB(j)  (1280 + 64 * (j))
#define XB_XGEN(j)  (2304 + 64 * (j))
#define XB_TOP      3328
#define XB_TOPGEN   3392
#define XCD_BAR_WORDS 3456
#define XB_SPIN_CAP (1u << 22)
__device__ __forceinline__ unsigned xb_ld(unsigned* p)              { return __hip_atomic_load(p, __ATOMIC_RELAXED, __HIP_MEMORY_SCOPE_AGENT); }
__device__ __forceinline__ unsigned xb_add(unsigned* p, unsigned v) { return __hip_atomic_fetch_add(p, v, __ATOMIC_RELAXED, __HIP_MEMORY_SCOPE_AGENT); }
__device__ __forceinline__ unsigned xb_xcc_id() { return (unsigned)__builtin_amdgcn_s_getreg((3 << 11) | 20) & 0xFu; }
#define XB_SPIN(cond, bar) do { unsigned _sp = 0; while (cond) { __builtin_amdgcn_s_sleep(1); \
    if ((++_sp & 255u) == 0u) { if (xb_ld(&(bar)[XB_TMO])) break; if (_sp > XB_SPIN_CAP) { atomicAdd(&(bar)[XB_TMO], 1u); break; } } } } while (0)
struct XcdBarrier { unsigned* bar; unsigned x; volatile LAS unsigned* st; };
__device__ __forceinline__ XcdBarrier xcd_barrier_post(unsigned* bar, volatile LAS unsigned* st) {
    XcdBarrier b; b.bar = bar; b.x = xb_xcc_id(); b.st = st;
    if (threadIdx.x == 0) (void)xb_add(&bar[XB_XCNT(b.x)], 1u);
    return b;
}
__device__ __forceinline__ void xcd_barrier_complete(unsigned* bar, unsigned x, unsigned& nloc, unsigned& nx) {
    const unsigned G = gridDim.x * gridDim.y * gridDim.z;
    unsigned sum, cnt, mine, sp = 0u;
    for (;;) {
        sum = 0u; cnt = 0u; mine = 0u;
#pragma unroll
        for (unsigned j = 0; j < 16; ++j) { const unsigned c = xb_ld(&bar[XB_XCNT(j)]); sum += c; cnt += (c > 0u) ? 1u : 0u; mine = (j == x) ? c : mine; }
        if (sum == G) break;
        __builtin_amdgcn_s_sleep(1);
        if ((++sp & 255u) == 0u) { if (xb_ld(&bar[XB_TMO])) break; if (sp > XB_SPIN_CAP) { atomicAdd(&bar[XB_TMO], 1u); break; } }
    }
    nloc = mine > 0u ? mine : 1u; nx = cnt > 0u ? cnt : 1u;
}
__device__ __forceinline__ void xcd_barrier(const XcdBarrier& b) {
    asm volatile("s_waitcnt vmcnt(0)" ::: "memory");
    __syncthreads();
    if (threadIdx.x == 0) {
        unsigned* bar = b.bar;
        __builtin_amdgcn_s_waitcnt(0);
        unsigned nloc = b.st[0], nx = b.st[1];
        if (nloc == 0u) { xcd_barrier_complete(bar, b.x, nloc, nx); b.st[0] = nloc; b.st[1] = nx; }
        const unsigned old = xb_add(&bar[XB_XSUB(b.x)], 1u);
        const unsigned gen = old / nloc;
        if (old + 1u == (gen + 1u) * nloc) {
            __builtin_amdgcn_fence(__ATOMIC_RELEASE, "agent");
            asm volatile("s_waitcnt vmcnt(0)" ::: "memory");
            const unsigned og = xb_add(&bar[XB_TOP], 1u);
            const unsigned tg = og / nx;
            if (og + 1u == (tg + 1u) * nx) xb_add(&bar[XB_TOPGEN], 1u);
            else XB_SPIN(xb_ld(&bar[XB_TOPGEN]) == tg, bar);
            __builtin_amdgcn_fence(__ATOMIC_ACQUIRE, "agent");
            xb_add(&bar[XB_XGEN(b.x)], 1u);
            asm volatile("s_waitcnt vmcnt(0)" ::: "memory");
        } else {
            XB_SPIN(xb_ld(&bar[XB_XGEN(b.x)]) == gen, bar);
            __builtin_amdgcn_fence(__ATOMIC_ACQUIRE, "agent");
            asm volatile("s_waitcnt vmcnt(0)" ::: "memory");
        }
    }
    __syncthreads();
}
#ifndef PHMASK
#define PHMASK 0xFFFFF
#endif
#ifndef REPMASK
#define REPMASK 0
#endif
#ifndef XSYNC
#define XSYNC 0
#endif
#define PH(k) for (int rep_ = 0; rep_ < 1 + (((REPMASK) >> (k)) & 1); ++rep_) if constexpr (((PHMASK) >> (k)) & 1)

template <int W>
__device__ __forceinline__ void pool_rows(LAS bf16_t* raw, LAS float* rowb, LAS bf16_t* ob, bf16_t* dst  , int tid) {
    constexpr int lo = W / 2, hi = W - 1 - lo;
    const int c = tid >> 3, ch = tid & 7;
    const int clo = c - lo < 0 ? 0 : c - lo, chi = c + hi > 63 ? 63 : c + hi; const float icc = 1.0f / (float)(chi - clo + 1);
    float vs = 0.f;
#pragma unroll
    for (int r = 0; r <= hi; ++r) vs += bf2f(raw[(r * 64 + c) * 8 + ch]);
#pragma unroll 1
    for (int r = 0; r < 128; ++r) {
        const int rlo = r - lo < 0 ? 0 : r - lo, rhi = r + hi > 127 ? 127 : r + hi;
        LAS float* rb = rowb + (r & 1) * 512;
        rb[c * 8 + ch] = vs * __builtin_amdgcn_rcpf((float)(rhi - rlo + 1));
        __syncthreads();
        float hv[W];
#pragma unroll
        for (int i = 0; i < W; ++i) { int c2 = c - lo + i; c2 = c2 < 0 ? 0 : (c2 > 63 ? 63 : c2); hv[i] = rb[c2 * 8 + ch]; }
        float hs = 0.f;
#pragma unroll
        for (int i = 0; i < W; ++i) { const int c2 = c - lo + i; hs += (c2 >= 0 && c2 <= 63) ? hv[i] : 0.f; }
        const float dval = hs * icc - bf2f(raw[(r * 64 + c) * 8 + ch]);
        ob[(r & 1) * 512 + tid] = (bf16_t)(cvt_pk_bf16(dval, 0.f) & 0xffffu);
        if (r > 0 && tid < 64) *(u32x4*)(dst + (size_t)((r - 1) * 64 + tid) * D) = *(const LAS u32x4*)(ob + ((r - 1) & 1) * 512 + tid * 8);
        if (r + 1 + hi <= 127) vs += bf2f(raw[((r + 1 + hi) * 64 + c) * 8 + ch]);
        if (r - lo >= 0) vs -= bf2f(raw[((r - lo) * 64 + c) * 8 + ch]);
    }
    __syncthreads();
    if (tid < 64) *(u32x4*)(dst + (size_t)(127 * 64 + tid) * D) = *(const LAS u32x4*)(ob + 512 + tid * 8);
}
__global__ void __launch_bounds__(512, 2) fwd_megakernel(KArgs a) {
    extern __shared__ __attribute__((aligned(16))) unsigned char lds_raw[];
    LAS unsigned char* lds = (LAS unsigned char*)lds_raw;
    cg::grid_group grid = cg::this_grid();
    const int tid = threadIdx.x, lane = tid & 63, wave = __builtin_amdgcn_readfirstlane(tid >> 6);
    const int G = gridDim.x, bid = blockIdx.x;
    const int gw = bid * 8 + wave, NGW = G * 8;
    volatile LAS unsigned* bst = (volatile LAS unsigned*)(lds + LDS_BYTES - 64);
    if (tid == 0) { bst[0] = 0u; bst[1] = 0u; }
    __syncthreads();
    if (bid == 0) for (int i = tid; i < XCD_BAR_WORDS; i += 512) ((unsigned*)a.ws)[i] = 0u;
#ifndef TPROBE
#define TPROBE 0
#endif
#ifndef TSEL_A
#define TSEL_A 0
#define TSEL_B 1
#endif
#if TPROBE
    unsigned long long* tsb = (unsigned long long*)(a.ws + 65536); int tsi = 1;
    if (bid == 0 && tid == 0) tsb[0] = __builtin_amdgcn_s_memrealtime();
#define TSTAMP() do { if (bid == 0 && tid == 0) tsb[tsi] = __builtin_amdgcn_s_memrealtime(); ++tsi; } while (0)
#else
#define TSTAMP() do {} while (0)
#endif
#define GSYNC() do { xcd_barrier(xbar); TSTAMP(); } while (0)
#define ws (a.ws)
#define xin_ (a.in[0])
#define cvec (a.in[1])
#define ctx (a.in[2])
#define cctx (a.in[3])
#define norm_g (a.in[4])
#define w_ada (a.in[5])
#define b_ada (a.in[6])
#define mod ((float*)(ws + WS_MOD))
#define Hctx ((f32x2*)(ws + WS_HCTX))
#define Win_t ((bf16_t*)(ws + WS_WIN))
#define Wmix_t ((bf16_t*)(ws + WS_WMIX))
#define Wglu_t ((bf16_t*)(ws + WS_WGLU))
#define BB ((f32x2*)(ws + WS_BB))
#define Ktab ((float*)(ws + WS_KTAB))
#define PW ((f32x2*)(ws + WS_PW))
#define W13a ((bf16_t*)(ws + WS_W13A))
#define W2a ((bf16_t*)(ws + WS_W2A))
#define W13b ((bf16_t*)(ws + WS_W13B))
#define W2b ((bf16_t*)(ws + WS_W2B))
#define Wst ((bf16_t*)(ws + WS_WST))
#define Bs5 ((bf16_t*)(ws + WS_BS5))
#define Hn ((bf16_t*)(ws + WS_HN))
#define mixcat ((bf16_t*)(ws + WS_MIX))
#define X1c ((float*)(ws + WS_X1C))
#define Uctx ((float*)(ws + WS_UCTXP))
#define Pc ((float*)(ws + WS_PC))
#define Ubuf ((bf16_t*)(ws + WS_UB))
#define poolb ((bf16_t*)(ws + WS_POOL))
#define As5 ((bf16_t*)(ws + WS_AS5))
#define Sbuf ((float*)(ws + WS_S))
#define Ybuf ((bf16_t*)(ws + WS_Y))
#define out (a.out)

    PH(0) {
        LAS float* sc = (LAS float*)lds;
        LAS float* red = (LAS float*)(lds + 16384);
        for (int i = tid; i < 3072; i += 512) { const float v = i < 2048 ? cvec[i] : cctx[i - 2048]; sc[i] = v / (1.f + expf(-v)); }
        __syncthreads();
        for (int strip = bid; strip < 256; strip += G) {
            const int cg4 = tid % 9, kk = tid / 9;
            f32x4 a0 = {0.f, 0.f, 0.f, 0.f}, a1 = a0, a2 = a0;
            if (tid < 504) {
#pragma unroll
                for (int it = 0; it < 19; ++it) { const int k = kk + 56 * it; if (k < 1024) { const f32x4 w = *(const f32x4*)(w_ada + (size_t)k * NMODW + strip * 36 + cg4 * 4);
                    a0 += w * sc[k]; a1 += w * sc[1024 + k]; a2 += w * sc[2048 + k]; } }
#pragma unroll
                for (int i = 0; i < 4; ++i) { red[kk * 112 + cg4 * 4 + i] = a0[i]; red[kk * 112 + 36 + cg4 * 4 + i] = a1[i]; red[kk * 112 + 72 + cg4 * 4 + i] = a2[i]; }
            }
            __syncthreads();
            if (tid < 108) { float s = 0.f;
#pragma unroll 8
                for (int k2 = 0; k2 < 56; ++k2) s += red[k2 * 112 + tid];
                const int r = tid / 36, col = strip * 36 + (tid % 36); mod[r * NMODW + col] = s + b_ada[col]; }
            __syncthreads();
        }
        LAS f32x2* pwL = (LAS f32x2*)(lds + 65536);
        LAS f32x2* bbL = (LAS f32x2*)(lds + 65536 + 17408);
        LAS f32x2* cL = (LAS f32x2*)(lds + 65536 + 17408 + 8192);
        const float* a_re = a.in[13]; const float* a_im = a.in[14]; const float* log_dt = a.in[15]; const float* b_re = a.in[16]; const float* b_im = a.in[17];
        const float* c_re = a.in[18]; const float* c_im = a.in[19];
#pragma unroll 1
        for (int it2 = G - 1 - bid; it2 < 256; it2 += G) {
            const int it = it2 >> 2, qq = it2 & 3; const bool wr_tab = qq == 0;
            const int g = it >> 1, dir = it & 1, pd = dir * 32 + g;
            const float dt = expf(log_dt[pd]);
            for (int idx = tid; idx < 33 * 64; idx += 512) { const int tau = idx >> 6, p = idx & 63; const float are = a_re[pd * 64 + p], aim = a_im[pd * 64 + p];
                const float mag = expf(are * dt * (float)tau); double ang = (double)aim * (double)dt * (double)tau; ang -= 6.283185307179586 * rint(ang * 0.15915494309189535);
                float sn, cs; sincosf((float)ang, &sn, &cs); const f32x2 v = {mag * cs, mag * sn}; pwL[idx] = v; if (wr_tab) PW[(size_t)it * 33 * 64 + idx] = v; }
            for (int idx = tid; idx < 1024; idx += 512) { const f32x2 v = {c_re[(size_t)pd * 1024 + idx], c_im[(size_t)pd * 1024 + idx]}; cL[idx] = v; }
            __syncthreads();
            for (int idx = tid; idx < 1024; idx += 512) { const int p = idx >> 4; const float are = a_re[pd * 64 + p], aim = a_im[pd * 64 + p]; const float zr = are * dt, zi = aim * dt;
                float qr, qi;
                if (zr * zr + zi * zi < 0.25f) { float tr = 1.f, ti = 0.f;
                    for (int k = 12; k >= 2; --k) { const float ik = 1.0f / (float)k, wr_ = zr * ik, wi_ = zi * ik; const float nr = 1.f + (wr_ * tr - wi_ * ti), ni = wr_ * ti + wi_ * tr; tr = nr; ti = ni; }
                    qr = dt * tr; qi = dt * ti; }
                else { const f32x2 ab = pwL[64 + p]; const float nr = ab.x - 1.f, ni = ab.y, den = are * are + aim * aim; qr = (nr * are + ni * aim) / den; qi = (ni * are - nr * aim) / den; }
                const float br = b_re[(size_t)g * 1024 + idx], bi = b_im[(size_t)g * 1024 + idx];
                const f32x2 v = {qr * br - qi * bi, qr * bi + qi * br}; bbL[idx] = v; if (wr_tab) BB[(size_t)it * 1024 + idx] = v; }
            __syncthreads();
#pragma unroll 1
            for (int j = 0; j < 4; ++j) { const int idx = qq * 2048 + tid + 512 * j, tau = idx >> 8, c = (idx >> 4) & 15, cc = idx & 15; float s = 0.f;
#pragma unroll 8
                for (int p = 0; p < 64; ++p) { const f32x2 C = cL[c * 64 + p], w = pwL[tau * 64 + p], b = bbL[p * 16 + cc]; const float zr = C.x * w.x - C.y * w.y, zi = C.x * w.y + C.y * w.x; s += zr * b.x - zi * b.y; }
                Ktab[(size_t)it * 8192 + idx] = s; }
            __syncthreads();
        }
    }
    grid.sync(); TSTAMP();
    const XcdBarrier xbar = xcd_barrier_post((unsigned*)ws, bst);

    PH(1) {
        LAS float* scr = (LAS float*)(lds + wave * 16384);
        constexpr int I_UP = 16 * 88, I_DN = 44 * 32, I_IN = 16 * 32, I_OUT = 8 * 32, I_GLU = 8 * 16;
        constexpr int NITEMS = 4 * I_UP + 2 * I_DN + I_IN + I_OUT + I_GLU;
        for (int it = gw; it < NITEMS; it += NGW) {
            int r = it;
            if (r < I_UP) { transpose_item(a.in[7], FF, W13a, D, 1, scr, r / 88, r % 88, lane); continue; } r -= I_UP;
            if (r < I_UP) { transpose_item(a.in[8], FF, W13a, D, 2, scr, r / 88, r % 88, lane); continue; } r -= I_UP;
            if (r < I_DN) { transpose_item(a.in[9], D, W2a, FF, 0, scr, r / 32, r % 32, lane); continue; } r -= I_DN;
            if (r < I_UP) { transpose_item(a.in[7] + (size_t)D * FF, FF, W13b, D, 1, scr, r / 88, r % 88, lane); continue; } r -= I_UP;
            if (r < I_UP) { transpose_item(a.in[8] + (size_t)D * FF, FF, W13b, D, 2, scr, r / 88, r % 88, lane); continue; } r -= I_UP;
            if (r < I_DN) { transpose_item(a.in[9] + (size_t)D * FF, D, W2b, FF, 0, scr, r / 32, r % 32, lane); continue; } r -= I_DN;
            if (r < I_IN) { transpose_item(a.in[10], D, Win_t, D, 0, scr, r / 32, r % 32, lane); continue; } r -= I_IN;
            if (r < I_OUT) { transpose_item(a.in[22] + (size_t)512 * D, D, Wmix_t + 512, D, 0, scr, r / 32, r % 32, lane); continue; } r -= I_OUT;
            transpose_item(a.in[21], 512, Wglu_t, 512, 0, scr, r / 16, r % 16, lane);
        }
        {
            const float* pool_w = a.in[11]; const float* pool_scale = a.in[12]; const float* w_out = a.in[22];
            for (int it = G - 1 - bid; it < 256; it += G) { const int k = it >> 6, cb = (it >> 2) & 15, nq = it & 3, n = nq * 256 + (tid & 255), c4 = cb * 8 + (tid >> 8) * 4;
                float ac[4] = {0.f, 0.f, 0.f, 0.f};
#pragma unroll 8
                for (int d = 0; d < 128; ++d) { const float wo = w_out[(size_t)(k * 128 + d) * D + n] * pool_scale[k * 128 + d];
#pragma unroll
                    for (int i = 0; i < 4; ++i) ac[i] += wo * pool_w[(size_t)(k * 128 + c4 + i) * 128 + d]; }
                u32x2 w0; w0.x = cvt_pk_bf16(ac[0], ac[1]); w0.y = cvt_pk_bf16(ac[2], ac[3]);
                *(u32x2*)(Wmix_t + (size_t)n * D + k * 128 + c4) = w0; }
        }
        {
            const float* c_re = a.in[18]; const float* c_im = a.in[19]; const float* dskip = a.in[20];
            const int gt = bid * 512 + tid, NT = G * 512;
            for (int e = gt; e < 32 * 512 * 96; e += NT) { const int k8 = e % 96, n = (e / 96) & 511, g = e / (96 * 512), t = n >> 4, c = n & 15; float v[8];
                if (k8 < 64) { const int s = k8 >> 1, c0 = (k8 & 1) * 8;
#pragma unroll
                    for (int i = 0; i < 8; ++i) v[i] = 0.f;
                    if (s <= t) { const float* kp = Ktab + ((size_t)((g * 2 + 0) * 32 + (t - s)) * 256 + c * 16 + c0); const f32x4 k0 = *(const f32x4*)kp, k1 = *(const f32x4*)(kp + 4);
                        v[0] += k0.x; v[1] += k0.y; v[2] += k0.z; v[3] += k0.w; v[4] += k1.x; v[5] += k1.y; v[6] += k1.z; v[7] += k1.w; }
                    if (s >= t) { const float* kp = Ktab + ((size_t)((g * 2 + 1) * 32 + (s - t)) * 256 + c * 16 + c0); const f32x4 k0 = *(const f32x4*)kp, k1 = *(const f32x4*)(kp + 4);
                        v[0] += k0.x; v[1] += k0.y; v[2] += k0.z; v[3] += k0.w; v[4] += k1.x; v[5] += k1.y; v[6] += k1.z; v[7] += k1.w; }
                    if (s == t) { const float dv = dskip[g * 16 + c];
#pragma unroll
                        for (int i = 0; i < 8; ++i) if (c0 + i == c) v[i] += dv; }
                } else { const int j = k8 - 64, part = j >> 3, p0 = (j & 7) * 8, dir = part >> 1, ex = dir == 0 ? t + 1 : 32 - t;
#pragma unroll
                    for (int i = 0; i < 8; ++i) { const int p = p0 + i; const size_t ci = ((size_t)(dir * 32 + g) * 16 + c) * 64 + p; const float cr = c_re[ci], cim = c_im[ci]; const f32x2 w = PW[((size_t)(g * 2 + dir) * 33 + ex) * 64 + p];
                        const float zr = cr * w.x - cim * w.y, zi = cr * w.y + cim * w.x; v[i] = (part & 1) ? -zi : zr; } }
                u32x4 o; o.x = cvt_pk_bf16(v[0], v[1]); o.y = cvt_pk_bf16(v[2], v[3]); o.z = cvt_pk_bf16(v[4], v[5]); o.w = cvt_pk_bf16(v[6], v[7]);
                *(u32x4*)(Bs5 + ((size_t)g * 512 + n) * KS5 + k8 * 8) = o; }
            for (int e = gt; e < 32 * 256 * 64; e += NT) { const int k8 = e & 63, n = (e >> 6) & 255, g = e >> 14, dir = n >> 7, reim = (n >> 6) & 1, p = n & 63, s = k8 >> 1, c0 = (k8 & 1) * 8, ex = dir == 0 ? 31 - s : s;
                const f32x2 w = PW[((size_t)(g * 2 + dir) * 33 + ex) * 64 + p]; float v[8];
#pragma unroll
                for (int i = 0; i < 8; ++i) { const f32x2 b = BB[((size_t)(g * 2 + dir) * 64 + p) * 16 + c0 + i]; v[i] = reim ? (w.x * b.y + w.y * b.x) : (w.x * b.x - w.y * b.y); }
                u32x4 o; o.x = cvt_pk_bf16(v[0], v[1]); o.y = cvt_pk_bf16(v[2], v[3]); o.z = cvt_pk_bf16(v[4], v[5]); o.w = cvt_pk_bf16(v[6], v[7]);
                *(u32x4*)(Wst + ((size_t)g * 256 + n) * 512 + k8 * 8) = o; }
        }
        for (int m = gw; m < MALL; m += NGW) { const int set = m < SEQ ? 0 : (m < ML ? 1 : 2); const float* src = m < ML ? xin_ + (size_t)m * D : ctx + (size_t)(m - ML) * D;
            norm_mod_row(src, norm_g, mod + set * NMODW + 0 * 1024, mod + set * NMODW + 1 * 1024, Hn + (size_t)m * D, lane); }
    }
    GSYNC();

    PH(2) { pg8::Gemm g{Hn, W13a, D, D, D, 0, 0}; pg8::StaticOrder S; S.init(MALL, 2 * FF, D, G, bid); EpiUp E{Ubuf}; pg8::gemm_phase(lds, g, S, E); }
    GSYNC();
    PH(3) { pg8::Gemm g{Ubuf, W2a, FF, FF, FF, 0, 0}; pg8::TailOrder S; S.init(ML, D, FF, G, bid, 88, 11, 0, 4); EpiRes E{xin_, out, Pc, mod + 2 * 1024, 0.5f}; pg8::gemm_phase(lds, g, S, E); }
    GSYNC();
    PH(4) {
        for (int m = (gw & 3) == 0 ? (gw >> 2) : MC; m < MC; m += (NGW + 3) >> 2) {
            const f32x4* xr = (const f32x4*)(ctx + (size_t)m * D) + lane; f32x4 v[4]; float ss = 0.f;
#pragma unroll
            for (int j = 0; j < 4; ++j) { f32x4 p = {0.f, 0.f, 0.f, 0.f};
#pragma unroll
                for (int ks = 0; ks < 11; ++ks) p += ((const f32x4*)(Pc + (size_t)ks * MC * D + (size_t)m * D))[lane + 64 * j];
                v[j] = xr[64 * j] + (((const f32x4*)(mod + 2 * NMODW + 2 * 1024))[lane + 64 * j] * 0.5f) * p;
                ss += (v[j].x * v[j].x + v[j].y * v[j].y) + (v[j].z * v[j].z + v[j].w * v[j].w); }
            const float r = 1.0f / sqrtf(wave_sum(ss) * (1.f / D) + EPS);
            u32x2* o8 = (u32x2*)(Hn + (size_t)(ML + m) * D) + lane;
#pragma unroll
            for (int j = 0; j < 4; ++j) { const f32x4 gg = ((const f32x4*)(norm_g + 1024))[lane + 64 * j], sh = ((const f32x4*)(mod + 2 * NMODW + 3 * 1024))[lane + 64 * j], sc = ((const f32x4*)(mod + 2 * NMODW + 4 * 1024))[lane + 64 * j];
                const f32x4 y = (v[j] * r) * gg; const f32x4 h = y * (sc + 1.0f) + sh; u32x2 w; w.x = cvt_pk_bf16(h.x, h.y); w.y = cvt_pk_bf16(h.z, h.w); o8[64 * j] = w; }
        }
        for (int m = gw; m < ML; m += NGW) { const int set = m < SEQ ? 0 : 1;
            norm_mod_row(out + (size_t)m * D, norm_g + 1024, mod + set * NMODW + 3 * 1024, mod + set * NMODW + 4 * 1024, Hn + (size_t)m * D, lane); }
    }
    GSYNC();
    PH(5) { pg8::Gemm g{Hn, Win_t, D, D, D, 0, 0}; pg8::TailOrder S; S.init(ML, D, D, G, bid, 16, 4, 2, 2); EpiWin E{poolb, As5, Uctx}; pg8::gemm_phase(lds, g, S, E); }
    GSYNC();
    PH(6) {
        const int Gg = G < 64 ? G : 64;
        { pg8::Gemm g{As5, Wst, KS5, 512, 512, (size_t)ROWS5 * KS5, (size_t)256 * 512}; pg8::GroupOrder S; S.init(2, 1, 32, 512, Gg, bid); EpiState E{Sbuf}; pg8::gemm_phase(lds, g, S, E); }
        const int r1 = (bid + G - Gg % G) % G;
        for (int it = r1; it < 16; it += G) { const int wi = it * 8 + wave, b = wi >> 6, g = (wi >> 1) & 31, dir = wi & 1, g0 = (it & 7) * 4;
            LAS float* ul = (LAS float*)lds;
            __syncthreads();
#pragma unroll 2
            for (int i = 0; i < 8; ++i) { const int idx = i * 512 + tid, t = idx >> 4, q = idx & 15; const size_t off = (size_t)(b * CTXL + t) * 512 + g0 * 16 + q * 4;
                const f32x4 s4 = (*(const f32x4*)(Uctx + off) + *(const f32x4*)(Uctx + (size_t)MC * 512 + off)) + (*(const f32x4*)(Uctx + (size_t)2 * MC * 512 + off) + *(const f32x4*)(Uctx + (size_t)3 * MC * 512 + off));
                *(LAS f32x4*)(ul + t * 64 + q * 4) = s4; }
            const f32x2 av = PW[((size_t)(g * 2 + dir) * 33 + 1) * 64 + lane]; f32x2 bb[16];
#pragma unroll
            for (int i = 0; i < 16; ++i) bb[i] = BB[((size_t)(g * 2 + dir) * 64 + lane) * 16 + i];
            __syncthreads();
            float hr = 0.f, hi = 0.f; const int gl = (wave >> 1) * 16;
#pragma unroll 4
            for (int step = 0; step < CTXL; ++step) { const int t = dir == 0 ? step : CTXL - 1 - step; const LAS f32x4* up = (const LAS f32x4*)(ul + t * 64 + gl);
                const f32x4 u0 = up[0], u1 = up[1], u2 = up[2], u3 = up[3]; f32x2 sa = {0.f, 0.f}, sb = {0.f, 0.f};
#pragma unroll
                for (int i = 0; i < 4; ++i) { sa += bb[i] * u0[i]; sb += bb[4 + i] * u1[i]; }
#pragma unroll
                for (int i = 0; i < 4; ++i) { sa += bb[8 + i] * u2[i]; sb += bb[12 + i] * u3[i]; }
                const f32x2 sv = sa + sb;
                const float nr = av.x * hr - av.y * hi + sv.x, ni = av.x * hi + av.y * hr + sv.y; hr = nr; hi = ni; }
            Hctx[(size_t)wi * 64 + lane] = (f32x2){hr, hi}; }
        const int r2 = (bid + 2 * G - (Gg + 16) % G) % G;
        LAS bf16_t* raw = (LAS bf16_t*)lds;
        LAS float* rowb = (LAS float*)(lds + 131072);
        for (int it = r2; it < 128; it += G) { const int b = it >> 6, k = (it >> 4) & 3, slab = it & 15;
            __syncthreads();
            const bf16_t* src = poolb + (size_t)it * 8192 * 8;
#pragma unroll 4
            for (int i = 0; i < 16; ++i) { const int tok = i * 512 + tid; *(LAS u32x4*)(raw + tok * 8) = *(const u32x4*)(src + (size_t)tok * 8); }
            __syncthreads();
            LAS bf16_t* ob = (LAS bf16_t*)(lds + 131072 + 4096);
            bf16_t* dst = mixcat + (size_t)b * SEQ * D + k * 128 + slab * 8;
            if (k == 0) pool_rows<2>(raw, rowb, ob, dst, tid); else if (k == 1) pool_rows<4>(raw, rowb, ob, dst, tid); else if (k == 2) pool_rows<8>(raw, rowb, ob, dst, tid); else pool_rows<16>(raw, rowb, ob, dst, tid);
        }
    }
    GSYNC();
    PH(7) for (int it = bid; it < 16; it += G) { const int wi = it * 8 + wave, b = wi >> 6, g = (wi >> 1) & 31, dir = wi & 1;
        const f32x2 a32 = PW[((size_t)(g * 2 + dir) * 33 + 32) * 64 + lane]; f32x2 h = Hctx[(size_t)wi * 64 + lane];
        const size_t rbase = (size_t)g * ROWS5 + b * 256;
        for (int s0 = 0; s0 < 256; s0 += 32) { float sre[32], sim[32];
#pragma unroll
            for (int i = 0; i < 32; ++i) { const int j = dir == 0 ? s0 + i : 255 - s0 - i; const float* sp = Sbuf + (rbase + j) * 256 + dir * 128 + lane; sre[i] = sp[0]; sim[i] = sp[64]; }
#pragma unroll
            for (int i = 0; i < 32; ++i) { const int j = dir == 0 ? s0 + i : 255 - s0 - i; bf16_t* hp = As5 + (rbase + j) * KS5 + 512 + dir * 128 + lane;
                hp[0] = (bf16_t)(cvt_pk_bf16(h.x, 0.f) & 0xffffu); hp[64] = (bf16_t)(cvt_pk_bf16(h.y, 0.f) & 0xffffu);
                const float nr = a32.x * h.x - a32.y * h.y + sre[i], ni = a32.x * h.y + a32.y * h.x + sim[i]; h.x = nr; h.y = ni; } }
    }
    GSYNC();
    PH(8) { pg8::Gemm g{As5, Bs5, KS5, KS5, KS5, (size_t)ROWS5 * KS5, (size_t)512 * KS5}; pg8::GroupOrder S; S.init(2, 2, 32, KS5, G, bid); EpiS5 E{Ybuf}; pg8::gemm_phase(lds, g, S, E); }
    GSYNC();
    PH(9) { pg8::Gemm g{Ybuf, Wglu_t, 512, 512, 512, 0, 0}; pg8::StaticOrder S; S.init(ML, 512, 512, G, bid); EpiGlu E{Ybuf, mixcat}; pg8::gemm_phase(lds, g, S, E); }
    GSYNC();
    PH(10) { pg8::Gemm g{mixcat, Wmix_t, D, D, D, 0, 0}; pg8::StaticOrder S; S.init(ML, D, D, G, bid); EpiRes E{out, out, Pc, mod + 5 * 1024, 1.0f}; pg8::gemm_phase(lds, g, S, E); }
    GSYNC();
    PH(11) for (int m = gw; m < ML; m += NGW) { const int set = m < SEQ ? 0 : 1;
        norm_mod_row(out + (size_t)m * D, norm_g + 2048, mod + set * NMODW + 6 * 1024, mod + set * NMODW + 7 * 1024, Hn + (size_t)m * D, lane); }
    GSYNC();
    PH(12) { pg8::Gemm g{Hn, W13b, D, D, D, 0, 0}; pg8::StaticOrder S; S.init(ML, 2 * FF, D, G, bid); EpiUp E{Ubuf}; pg8::gemm_phase(lds, g, S, E); }
    GSYNC();
    PH(13) { pg8::Gemm g{Ubuf, W2b, FF, FF, FF, 0, 0}; pg8::StaticOrder S; S.init(ML, D, FF, G, bid); EpiRes E{out, out, Pc, mod + 8 * 1024, 0.5f}; pg8::gemm_phase(lds, g, S, E); }
    GSYNC();
    for (int xs_ = 0; xs_ < XSYNC; ++xs_) GSYNC();
    PH(14) {
        const float* fg = a.in[23];
        for (int m = gw; m < ML; m += NGW) { f32x4* xr = (f32x4*)(out + (size_t)m * D) + lane; f32x4 v[4]; float s = 0.f;
#pragma unroll
            for (int j = 0; j < 4; ++j) { v[j] = xr[64 * j]; s += (v[j].x * v[j].x + v[j].y * v[j].y) + (v[j].z * v[j].z + v[j].w * v[j].w); }
            const float r = 1.0f / sqrtf(wave_sum(s) * (1.f / D) + EPS);
#pragma unroll
            for (int j = 0; j < 4; ++j) xr[64 * j] = (v[j] * r) * ((const f32x4*)fg)[lane + 64 * j]; }
    }
#if TPROBE
    GSYNC();
    if (bid == 0) { __syncthreads();
        long K = TPROBE == 2 ? 400000 : (long)(tsb[TSEL_B] - tsb[TSEL_A]) * 5; if (K > 900000) K = 900000; if (K < 0) K = 0;
        for (long i = tid; i < K; i += 512) out[i] += 0.02f; }
#endif
}

#undef ws
#undef xin_
#undef cvec
#undef ctx
#undef cctx
#undef norm_g
#undef w_ada
#undef b_ada
#undef mod
#undef Hctx
#undef Win_t
#undef Wmix_t
#undef Wglu_t
#undef BB
#undef Ktab
#undef PW
#undef W13a
#undef W2a
#undef W13b
#undef W2b
#undef Wst
#undef Bs5
#undef Hn
#undef mixcat
#undef X1c
#undef Uctx
#undef Pc
#undef Ubuf
#undef poolb
#undef As5
#undef Sbuf
#undef Ybuf
#undef out
extern "C" void kernel_launch(void* const* d_in, const int* in_sizes, int n_in, void* d_out, int out_size, void* d_ws, size_t ws_size, hipStream_t stream) {
    static int grid = 0;
    if (grid == 0) {
        if (n_in != 24 || out_size != ML * D || ws_size < WS_END) { fprintf(stderr, "kernel_launch: unexpected shapes (n_in %d out %d ws %zu)\n", n_in, out_size, ws_size); grid = -1; return; }
        int dev = 0, cus = 0, per_cu = 0;
        hipGetDevice(&dev); hipDeviceGetAttribute(&cus, hipDeviceAttributeMultiprocessorCount, dev);
        hipFuncSetAttribute((const void*)fwd_megakernel, hipFuncAttributeMaxDynamicSharedMemorySize, LDS_BYTES);
        if (hipOccupancyMaxActiveBlocksPerMultiprocessor(&per_cu, (const void*)fwd_megakernel, 512, LDS_BYTES) != hipSuccess || per_cu < 1) per_cu = 1;
        (void)hipGetLastError();
        grid = cus * 1;
        if (grid <= 0) grid = 256;
    }
    if (grid < 0) return;
    KArgs a{};
    for (int i = 0; i < 24; ++i) a.in[i] = (const float*)d_in[i];
    a.out = (float*)d_out; a.ws = (unsigned char*)d_ws;
    void* args[] = {&a};
    hipError_t e = hipLaunchCooperativeKernel((const void*)fwd_megakernel, dim3(grid), dim3(512), args, LDS_BYTES, stream);
    if (e != hipSuccess) fprintf(stderr, "cooperative launch failed: %s (grid %d)\n", hipGetErrorString(e), grid);
}
```

```cpp
#include <hip/hip_runtime.h>
#include <hip/hip_cooperative_groups.h>
#include <cstdio>
#include <cstdint>
namespace cg = cooperative_groups;

#define LAS __attribute__((address_space(3)))
typedef unsigned short bf16_t;
typedef short bf16x8 __attribute__((ext_vector_type(8)));
typedef float f32x4 __attribute__((ext_vector_type(4)));
typedef float f32x2 __attribute__((ext_vector_type(2)));
typedef unsigned u32x4 __attribute__((ext_vector_type(4)));
typedef unsigned u32x2 __attribute__((ext_vector_type(2)));

__device__ __forceinline__ unsigned cvt_pk_bf16(float lo, float hi) { unsigned r; asm volatile("v_cvt_pk_bf16_f32 %0, %1, %2" : "=v"(r) : "v"(lo), "v"(hi)); return r; }
__device__ __forceinline__ float bf_lo(unsigned w) { return __builtin_bit_cast(float, w << 16); }
__device__ __forceinline__ float bf_hi(unsigned w) { return __builtin_bit_cast(float, w & 0xffff0000u); }
__device__ __forceinline__ float bf2f(bf16_t h) { return __builtin_bit_cast(float, ((unsigned)h) << 16); }
__device__ __forceinline__ float sigmoid_fast(float x) { return __builtin_amdgcn_rcpf(1.f + __expf(-x)); }
__device__ __forceinline__ float silu_fast(float x) { return x * sigmoid_fast(x); }
__device__ __forceinline__ float gelu_tanh(float x) { const float z = 1.5957691216057308f * (x + 0.044715f * x * x * x); return x * sigmoid_fast(z); }

namespace pg8 {
constexpr int BM = 256, BK = 64, HALF = 128, HTB = HALF * BK * 2, STAGE_BYTES = 8 * HTB, NXCD = 8, WGM = 8;
__host__ __device__ __forceinline__ int lds_byte(int r, int c) { const int st = (r >> 4) * 2 + (c >> 5), rr = r & 15, cc = c & 31, ob = rr * 64 + cc * 2; return st * 1024 + (ob ^ (((ob >> 9) & 1) << 5)); }
__host__ __device__ __forceinline__ void stage_rc(int b, int& R, int& C) { const int st = b / 1024, sb = b % 1024, swz = sb ^ (((sb >> 9) & 1) << 5); R = (st >> 1) * 16 + swz / 64; C = (st & 1) * 32 + (swz % 64) / 2; }
__host__ __device__ __forceinline__ int perm32(int rho) { const int n = rho >> 4, i = rho & 15; return 8 * (i >> 2) + 4 * n + (i & 3); }

struct Unit { int pm, pn, g, k0, nt; };
struct Gemm { const bf16_t* A; const bf16_t* Bt; int lda, ldb, K; size_t gsA, gsB; };

struct StaticOrder {
    int nM, nN, nwg, G, c, ntf;
    __device__ void init(int M, int N, int K, int G_, int c_) { nM = M / BM; nN = N / BM; nwg = nM * nN; G = G_; c = c_; ntf = K / BK; }
    __device__ bool next(int i, Unit& u) const { const long L = (long)i * G + c; if (L >= nwg) return false; unit_of((int)L, u); return true; }
    __device__ void unit_of(int L, Unit& u) const {
        int wgid = L; { const int q = nwg / NXCD, r = nwg % NXCD, xcd = wgid % NXCD, off = wgid / NXCD; wgid = (xcd < r ? xcd * (q + 1) : r * (q + 1) + (xcd - r) * q) + off; }
        const int nig = WGM * nN, gid = wgid / nig, fm = gid * WGM, gsz = (nM - fm) < WGM ? (nM - fm) : WGM;
        u.pm = fm + ((wgid % nig) % gsz); u.pn = (wgid % nig) / gsz; u.g = 0; u.k0 = 0; u.nt = ntf;
    }
};
struct TailOrder {
    StaticOrder base; int nmini, nks, pn0, npn;
    __device__ void init(int M, int N, int K, int G_, int c_, int nmini_, int nks_, int pn0_, int npn_) { base.init(M, N, K, G_, c_); nmini = nmini_; nks = nks_; pn0 = pn0_; npn = npn_; }
    __device__ bool next(int i, Unit& u) const {
        const long L = (long)i * base.G + base.c; if (L < base.nwg) { base.unit_of((int)L, u); return true; }
        const int idx = (int)(L - base.nwg); if (idx >= nmini) return false;
        const int ks = idx % nks, t = idx / nks; u.pm = 64 + t / npn; u.pn = pn0 + t % npn; u.g = 0; u.k0 = ks * 256; u.nt = 4; return true;
    }
};
struct GroupOrder {
    int nM, nN, ng, G, c, ntf;
    __device__ void init(int nM_, int nN_, int ng_, int K, int G_, int c_) { nM = nM_; nN = nN_; ng = ng_; G = G_; c = c_; ntf = K / BK; }
    __device__ bool next(int i, Unit& u) const {
        if (c >= G) return false;
        const long L = (long)i * G + c; if (L >= (long)ng * nM * nN) return false;
        const int per = nM * nN, l = (int)L; u.g = l / per; const int r = l % per; u.pm = r / nN; u.pn = r % nN; u.k0 = 0; u.nt = ntf; return true;
    }
};

template <class Epi, class Sched>
__device__ __forceinline__ void gemm_phase(LAS unsigned char* lds, const Gemm g, const Sched& S, const Epi& E) {
    int tid_ = threadIdx.x; asm volatile("" : "+v"(tid_));
    const int tid = tid_, wid = __builtin_amdgcn_readfirstlane(tid >> 6), lane = tid & 63, wr = wid >> 2, wc = wid & 3, fr = lane & 15, fq = lane >> 4;
    unsigned voffA[2], voffB[2];
#pragma unroll
    for (int i = 0; i < 2; ++i) { int R, C; stage_rc(tid * 16 + i * 8192, R, C); const int Rb = Epi::PERM ? ((R & ~31) + perm32(R & 31)) : R;
        voffA[i] = (unsigned)(R * g.lda + C) * 2u; voffB[i] = (unsigned)(Rb * g.ldb + C) * 2u; }
    const size_t kstep = (size_t)(BK * 2);
    const size_t hstepA = (size_t)HALF * g.lda * 2, hstepB = (size_t)HALF * g.ldb * 2;
    const size_t tstepA = 2 * hstepA, tstepB = 2 * hstepB;
    const unsigned ldsw = (unsigned)wid * 1024u;
    const int aoff = lds_byte(wr * 64 + fr, fq * 8), boff = lds_byte(wc * 32 + fr, fq * 8);
#define PG8_SA(b, h) (((b) * 2 + (h)) * HTB)
#define PG8_SB(b, h) ((4 + (b) * 2 + (h)) * HTB)
#define PG8_STAGE(bufoff, gbase, voff) do { _Pragma("unroll") for (int _i = 0; _i < 2; ++_i) \
        __builtin_amdgcn_global_load_lds((const unsigned*)((const char*)(gbase) + (voff)[_i]), (LAS unsigned*)(lds + (bufoff) + ldsw + _i * 8192), 16, 0, 0); } while (0)
#define PG8_LDA(dst, b, h) do { _Pragma("unroll") for (int m = 0; m < 4; ++m) _Pragma("unroll") for (int k = 0; k < 2; ++k) dst[m][k] = *(const LAS bf16x8*)(lds + PG8_SA(b, h) + aoff + m * 2048 + k * 1024); } while (0)
#define PG8_LDB(dst, b, h) do { _Pragma("unroll") for (int n = 0; n < 2; ++n) _Pragma("unroll") for (int k = 0; k < 2; ++k) dst[n][k] = *(const LAS bf16x8*)(lds + PG8_SB(b, h) + boff + n * 2048 + k * 1024); } while (0)
#define PG8_MMA(ai, bj, At, Bt) do { __builtin_amdgcn_s_setprio(1); _Pragma("unroll") for (int m = 0; m < 4; ++m) _Pragma("unroll") for (int n = 0; n < 2; ++n) _Pragma("unroll") for (int k = 0; k < 2; ++k) \
        acc[ai][bj][m][n] = __builtin_amdgcn_mfma_f32_16x16x32_bf16(Bt[n][k], At[m][k], acc[ai][bj][m][n], 0, 0, 0); __builtin_amdgcn_s_setprio(0); } while (0)
#define PG8_WAIT_V(n) asm volatile("s_waitcnt vmcnt(" #n ")" ::: "memory")
#define PG8_WAIT_L(n) asm volatile("s_waitcnt lgkmcnt(" #n ")" ::: "memory")
#define PG8_BAR __builtin_amdgcn_s_barrier()
#define PG8_SCHED __builtin_amdgcn_sched_barrier(0)
    Unit cur, nxt; int ui = 0;
    if (!S.next(0, cur)) return;
    f32x4 acc[2][2][4][2];
#pragma unroll
    for (int a = 0; a < 2; ++a)
#pragma unroll
        for (int b = 0; b < 2; ++b)
#pragma unroll
            for (int m = 0; m < 4; ++m)
#pragma unroll
                for (int n = 0; n < 2; ++n) acc[a][b][m][n] = (f32x4){0.f, 0.f, 0.f, 0.f};
    bf16x8 At[4][2], B0[2][2], B1[2][2];
    const char* cA = (const char*)(g.A + (size_t)cur.g * g.gsA + cur.k0) + (size_t)cur.pm * tstepA; const char* cB = (const char*)(g.Bt + (size_t)cur.g * g.gsB + cur.k0) + (size_t)cur.pn * tstepB;
    PG8_STAGE(PG8_SB(0, 0), cB, voffB); PG8_STAGE(PG8_SB(0, 1), cB + hstepB, voffB); PG8_STAGE(PG8_SA(0, 0), cA, voffA); PG8_STAGE(PG8_SA(0, 1), cA + hstepA, voffA);
    if (wr == 1) PG8_BAR;
    PG8_WAIT_V(2); PG8_BAR;
    PG8_STAGE(PG8_SB(1, 0), cB + kstep, voffB); PG8_STAGE(PG8_SA(1, 0), cA + kstep, voffA); PG8_STAGE(PG8_SB(1, 1), cB + hstepB + kstep, voffB);
    PG8_WAIT_V(6); PG8_BAR;
    for (;;) {
        const bool has_next = S.next(ui + 1, nxt);
        const char* nA = has_next ? (const char*)(g.A + (size_t)nxt.g * g.gsA + nxt.k0) + (size_t)nxt.pm * tstepA : cA;
        const char* nB = has_next ? (const char*)(g.Bt + (size_t)nxt.g * g.gsB + nxt.k0) + (size_t)nxt.pn * tstepB : cB;
        const int nt = cur.nt;
        for (int t = 0; t < nt; t += 2) {
            const bool last = (t == nt - 2);
            const char* a1 = cA + (size_t)(t + 1) * kstep;
            const char* a2 = last ? nA : cA + (size_t)(t + 2) * kstep; const char* b2 = last ? nB : cB + (size_t)(t + 2) * kstep;
            const char* a3 = a2 + kstep; const char* b3 = b2 + kstep;
            PG8_LDB(B0, 0, 0); PG8_LDB(B1, 0, 1); PG8_SCHED; PG8_LDA(At, 0, 0); PG8_STAGE(PG8_SA(1, 1), a1 + hstepA, voffA);
            PG8_WAIT_V(8); PG8_WAIT_L(0); PG8_BAR; PG8_MMA(0, 0, At, B0); PG8_MMA(0, 1, At, B1); PG8_BAR; PG8_SCHED;
            PG8_LDA(At, 0, 1); PG8_STAGE(PG8_SB(0, 0), b2, voffB); PG8_STAGE(PG8_SB(0, 1), b2 + hstepB, voffB); PG8_STAGE(PG8_SA(0, 0), a2, voffA);
            PG8_WAIT_V(8); PG8_WAIT_L(0); PG8_BAR; PG8_MMA(1, 0, At, B0); PG8_MMA(1, 1, At, B1); PG8_BAR; PG8_SCHED;
            PG8_LDB(B0, 1, 0); PG8_LDB(B1, 1, 1); PG8_SCHED; PG8_LDA(At, 1, 0); PG8_STAGE(PG8_SA(0, 1), a2 + hstepA, voffA);
            PG8_WAIT_V(8); PG8_WAIT_L(0); PG8_BAR; PG8_MMA(0, 0, At, B0); PG8_MMA(0, 1, At, B1); PG8_BAR; PG8_SCHED;
            PG8_LDA(At, 1, 1); PG8_STAGE(PG8_SB(1, 0), b3, voffB); PG8_STAGE(PG8_SB(1, 1), b3 + hstepB, voffB); PG8_STAGE(PG8_SA(1, 0), a3, voffA);
            PG8_WAIT_V(8); PG8_WAIT_L(0); PG8_BAR; PG8_MMA(1, 0, At, B0); PG8_MMA(1, 1, At, B1); PG8_BAR; PG8_SCHED;
        }
        if (wr == 0) PG8_BAR;
        E(acc, cur, wr, wc, fr, fq);
        if (!has_next) break;
#pragma unroll
        for (int a = 0; a < 2; ++a)
#pragma unroll
            for (int b = 0; b < 2; ++b)
#pragma unroll
                for (int m = 0; m < 4; ++m)
#pragma unroll
                    for (int n = 0; n < 2; ++n) acc[a][b][m][n] = (f32x4){0.f, 0.f, 0.f, 0.f};
        cur = nxt; cA = nA; cB = nB; ++ui;
        if (wr == 1) PG8_BAR;
    }
    PG8_WAIT_V(0);
    PG8_BAR;
#undef PG8_SA
#undef PG8_SB
#undef PG8_STAGE
#undef PG8_LDA
#undef PG8_LDB
#undef PG8_MMA
#undef PG8_WAIT_V
#undef PG8_WAIT_L
#undef PG8_BAR
#undef PG8_SCHED
}
}

constexpr int D = 1024, SEQ = 8192, ML = 16384, CTXL = 256, MC = 512, MALL = ML + MC, FF = 2816, NMODW = 9 * 1024;
constexpr int TCH = 32, KS5 = 768, ROWS5 = 512;
constexpr float EPS = 1e-6f;
constexpr size_t MiB = 1u << 20;
constexpr size_t WS_MOD = 128 * 1024, WS_HCTX = 512 * 1024;
constexpr size_t WS_WIN = 1 * MiB, WS_WMIX = 3 * MiB, WS_WGLU = 5 * MiB, WS_BB = 5 * MiB + 512 * 1024, WS_KTAB = 6 * MiB, WS_PW = 8 * MiB;
constexpr size_t WS_W13A = 10 * MiB, WS_W2A = 21 * MiB, WS_W13B = 27 * MiB, WS_W2B = 38 * MiB, WS_WST = 44 * MiB, WS_BS5 = 52 * MiB;
constexpr size_t WS_HN = 76 * MiB, WS_MIX = 109 * MiB, WS_X1C = 141 * MiB, WS_UCTX = 143 * MiB, WS_UB = 144 * MiB;
constexpr size_t WS_POOL = 144 * MiB, WS_AS5 = 160 * MiB, WS_S = 184 * MiB, WS_Y = 200 * MiB, WS_UCTXP = 216 * MiB, WS_END = 236 * MiB;
constexpr size_t WS_PC = WS_MIX;
constexpr int LDS_BYTES = 147456;

struct KArgs { const float* in[24]; float* out; unsigned char* ws; };

struct EpiUp {
    static constexpr bool PERM = true;
    bf16_t* O;
    __device__ __forceinline__ void operator()(const f32x4 (&acc)[2][2][4][2], const pg8::Unit& u, int wr, int wc, int fr, int fq) const {
        const int row0 = u.pm * 256 + wr * 64 + fr, f0 = u.pn * 128 + wc * 16 + 4 * fq;
#pragma unroll
        for (int ai = 0; ai < 2; ++ai)
#pragma unroll
            for (int m = 0; m < 4; ++m) { bf16_t* rowp = O + (size_t)(row0 + ai * 128 + m * 16) * FF + f0;
#pragma unroll
                for (int bj = 0; bj < 2; ++bj) { const f32x4 a = acc[ai][bj][m][0], b = acc[ai][bj][m][1];
                    u32x2 w; w.x = cvt_pk_bf16(silu_fast(a[0]) * b[0], silu_fast(a[1]) * b[1]); w.y = cvt_pk_bf16(silu_fast(a[2]) * b[2], silu_fast(a[3]) * b[3]);
                    *(u32x2*)(rowp + bj * 64) = w; } }
    }
};
struct EpiRes {
    static constexpr bool PERM = false;
    const float* resid_l; float* out_l; float* part_c; const float* gate; float coef;
    __device__ __forceinline__ void operator()(const f32x4 (&acc)[2][2][4][2], const pg8::Unit& u, int wr, int wc, int fr, int fq) const {
        const int set = u.pm < 32 ? 0 : 1;
        const int row0 = u.pm * 256 + wr * 64 + fr, col0 = u.pn * 256 + wc * 32 + 4 * fq;
        if (u.pm >= 64) { float* pb = part_c + (size_t)(u.k0 >> 8) * MC * D;
#pragma unroll
            for (int ai = 0; ai < 2; ++ai)
#pragma unroll
                for (int m = 0; m < 4; ++m) { const size_t off = (size_t)(row0 - ML + ai * 128 + m * 16) * D + col0;
#pragma unroll
                    for (int bj = 0; bj < 2; ++bj)
#pragma unroll
                        for (int n = 0; n < 2; ++n) *(f32x4*)(pb + off + bj * 128 + n * 16) = acc[ai][bj][m][n]; }
            return; }
        const float* rb = resid_l; float* ob = out_l;
        f32x4 gv[2][2];
#pragma unroll
        for (int bj = 0; bj < 2; ++bj)
#pragma unroll
            for (int n = 0; n < 2; ++n) gv[bj][n] = *(const f32x4*)(gate + set * NMODW + col0 + bj * 128 + n * 16) * coef;
#pragma unroll
        for (int am = 0; am < 4; ++am) { f32x4 rv[2][2][2];
#pragma unroll
            for (int mm = 0; mm < 2; ++mm) { const int ai = am >> 1, m = (am & 1) * 2 + mm; const size_t off = (size_t)(row0 + ai * 128 + m * 16) * D + col0;
#pragma unroll
                for (int bj = 0; bj < 2; ++bj)
#pragma unroll
                    for (int n = 0; n < 2; ++n) rv[mm][bj][n] = *(const f32x4*)(rb + off + bj * 128 + n * 16); }
            asm volatile("" ::: "memory");
#pragma unroll
            for (int mm = 0; mm < 2; ++mm) { const int ai = am >> 1, m = (am & 1) * 2 + mm; const size_t off = (size_t)(row0 + ai * 128 + m * 16) * D + col0;
#pragma unroll
                for (int bj = 0; bj < 2; ++bj)
#pragma unroll
                    for (int n = 0; n < 2; ++n) *(f32x4*)(ob + off + bj * 128 + n * 16) = rv[mm][bj][n] + gv[bj][n] * acc[ai][bj][m][n]; }
            asm volatile("" ::: "memory"); }
    }
};
struct EpiWin {
    static constexpr bool PERM = true;
    bf16_t* pool; bf16_t* As5; float* Uctx;
    __device__ __forceinline__ void operator()(const f32x4 (&acc)[2][2][4][2], const pg8::Unit& u, int wr, int wc, int fr, int fq) const {
        const int row0 = u.pm * 256 + wr * 64 + fr;
        const bool isc = u.pm >= 64, ispool = u.pn < 2;
        if (isc && ispool) return;
#pragma unroll
        for (int ai = 0; ai < 2; ++ai)
#pragma unroll
            for (int m = 0; m < 4; ++m) { const int row = row0 + ai * 128 + m * 16;
#pragma unroll
                for (int bj = 0; bj < 2; ++bj) { const int col0 = u.pn * 256 + bj * 128 + wc * 32 + 8 * fq; const f32x4 v0 = acc[ai][bj][m][0], v1 = acc[ai][bj][m][1];
                    if (isc) { float* p = Uctx + (size_t)(u.k0 >> 8) * MC * 512 + (size_t)(row - ML) * 512 + (col0 - 512); *(f32x4*)p = v0; *(f32x4*)(p + 4) = v1; }
                    else { u32x4 w; w.x = cvt_pk_bf16(v0[0], v0[1]); w.y = cvt_pk_bf16(v0[2], v0[3]); w.z = cvt_pk_bf16(v1[0], v1[1]); w.w = cvt_pk_bf16(v1[2], v1[3]);
                        const int b = row >> 13, tok = row & 8191;
                        if (ispool) { const int k = col0 >> 7, slab = (col0 >> 3) & 15; *(u32x4*)(pool + ((size_t)((b * 4 + k) * 16 + slab) * 8192 + tok) * 8) = w; }
                        else { const int cs = col0 - 512, gg = cs >> 4, c0 = cs & 15; *(u32x4*)(As5 + ((size_t)gg * ROWS5 + b * 256 + (tok >> 5)) * KS5 + (tok & 31) * 16 + c0) = w; } } } }
    }
};
struct EpiState {
    static constexpr bool PERM = false;
    float* S;
    __device__ __forceinline__ void operator()(const f32x4 (&acc)[2][2][4][2], const pg8::Unit& u, int wr, int wc, int fr, int fq) const {
        const int row0 = u.pm * 256 + wr * 64 + fr, col0 = wc * 32 + 4 * fq;
#pragma unroll
        for (int ai = 0; ai < 2; ++ai)
#pragma unroll
            for (int m = 0; m < 4; ++m) { float* rowp = S + ((size_t)u.g * ROWS5 + row0 + ai * 128 + m * 16) * 256 + col0;
#pragma unroll
                for (int bj = 0; bj < 2; ++bj)
#pragma unroll
                    for (int n = 0; n < 2; ++n) *(f32x4*)(rowp + bj * 128 + n * 16) = acc[ai][bj][m][n]; }
    }
};
struct EpiS5 {
    static constexpr bool PERM = true;
    bf16_t* Y;
    __device__ __forceinline__ void operator()(const f32x4 (&acc)[2][2][4][2], const pg8::Unit& u, int wr, int wc, int fr, int fq) const {
        const int row0 = u.pm * 256 + wr * 64 + fr;
#pragma unroll
        for (int ai = 0; ai < 2; ++ai)
#pragma unroll
            for (int m = 0; m < 4; ++m) { const int row = row0 + ai * 128 + m * 16, b = row >> 8, chunk = row & 255;
#pragma unroll
                for (int bj = 0; bj < 2; ++bj) { const int n0 = u.pn * 256 + bj * 128 + wc * 32 + 8 * fq, t = n0 >> 4, c0 = n0 & 15; const f32x4 v0 = acc[ai][bj][m][0], v1 = acc[ai][bj][m][1];
                    u32x4 w; w.x = cvt_pk_bf16(gelu_tanh(v0[0]), gelu_tanh(v0[1])); w.y = cvt_pk_bf16(gelu_tanh(v0[2]), gelu_tanh(v0[3]));
                    w.z = cvt_pk_bf16(gelu_tanh(v1[0]), gelu_tanh(v1[1])); w.w = cvt_pk_bf16(gelu_tanh(v1[2]), gelu_tanh(v1[3]));
                    *(u32x4*)(Y + (size_t)(b * SEQ + chunk * TCH + t) * 512 + u.g * 16 + c0) = w; } }
    }
};
struct EpiGlu {
    static constexpr bool PERM = true;
    const bf16_t* Y; bf16_t* mix;
    __device__ __forceinline__ void operator()(const f32x4 (&acc)[2][2][4][2], const pg8::Unit& u, int wr, int wc, int fr, int fq) const {
        const int row0 = u.pm * 256 + wr * 64 + fr;
#pragma unroll
        for (int ai = 0; ai < 2; ++ai)
#pragma unroll
            for (int m = 0; m < 4; ++m) { const int row = row0 + ai * 128 + m * 16;
#pragma unroll
                for (int bj = 0; bj < 2; ++bj) { const int col0 = u.pn * 256 + bj * 128 + wc * 32 + 8 * fq; const f32x4 v0 = acc[ai][bj][m][0], v1 = acc[ai][bj][m][1];
                    const u32x4 y = *(const u32x4*)(Y + (size_t)row * 512 + col0); u32x4 w;
                    w.x = cvt_pk_bf16(bf_lo(y.x) * sigmoid_fast(v0[0]), bf_hi(y.x) * sigmoid_fast(v0[1])); w.y = cvt_pk_bf16(bf_lo(y.y) * sigmoid_fast(v0[2]), bf_hi(y.y) * sigmoid_fast(v0[3]));
                    w.z = cvt_pk_bf16(bf_lo(y.z) * sigmoid_fast(v1[0]), bf_hi(y.z) * sigmoid_fast(v1[1])); w.w = cvt_pk_bf16(bf_lo(y.w) * sigmoid_fast(v1[2]), bf_hi(y.w) * sigmoid_fast(v1[3]));
                    *(u32x4*)(mix + (size_t)row * D + 512 + col0) = w; } }
    }
};

__device__ __forceinline__ float wave_sum(float v) {
#pragma unroll
    for (int o = 1; o < 64; o <<= 1) v += __shfl_xor(v, o);
    return v;
}
__device__ __forceinline__ void transpose_item(const float* W, int ldw, bf16_t* WT, int ldd, int mode, LAS float* scr, int kb, int nb, int lane) {
    const int k0 = 64 * kb, n0 = 32 * nb;
#pragma unroll 8
    for (int i = 0; i < 32; ++i) { const int kk = 2 * i + (lane >> 5); scr[kk * 33 + (lane & 31)] = W[(size_t)(k0 + kk) * ldw + n0 + (lane & 31)]; }
    asm volatile("s_waitcnt lgkmcnt(0)" ::: "memory");
    const int c = lane & 7;
#pragma unroll
    for (int j = 0; j < 4; ++j) { const int n = (lane >> 3) + 8 * j, ncol = n0 + n; const LAS float* s = scr + (8 * c) * 33 + n;
        const int row = mode == 0 ? ncol : (8 * (ncol >> 2) + (ncol & 3) + (mode == 2 ? 4 : 0));
        u32x4 o; o.x = cvt_pk_bf16(s[0 * 33], s[1 * 33]); o.y = cvt_pk_bf16(s[2 * 33], s[3 * 33]); o.z = cvt_pk_bf16(s[4 * 33], s[5 * 33]); o.w = cvt_pk_bf16(s[6 * 33], s[7 * 33]);
        *(u32x4*)(WT + (size_t)row * ldd + k0 + 8 * c) = o; }
    asm volatile("s_waitcnt lgkmcnt(0)" ::: "memory");
}
__device__ __forceinline__ void norm_mod_row(const float* xrow, const float* g, const float* shift, const float* scale, bf16_t* orow, int lane) {
    const f32x4* xr = (const f32x4*)xrow + lane; f32x4 v[4]; float s = 0.f;
#pragma unroll
    for (int j = 0; j < 4; ++j) { v[j] = xr[64 * j]; s += (v[j].x * v[j].x + v[j].y * v[j].y) + (v[j].z * v[j].z + v[j].w * v[j].w); }
    const float r = 1.0f / sqrtf(wave_sum(s) * (1.f / D) + EPS);
    u32x2* o8 = (u32x2*)orow + lane;
#pragma unroll
    for (int j = 0; j < 4; ++j) { const f32x4 gg = ((const f32x4*)g)[lane + 64 * j], sh = ((const f32x4*)shift)[lane + 64 * j], sc = ((const f32x4*)scale)[lane + 64 * j];
        const f32x4 y = (v[j] * r) * gg; const f32x4 h = y * (sc + 1.0f) + sh; u32x2 w; w.x = cvt_pk_bf16(h.x, h.y); w.y = cvt_pk_bf16(h.z, h.w); o8[64 * j] = w; }
}


#define XB_TMO      128
#define XB_XCNT(j)  (256  + 64 * (j))
#define XB_XSUB(j)  (1280 + 64 * (j))
#define XB_XGEN(j)  (2304 + 64 * (j))
#define XB_TOP      3328
#define XB_TOPGEN   3392
#define XCD_BAR_WORDS 3456
#define XB_SPIN_CAP (1u << 22)
__device__ __forceinline__ unsigned xb_ld(unsigned* p)              { return __hip_atomic_load(p, __ATOMIC_RELAXED, __HIP_MEMORY_SCOPE_AGENT); }
__device__ __forceinline__ unsigned xb_add(unsigned* p, unsigned v) { return __hip_atomic_fetch_add(p, v, __ATOMIC_RELAXED, __HIP_MEMORY_SCOPE_AGENT); }
__device__ __forceinline__ unsigned xb_xcc_id() { return (unsigned)__builtin_amdgcn_s_getreg((3 << 11) | 20) & 0xFu; }
#define XB_SPIN(cond, bar) do { unsigned _sp = 0; while (cond) { __builtin_amdgcn_s_sleep(1); \
    if ((++_sp & 255u) == 0u) { if (xb_ld(&(bar)[XB_TMO])) break; if (_sp > XB_SPIN_CAP) { atomicAdd(&(bar)[XB_TMO], 1u); break; } } } } while (0)
struct XcdBarrier { unsigned* bar; unsigned x; volatile LAS unsigned* st; };
__device__ __forceinline__ XcdBarrier xcd_barrier_post(unsigned* bar, volatile LAS unsigned* st) {
    XcdBarrier b; b.bar = bar; b.x = xb_xcc_id(); b.st = st;
    if (threadIdx.x == 0) (void)xb_add(&bar[XB_XCNT(b.x)], 1u);
    return b;
}
__device__ __forceinline__ void xcd_barrier_complete(unsigned* bar, unsigned x, unsigned& nloc, unsigned& nx) {
    const unsigned G = gridDim.x * gridDim.y * gridDim.z;
    unsigned sum, cnt, mine, sp = 0u;
    for (;;) {
        sum = 0u; cnt = 0u; mine = 0u;
#pragma unroll
        for (unsigned j = 0; j < 16; ++j) { const unsigned c = xb_ld(&bar[XB_XCNT(j)]); sum += c; cnt += (c > 0u) ? 1u : 0u; mine = (j == x) ? c : mine; }
        if (sum == G) break;
        __builtin_amdgcn_s_sleep(1);
        if ((++sp & 255u) == 0u) { if (xb_ld(&bar[XB_TMO])) break; if (sp > XB_SPIN_CAP) { atomicAdd(&bar[XB_TMO], 1u); break; } }
    }
    nloc = mine > 0u ? mine : 1u; nx = cnt > 0u ? cnt : 1u;
}
__device__ __forceinline__ void xcd_barrier(const XcdBarrier& b) {
    asm volatile("s_waitcnt vmcnt(0)" ::: "memory");
    __syncthreads();
    if (threadIdx.x == 0) {
        unsigned* bar = b.bar;
        __builtin_amdgcn_s_waitcnt(0);
        unsigned nloc = b.st[0], nx = b.st[1];
        if (nloc == 0u) { xcd_barrier_complete(bar, b.x, nloc, nx); b.st[0] = nloc; b.st[1] = nx; }
        const unsigned old = xb_add(&bar[XB_XSUB(b.x)], 1u);
        const unsigned gen = old / nloc;
        if (old + 1u == (gen + 1u) * nloc) {
            __builtin_amdgcn_fence(__ATOMIC_RELEASE, "agent");
            asm volatile("s_waitcnt vmcnt(0)" ::: "memory");
            const unsigned og = xb_add(&bar[XB_TOP], 1u);
            const unsigned tg = og / nx;
            if (og + 1u == (tg + 1u) * nx) xb_add(&bar[XB_TOPGEN], 1u);
            else XB_SPIN(xb_ld(&bar[XB_TOPGEN]) == tg, bar);
            __builtin_amdgcn_fence(__ATOMIC_ACQUIRE, "agent");
            xb_add(&bar[XB_XGEN(b.x)], 1u);
            asm volatile("s_waitcnt vmcnt(0)" ::: "memory");
        } else {
            XB_SPIN(xb_ld(&bar[XB_XGEN(b.x)]) == gen, bar);
            __builtin_amdgcn_fence(__ATOMIC_ACQUIRE, "agent");
            asm volatile("s_waitcnt vmcnt(0)" ::: "memory");
        }
    }
    __syncthreads();
}
#ifndef PHMASK
#define PHMASK 0xFFFFF
#endif
#ifndef REPMASK
#define REPMASK 0
#endif
#ifndef XSYNC
#define XSYNC 0
#endif
#define PH(k) for (int rep_ = 0; rep_ < 1 + (((REPMASK) >> (k)) & 1); ++rep_) if constexpr (((PHMASK) >> (k)) & 1)

template <int W>
__device__ __forceinline__ void pool_rows(LAS bf16_t* raw, LAS float* rowb, LAS bf16_t* ob, bf16_t* dst  , int tid, int r_begin, int r_end) {
    constexpr int lo = W / 2, hi = W - 1 - lo;
    const int c = tid >> 3, ch = tid & 7;
    const int clo = c - lo < 0 ? 0 : c - lo, chi = c + hi > 63 ? 63 : c + hi; const float icc = 1.0f / (float)(chi - clo + 1);
    float vs = 0.f;
    { const int ra = r_begin - lo < 0 ? 0 : r_begin - lo, rz = r_begin + hi > 127 ? 127 : r_begin + hi;
      for (int r = ra; r <= rz; ++r) vs += bf2f(raw[(r * 64 + c) * 8 + ch]); }
#pragma unroll 1
    for (int r = r_begin; r < r_end; r += 4) {
#pragma unroll
        for (int q = 0; q < 4; ++q) { const int rq = r + q, rlo = rq - lo < 0 ? 0 : rq - lo, rhi = rq + hi > 127 ? 127 : rq + hi;
            rowb[q * 512 + tid] = vs * __builtin_amdgcn_rcpf((float)(rhi - rlo + 1));
            if (rq + 1 + hi <= 127) vs += bf2f(raw[((rq + 1 + hi) * 64 + c) * 8 + ch]);
            if (rq - lo >= 0) vs -= bf2f(raw[((rq - lo) * 64 + c) * 8 + ch]); }
        __syncthreads();
#pragma unroll
        for (int q = 0; q < 4; ++q) { float hv[W];
#pragma unroll
            for (int i = 0; i < W; ++i) { int c2 = c - lo + i; c2 = c2 < 0 ? 0 : (c2 > 63 ? 63 : c2); hv[i] = rowb[q * 512 + c2 * 8 + ch]; }
            float hs = 0.f;
#pragma unroll
            for (int i = 0; i < W; ++i) { const int c2 = c - lo + i; hs += (c2 >= 0 && c2 <= 63) ? hv[i] : 0.f; }
            const float dval = hs * icc - bf2f(raw[((r + q) * 64 + c) * 8 + ch]);
            ob[q * 512 + tid] = (bf16_t)(cvt_pk_bf16(dval, 0.f) & 0xffffu); }
        __syncthreads();
        if (tid < 256) { const int q = tid >> 6, cc = tid & 63; *(u32x4*)(dst + (size_t)((r + q) * 64 + cc) * D) = *(const LAS u32x4*)(ob + q * 512 + cc * 8); }
    }
}

__global__ void __launch_bounds__(512, 2) fwd_megakernel(KArgs a) {
    extern __shared__ __attribute__((aligned(16))) unsigned char lds_raw[];
    LAS unsigned char* lds = (LAS unsigned char*)lds_raw;
    cg::grid_group grid = cg::this_grid();
    const int tid = threadIdx.x, lane = tid & 63, wave = __builtin_amdgcn_readfirstlane(tid >> 6);
    const int G = gridDim.x, bid = blockIdx.x;
    const int gw = bid * 8 + wave, NGW = G * 8;
    volatile LAS unsigned* bst = (volatile LAS unsigned*)(lds + LDS_BYTES - 64);
    if (tid == 0) { bst[0] = 0u; bst[1] = 0u; }
    __syncthreads();
    if (bid == 0) for (int i = tid; i < XCD_BAR_WORDS; i += 512) ((unsigned*)a.ws)[i] = 0u;
#ifndef TPROBE
#define TPROBE 0
#endif
#ifndef TSEL_A
#define TSEL_A 0
#define TSEL_B 1
#endif
#if TPROBE
    unsigned long long* tsb = (unsigned long long*)(a.ws + 65536); int tsi = 1;
    if (bid == 0 && tid == 0) tsb[0] = __builtin_amdgcn_s_memrealtime();
#define TSTAMP() do { if (bid == 0 && tid == 0) tsb[tsi] = __builtin_amdgcn_s_memrealtime(); ++tsi; } while (0)
#else
#define TSTAMP() do {} while (0)
#endif
#define GSYNC() do { xcd_barrier(xbar); TSTAMP(); } while (0)
#define ws (a.ws)
#define xin_ (a.in[0])
#define cvec (a.in[1])
#define ctx (a.in[2])
#define cctx (a.in[3])
#define norm_g (a.in[4])
#define w_ada (a.in[5])
#define b_ada (a.in[6])
#define mod ((float*)(ws + WS_MOD))
#define Hctx ((f32x2*)(ws + WS_HCTX))
#define Win_t ((bf16_t*)(ws + WS_WIN))
#define Wmix_t ((bf16_t*)(ws + WS_WMIX))
#define Wglu_t ((bf16_t*)(ws + WS_WGLU))
#define BB ((f32x2*)(ws + WS_BB))
#define Ktab ((float*)(ws + WS_KTAB))
#define PW ((f32x2*)(ws + WS_PW))
#define W13a ((bf16_t*)(ws + WS_W13A))
#define W2a ((bf16_t*)(ws + WS_W2A))
#define W13b ((bf16_t*)(ws + WS_W13B))
#define W2b ((bf16_t*)(ws + WS_W2B))
#define Wst ((bf16_t*)(ws + WS_WST))
#define Bs5 ((bf16_t*)(ws + WS_BS5))
#define Hn ((bf16_t*)(ws + WS_HN))
#define mixcat ((bf16_t*)(ws + WS_MIX))
#define X1c ((float*)(ws + WS_X1C))
#define Uctx ((float*)(ws + WS_UCTXP))
#define Pc ((float*)(ws + WS_PC))
#define Ubuf ((bf16_t*)(ws + WS_UB))
#define poolb ((bf16_t*)(ws + WS_POOL))
#define As5 ((bf16_t*)(ws + WS_AS5))
#define Sbuf ((float*)(ws + WS_S))
#define Ybuf ((bf16_t*)(ws + WS_Y))
#define out (a.out)

    PH(0) {
        if (bid == 0 && tid == 0) *(unsigned*)(ws + 69632) = 0u;
        LAS float* sc = (LAS float*)lds;
        LAS float* red = (LAS float*)(lds + 16384);
        for (int i = tid; i < 3072; i += 512) { const float v = i < 2048 ? cvec[i] : cctx[i - 2048]; sc[i] = v / (1.f + expf(-v)); }
        __syncthreads();
        for (int strip = bid; strip < 256; strip += G) {
            const int cg4 = tid % 9, kk = tid / 9;
            f32x4 a0 = {0.f, 0.f, 0.f, 0.f}, a1 = a0, a2 = a0;
            if (tid < 504) {
#pragma unroll
                for (int it = 0; it < 19; ++it) { const int k = kk + 56 * it; if (k < 1024) { const f32x4 w = *(const f32x4*)(w_ada + (size_t)k * NMODW + strip * 36 + cg4 * 4);
                    a0 += w * sc[k]; a1 += w * sc[1024 + k]; a2 += w * sc[2048 + k]; } }
#pragma unroll
                for (int i = 0; i < 4; ++i) { red[kk * 112 + cg4 * 4 + i] = a0[i]; red[kk * 112 + 36 + cg4 * 4 + i] = a1[i]; red[kk * 112 + 72 + cg4 * 4 + i] = a2[i]; }
            }
            __syncthreads();
            if (tid < 108) { float s = 0.f;
#pragma unroll 8
                for (int k2 = 0; k2 < 56; ++k2) s += red[k2 * 112 + tid];
                const int r = tid / 36, col = strip * 36 + (tid % 36); mod[r * NMODW + col] = s + b_ada[col]; }
            __syncthreads();
        }
        LAS f32x2* pwL = (LAS f32x2*)(lds + 65536);
        LAS f32x2* bbL = (LAS f32x2*)(lds + 65536 + 17408);
        LAS f32x2* cL = (LAS f32x2*)(lds + 65536 + 17408 + 8192);
        const float* a_re = a.in[13]; const float* a_im = a.in[14]; const float* log_dt = a.in[15]; const float* b_re = a.in[16]; const float* b_im = a.in[17];
        const float* c_re = a.in[18]; const float* c_im = a.in[19];
#pragma unroll 1
        for (int it2 = G - 1 - bid; it2 < 256; it2 += G) {
            const int it = it2 >> 2, qq = it2 & 3; const bool wr_tab = qq == 0;
            const int g = it >> 1, dir = it & 1, pd = dir * 32 + g;
            const float dt = expf(log_dt[pd]);
            for (int idx = tid; idx < 33 * 64; idx += 512) { const int tau = idx >> 6, p = idx & 63; const float are = a_re[pd * 64 + p], aim = a_im[pd * 64 + p];
                const float mag = expf(are * dt * (float)tau); double ang = (double)aim * (double)dt * (double)tau; ang -= 6.283185307179586 * rint(ang * 0.15915494309189535);
                float sn, cs; sincosf((float)ang, &sn, &cs); const f32x2 v = {mag * cs, mag * sn}; pwL[idx] = v; if (wr_tab) PW[(size_t)it * 33 * 64 + idx] = v; }
            for (int idx = tid; idx < 1024; idx += 512) { const f32x2 v = {c_re[(size_t)pd * 1024 + idx], c_im[(size_t)pd * 1024 + idx]}; cL[idx] = v; }
            __syncthreads();
            for (int idx = tid; idx < 1024; idx += 512) { const int p = idx >> 4; const float are = a_re[pd * 64 + p], aim = a_im[pd * 64 + p]; const float zr = are * dt, zi = aim * dt;
                float qr, qi;
                if (zr * zr + zi * zi < 0.25f) { float tr = 1.f, ti = 0.f;
                    for (int k = 12; k >= 2; --k) { const float ik = 1.0f / (float)k, wr_ = zr * ik, wi_ = zi * ik; const float nr = 1.f + (wr_ * tr - wi_ * ti), ni = wr_ * ti + wi_ * tr; tr = nr; ti = ni; }
                    qr = dt * tr; qi = dt * ti; }
                else { const f32x2 ab = pwL[64 + p]; const float nr = ab.x - 1.f, ni = ab.y, den = are * are + aim * aim; qr = (nr * are + ni * aim) / den; qi = (ni * are - nr * aim) / den; }
                const float br = b_re[(size_t)g * 1024 + idx], bi = b_im[(size_t)g * 1024 + idx];
                const f32x2 v = {qr * br - qi * bi, qr * bi + qi * br}; bbL[idx] = v; if (wr_tab) BB[(size_t)it * 1024 + idx] = v; }
            __syncthreads();
#pragma unroll 1
            for (int j = 0; j < 4; ++j) { const int idx = qq * 2048 + tid + 512 * j, tau = idx >> 8, c = (idx >> 4) & 15, cc = idx & 15; float s = 0.f;
#pragma unroll 8
                for (int p = 0; p < 64; ++p) { const f32x2 C = cL[c * 64 + p], w = pwL[tau * 64 + p], b = bbL[p * 16 + cc]; const float zr = C.x * w.x - C.y * w.y, zi = C.x * w.y + C.y * w.x; s += zr * b.x - zi * b.y; }
                Ktab[(size_t)it * 8192 + idx] = s; }
            __syncthreads();
        }
    }
    grid.sync(); TSTAMP();
    const XcdBarrier xbar = xcd_barrier_post((unsigned*)ws, bst);

    PH(1) {
        LAS float* scr = (LAS float*)(lds + wave * 16384);
        constexpr int I_UP = 16 * 88, I_DN = 44 * 32, I_IN = 16 * 32, I_OUT = 8 * 32, I_GLU = 8 * 16;
        constexpr int NITEMS = 4 * I_UP + 2 * I_DN + I_IN + I_OUT + I_GLU;
        for (int it = gw; it < NITEMS; it += NGW) {
            int r = it;
            if (r < I_UP) { transpose_item(a.in[7], FF, W13a, D, 1, scr, r / 88, r % 88, lane); continue; } r -= I_UP;
            if (r < I_UP) { transpose_item(a.in[8], FF, W13a, D, 2, scr, r / 88, r % 88, lane); continue; } r -= I_UP;
            if (r < I_DN) { transpose_item(a.in[9], D, W2a, FF, 0, scr, r / 32, r % 32, lane); continue; } r -= I_DN;
            if (r < I_UP) { transpose_item(a.in[7] + (size_t)D * FF, FF, W13b, D, 1, scr, r / 88, r % 88, lane); continue; } r -= I_UP;
            if (r < I_UP) { transpose_item(a.in[8] + (size_t)D * FF, FF, W13b, D, 2, scr, r / 88, r % 88, lane); continue; } r -= I_UP;
            if (r < I_DN) { transpose_item(a.in[9] + (size_t)D * FF, D, W2b, FF, 0, scr, r / 32, r % 32, lane); continue; } r -= I_DN;
            if (r < I_IN) { transpose_item(a.in[10], D, Win_t, D, 0, scr, r / 32, r % 32, lane); continue; } r -= I_IN;
            if (r < I_OUT) { transpose_item(a.in[22] + (size_t)512 * D, D, Wmix_t + 512, D, 0, scr, r / 32, r % 32, lane); continue; } r -= I_OUT;
            transpose_item(a.in[21], 512, Wglu_t, 512, 0, scr, r / 16, r % 16, lane);
        }
        {
            const float* pool_w = a.in[11]; const float* pool_scale = a.in[12]; const float* w_out = a.in[22];
            for (int it = G - 1 - bid; it < 256; it += G) { const int k = it >> 6, cb = (it >> 2) & 15, nq = it & 3, n = nq * 256 + (tid & 255), c4 = cb * 8 + (tid >> 8) * 4;
                float ac[4] = {0.f, 0.f, 0.f, 0.f};
#pragma unroll 8
                for (int d = 0; d < 128; ++d) { const float wo = w_out[(size_t)(k * 128 + d) * D + n] * pool_scale[k * 128 + d];
#pragma unroll
                    for (int i = 0; i < 4; ++i) ac[i] += wo * pool_w[(size_t)(k * 128 + c4 + i) * 128 + d]; }
                u32x2 w0; w0.x = cvt_pk_bf16(ac[0], ac[1]); w0.y = cvt_pk_bf16(ac[2], ac[3]);
                *(u32x2*)(Wmix_t + (size_t)n * D + k * 128 + c4) = w0; }
        }
        {
            const float* c_re = a.in[18]; const float* c_im = a.in[19]; const float* dskip = a.in[20];
            const int gt = bid * 512 + tid, NT = G * 512;
            for (int e = gt; e < 32 * 512 * 96; e += NT) { const int k8 = e % 96, n = (e / 96) & 511, g = e / (96 * 512), t = n >> 4, c = n & 15; float v[8];
                if (k8 < 64) { const int s = k8 >> 1, c0 = (k8 & 1) * 8;
#pragma unroll
                    for (int i = 0; i < 8; ++i) v[i] = 0.f;
                    if (s <= t) { const float* kp = Ktab + ((size_t)((g * 2 + 0) * 32 + (t - s)) * 256 + c * 16 + c0); const f32x4 k0 = *(const f32x4*)kp, k1 = *(const f32x4*)(kp + 4);
                        v[0] += k0.x; v[1] += k0.y; v[2] += k0.z; v[3] += k0.w; v[4] += k1.x; v[5] += k1.y; v[6] += k1.z; v[7] += k1.w; }
                    if (s >= t) { const float* kp = Ktab + ((size_t)((g * 2 + 1) * 32 + (s - t)) * 256 + c * 16 + c0); const f32x4 k0 = *(const f32x4*)kp, k1 = *(const f32x4*)(kp + 4);
                        v[0] += k0.x; v[1] += k0.y; v[2] += k0.z; v[3] += k0.w; v[4] += k1.x; v[5] += k1.y; v[6] += k1.z; v[7] += k1.w; }
                    if (s == t) { const float dv = dskip[g * 16 + c];
#pragma unroll
                        for (int i = 0; i < 8; ++i) if (c0 + i == c) v[i] += dv; }
                } else { const int j = k8 - 64, dir = j >> 4, p0 = (j & 15) * 4, ex = dir == 0 ? t + 1 : 32 - t;
#pragma unroll
                    for (int i = 0; i < 4; ++i) { const int p = p0 + i; const size_t ci = ((size_t)(dir * 32 + g) * 16 + c) * 64 + p; const float cr = c_re[ci], cim = c_im[ci]; const f32x2 w = PW[((size_t)(g * 2 + dir) * 33 + ex) * 64 + p];
                        const float zr = cr * w.x - cim * w.y, zi = cr * w.y + cim * w.x; v[2 * i] = zr; v[2 * i + 1] = -zi; } }
                u32x4 o; o.x = cvt_pk_bf16(v[0], v[1]); o.y = cvt_pk_bf16(v[2], v[3]); o.z = cvt_pk_bf16(v[4], v[5]); o.w = cvt_pk_bf16(v[6], v[7]);
                *(u32x4*)(Bs5 + ((size_t)g * 512 + n) * KS5 + k8 * 8) = o; }
            for (int e = gt; e < 32 * 256 * 64; e += NT) { const int k8 = e & 63, n = (e >> 6) & 255, g = e >> 14, dir = n >> 7, reim = n & 1, p = (n >> 1) & 63, s = k8 >> 1, c0 = (k8 & 1) * 8, ex = dir == 0 ? 31 - s : s;
                const f32x2 w = PW[((size_t)(g * 2 + dir) * 33 + ex) * 64 + p]; float v[8];
#pragma unroll
                for (int i = 0; i < 8; ++i) { const f32x2 b = BB[((size_t)(g * 2 + dir) * 64 + p) * 16 + c0 + i]; v[i] = reim ? (w.x * b.y + w.y * b.x) : (w.x * b.x - w.y * b.y); }
                u32x4 o; o.x = cvt_pk_bf16(v[0], v[1]); o.y = cvt_pk_bf16(v[2], v[3]); o.z = cvt_pk_bf16(v[4], v[5]); o.w = cvt_pk_bf16(v[6], v[7]);
                *(u32x4*)(Wst + ((size_t)g * 256 + n) * 512 + k8 * 8) = o; }
        }
        for (int m = gw; m < MALL; m += NGW) { const int set = m < SEQ ? 0 : (m < ML ? 1 : 2); const float* src = m < ML ? xin_ + (size_t)m * D : ctx + (size_t)(m - ML) * D;
            norm_mod_row(src, norm_g, mod + set * NMODW + 0 * 1024, mod + set * NMODW + 1 * 1024, Hn + (size_t)m * D, lane); }
    }
    GSYNC();

    PH(2) { pg8::Gemm g{Hn, W13a, D, D, D, 0, 0}; pg8::StaticOrder S; S.init(MALL, 2 * FF, D, G, bid); EpiUp E{Ubuf}; pg8::gemm_phase(lds, g, S, E); }
    GSYNC();
    PH(3) { pg8::Gemm g{Ubuf, W2a, FF, FF, FF, 0, 0}; pg8::TailOrder S; S.init(ML, D, FF, G, bid, 88, 11, 0, 4); EpiRes E{xin_, out, Pc, mod + 2 * 1024, 0.5f}; pg8::gemm_phase(lds, g, S, E); }
    GSYNC();
    PH(4) {
        for (int m = (gw & 3) == 0 ? (gw >> 2) : MC; m < MC; m += (NGW + 3) >> 2) {
            const f32x4* xr = (const f32x4*)(ctx + (size_t)m * D) + lane; f32x4 v[4]; float ss = 0.f;
#pragma unroll
            for (int j = 0; j < 4; ++j) { f32x4 p = {0.f, 0.f, 0.f, 0.f};
#pragma unroll
                for (int ks = 0; ks < 11; ++ks) p += ((const f32x4*)(Pc + (size_t)ks * MC * D + (size_t)m * D))[lane + 64 * j];
                v[j] = xr[64 * j] + (((const f32x4*)(mod + 2 * NMODW + 2 * 1024))[lane + 64 * j] * 0.5f) * p;
                ss += (v[j].x * v[j].x + v[j].y * v[j].y) + (v[j].z * v[j].z + v[j].w * v[j].w); }
            const float r = 1.0f / sqrtf(wave_sum(ss) * (1.f / D) + EPS);
            u32x2* o8 = (u32x2*)(Hn + (size_t)(ML + m) * D) + lane;
#pragma unroll
            for (int j = 0; j < 4; ++j) { const f32x4 gg = ((const f32x4*)(norm_g + 1024))[lane + 64 * j], sh = ((const f32x4*)(mod + 2 * NMODW + 3 * 1024))[lane + 64 * j], sc = ((const f32x4*)(mod + 2 * NMODW + 4 * 1024))[lane + 64 * j];
                const f32x4 y = (v[j] * r) * gg; const f32x4 h = y * (sc + 1.0f) + sh; u32x2 w; w.x = cvt_pk_bf16(h.x, h.y); w.y = cvt_pk_bf16(h.z, h.w); o8[64 * j] = w; }
        }
        for (int m = gw; m < ML; m += NGW) { const int set = m < SEQ ? 0 : 1;
            norm_mod_row(out + (size_t)m * D, norm_g + 1024, mod + set * NMODW + 3 * 1024, mod + set * NMODW + 4 * 1024, Hn + (size_t)m * D, lane); }
    }
    GSYNC();
    PH(5) { pg8::Gemm g{Hn, Win_t, D, D, D, 0, 0}; pg8::TailOrder S; S.init(ML, D, D, G, bid, 16, 4, 2, 2); EpiWin E{poolb, As5, Uctx}; pg8::gemm_phase(lds, g, S, E); }
    GSYNC();
    PH(6) {
        const int Gg = G < 64 ? G : 64;
        { pg8::Gemm g{As5, Wst, KS5, 512, 512, (size_t)ROWS5 * KS5, (size_t)256 * 512}; pg8::GroupOrder S; S.init(2, 1, 32, 512, Gg, bid); EpiState E{Sbuf}; pg8::gemm_phase(lds, g, S, E); }
        const int r1 = (bid + G - Gg % G) % G;
        for (int it = r1; it < 16; it += G) { const int wi = it * 8 + wave, b = wi >> 6, g = (wi >> 1) & 31, dir = wi & 1, g0 = (it & 7) * 4;
            LAS float* ul = (LAS float*)lds;
            __syncthreads();
#pragma unroll 2
            for (int i = 0; i < 8; ++i) { const int idx = i * 512 + tid, t = idx >> 4, q = idx & 15; const size_t off = (size_t)(b * CTXL + t) * 512 + g0 * 16 + q * 4;
                const f32x4 s4 = (*(const f32x4*)(Uctx + off) + *(const f32x4*)(Uctx + (size_t)MC * 512 + off)) + (*(const f32x4*)(Uctx + (size_t)2 * MC * 512 + off) + *(const f32x4*)(Uctx + (size_t)3 * MC * 512 + off));
                *(LAS f32x4*)(ul + t * 64 + q * 4) = s4; }
            const f32x2 av = PW[((size_t)(g * 2 + dir) * 33 + 1) * 64 + lane]; f32x2 bb[16];
#pragma unroll
            for (int i = 0; i < 16; ++i) bb[i] = BB[((size_t)(g * 2 + dir) * 64 + lane) * 16 + i];
            __syncthreads();
            float hr = 0.f, hi = 0.f; const int gl = (wave >> 1) * 16;
#pragma unroll 4
            for (int step = 0; step < CTXL; ++step) { const int t = dir == 0 ? step : CTXL - 1 - step; const LAS f32x4* up = (const LAS f32x4*)(ul + t * 64 + gl);
                const f32x4 u0 = up[0], u1 = up[1], u2 = up[2], u3 = up[3]; f32x2 sa = {0.f, 0.f}, sb = {0.f, 0.f};
#pragma unroll
                for (int i = 0; i < 4; ++i) { sa += bb[i] * u0[i]; sb += bb[4 + i] * u1[i]; }
#pragma unroll
                for (int i = 0; i < 4; ++i) { sa += bb[8 + i] * u2[i]; sb += bb[12 + i] * u3[i]; }
                const f32x2 sv = sa + sb;
                const float nr = av.x * hr - av.y * hi + sv.x, ni = av.x * hi + av.y * hr + sv.y; hr = nr; hi = ni; }
            Hctx[(size_t)wi * 64 + lane] = (f32x2){hr, hi}; }
        {
            unsigned* pctr = (unsigned*)(ws + 69632);
            volatile LAS unsigned* sh_it = (volatile LAS unsigned*)(lds + LDS_BYTES - 32);
            LAS bf16_t* raw = (LAS bf16_t*)lds;
            LAS float* rowb = (LAS float*)(lds + 131072);
            LAS bf16_t* ob = (LAS bf16_t*)(lds + 131072 + 8192);
            for (;;) {
                __syncthreads();
                if (tid == 0) *sh_it = __hip_atomic_fetch_add(pctr, 1u, __ATOMIC_RELAXED, __HIP_MEMORY_SCOPE_AGENT);
                __syncthreads();
                const int it = (int)*sh_it;
                if (it >= 512) break;
                const int k = 3 - (it >> 7), bs = (it & 127) >> 2, r_begin = (it & 3) * 32, r_end = r_begin + 32, b = bs >> 4, slab = bs & 15;
                const int w = 2 << k, lo = w >> 1, hi = w - 1 - lo, ra = r_begin - lo < 0 ? 0 : r_begin - lo, rz = r_end - 1 + hi > 127 ? 127 : r_end - 1 + hi, ntok = (rz - ra + 1) * 64;
                const bf16_t* src = poolb + (size_t)((b * 4 + k) * 16 + slab) * 8192 * 8;
                for (int i = tid; i < ntok; i += 512) { const int tok = ra * 64 + i; *(LAS u32x4*)(raw + tok * 8) = *(const u32x4*)(src + (size_t)tok * 8); }
                __syncthreads();
                bf16_t* dst = mixcat + (size_t)b * SEQ * D + k * 128 + slab * 8;
                if (k == 0) pool_rows<2>(raw, rowb, ob, dst, tid, r_begin, r_end); else if (k == 1) pool_rows<4>(raw, rowb, ob, dst, tid, r_begin, r_end); else if (k == 2) pool_rows<8>(raw, rowb, ob, dst, tid, r_begin, r_end); else pool_rows<16>(raw, rowb, ob, dst, tid, r_begin, r_end);
            }
        }
    }
    GSYNC();
    PH(7) for (int wi = bid; wi < 128; wi += G) {
        const int b = wi >> 6, g = (wi >> 1) & 31, dir = wi & 1; const size_t rbase = (size_t)g * ROWS5 + b * 256;
        LAS float* sl = (LAS float*)lds;
        __syncthreads();
#pragma unroll 4
        for (int i = 0; i < 16; ++i) { const int row = i * 16 + (tid >> 5), q = tid & 31; *(LAS f32x4*)(sl + row * 128 + q * 4) = *(const f32x4*)(Sbuf + (rbase + row) * 256 + dir * 128 + q * 4); }
        __syncthreads();
        if (wave == 0) { const f32x2 a32 = PW[((size_t)(g * 2 + dir) * 33 + 32) * 64 + lane]; f32x2 h = Hctx[(size_t)wi * 64 + lane];
#pragma unroll 8
            for (int step = 0; step < 256; ++step) { const int j = dir == 0 ? step : 255 - step; const f32x2 sv = *(const LAS f32x2*)(sl + j * 128 + lane * 2);
                *(unsigned*)(As5 + (rbase + j) * KS5 + 512 + dir * 128 + lane * 2) = cvt_pk_bf16(h.x, h.y);
                const float nr = a32.x * h.x - a32.y * h.y + sv.x, ni = a32.x * h.y + a32.y * h.x + sv.y; h.x = nr; h.y = ni; } }
    }
    GSYNC();
    PH(8) { pg8::Gemm g{As5, Bs5, KS5, KS5, KS5, (size_t)ROWS5 * KS5, (size_t)512 * KS5}; pg8::GroupOrder S; S.init(2, 2, 32, KS5, G, bid); EpiS5 E{Ybuf}; pg8::gemm_phase(lds, g, S, E); }
    GSYNC();
    PH(9) { pg8::Gemm g{Ybuf, Wglu_t, 512, 512, 512, 0, 0}; pg8::StaticOrder S; S.init(ML, 512, 512, G, bid); EpiGlu E{Ybuf, mixcat}; pg8::gemm_phase(lds, g, S, E); }
    GSYNC();
    PH(10) { pg8::Gemm g{mixcat, Wmix_t, D, D, D, 0, 0}; pg8::StaticOrder S; S.init(ML, D, D, G, bid); EpiRes E{out, out, Pc, mod + 5 * 1024, 1.0f}; pg8::gemm_phase(lds, g, S, E); }
    GSYNC();
    PH(11) for (int m = gw; m < ML; m += NGW) { const int set = m < SEQ ? 0 : 1;
        norm_mod_row(out + (size_t)m * D, norm_g + 2048, mod + set * NMODW + 6 * 1024, mod + set * NMODW + 7 * 1024, Hn + (size_t)m * D, lane); }
    GSYNC();
    PH(12) { pg8::Gemm g{Hn, W13b, D, D, D, 0, 0}; pg8::StaticOrder S; S.init(ML, 2 * FF, D, G, bid); EpiUp E{Ubuf}; pg8::gemm_phase(lds, g, S, E); }
    GSYNC();
    PH(13) { pg8::Gemm g{Ubuf, W2b, FF, FF, FF, 0, 0}; pg8::StaticOrder S; S.init(ML, D, FF, G, bid); EpiRes E{out, out, Pc, mod + 8 * 1024, 0.5f}; pg8::gemm_phase(lds, g, S, E); }
    GSYNC();
    for (int xs_ = 0; xs_ < XSYNC; ++xs_) GSYNC();
    PH(14) {
        const float* fg = a.in[23];
        for (int m = gw; m < ML; m += NGW) { f32x4* xr = (f32x4*)(out + (size_t)m * D) + lane; f32x4 v[4]; float s = 0.f;
#pragma unroll
            for (int j = 0; j < 4; ++j) { v[j] = xr[64 * j]; s += (v[j].x * v[j].x + v[j].y * v[j].y) + (v[j].z * v[j].z + v[j].w * v[j].w); }
            const float r = 1.0f / sqrtf(wave_sum(s) * (1.f / D) + EPS);
#pragma unroll
            for (int j = 0; j < 4; ++j) xr[64 * j] = (v[j] * r) * ((const f32x4*)fg)[lane + 64 * j]; }
    }
#if TPROBE
    GSYNC();
    if (bid == 0) { __syncthreads();
        long K = TPROBE == 2 ? 400000 : (long)(tsb[TSEL_B] - tsb[TSEL_A]) * 5; if (K > 900000) K = 900000; if (K < 0) K = 0;
        for (long i = tid; i < K; i += 512) out[i] += 0.02f; }
#endif
}

#undef ws
#undef xin_
#undef cvec
#undef ctx
#undef cctx
#undef norm_g
#undef w_ada
#undef b_ada
#undef mod
#undef Hctx
#undef Win_t
#undef Wmix_t
#undef Wglu_t
#undef BB
#undef Ktab
#undef PW
#undef W13a
#undef W2a
#undef W13b
#undef W2b
#undef Wst
#undef Bs5
#undef Hn
#undef mixcat
#undef X1c
#undef Uctx
#undef Pc
#undef Ubuf
#undef poolb
#undef As5
#undef Sbuf
#undef Ybuf
#undef out
extern "C" void kernel_launch(void* const* d_in, const int* in_sizes, int n_in, void* d_out, int out_size, void* d_ws, size_t ws_size, hipStream_t stream) {
    static int grid = 0;
    if (grid == 0) {
        if (n_in != 24 || out_size != ML * D || ws_size < WS_END) { fprintf(stderr, "kernel_launch: unexpected shapes (n_in %d out %d ws %zu)\n", n_in, out_size, ws_size); grid = -1; return; }
        int dev = 0, cus = 0, per_cu = 0;
        hipGetDevice(&dev); hipDeviceGetAttribute(&cus, hipDeviceAttributeMultiprocessorCount, dev);
        hipFuncSetAttribute((const void*)fwd_megakernel, hipFuncAttributeMaxDynamicSharedMemorySize, LDS_BYTES);
        if (hipOccupancyMaxActiveBlocksPerMultiprocessor(&per_cu, (const void*)fwd_megakernel, 512, LDS_BYTES) != hipSuccess || per_cu < 1) per_cu = 1;
        (void)hipGetLastError();
        grid = cus * 1;
        if (grid <= 0) grid = 256;
    }
    if (grid < 0) return;
    KArgs a{};
    for (int i = 0; i < 24; ++i) a.in[i] = (const float*)d_in[i];
    a.out = (float*)d_out; a.ws = (unsigned char*)d_ws;
    void* args[] = {&a};
    hipError_t e = hipLaunchCooperativeKernel((const void*)fwd_megakernel, dim3(grid), dim3(512), args, LDS_BYTES, stream);
    if (e != hipSuccess) fprintf(stderr, "cooperative launch failed: %s (grid %d)\n", hipGetErrorString(e), grid);
}
```

```cpp
#include <hip/hip_runtime.h>
#include <hip/hip_cooperative_groups.h>
#include <cstdio>
#include <cstdint>
namespace cg = cooperative_groups;

#define LAS __attribute__((address_space(3)))
typedef unsigned short bf16_t;
typedef short bf16x8 __attribute__((ext_vector_type(8)));
typedef float f32x4 __attribute__((ext_vector_type(4)));
typedef float f32x2 __attribute__((ext_vector_type(2)));
typedef unsigned u32x4 __attribute__((ext_vector_type(4)));
typedef unsigned u32x2 __attribute__((ext_vector_type(2)));

__device__ __forceinline__ unsigned cvt_pk_bf16(float lo, float hi) { unsigned r; asm volatile("v_cvt_pk_bf16_f32 %0, %1, %2" : "=v"(r) : "v"(lo), "v"(hi)); return r; }
__device__ __forceinline__ float bf_lo(unsigned w) { return __builtin_bit_cast(float, w << 16); }
__device__ __forceinline__ float bf_hi(unsigned w) { return __builtin_bit_cast(float, w & 0xffff0000u); }
__device__ __forceinline__ float bf2f(bf16_t h) { return __builtin_bit_cast(float, ((unsigned)h) << 16); }
__device__ __forceinline__ float sigmoid_fast(float x) { return __builtin_amdgcn_rcpf(1.f + __expf(-x)); }
__device__ __forceinline__ float silu_fast(float x) { return x * sigmoid_fast(x); }
__device__ __forceinline__ float gelu_tanh(float x) { const float z = 1.5957691216057308f * (x + 0.044715f * x * x * x); return x * sigmoid_fast(z); }

namespace pg8 {
constexpr int BM = 256, BK = 64, HALF = 128, HTB = HALF * BK * 2, STAGE_BYTES = 8 * HTB, NXCD = 8, WGM = 8;
__host__ __device__ __forceinline__ int lds_byte(int r, int c) { const int st = (r >> 4) * 2 + (c >> 5), rr = r & 15, cc = c & 31, ob = rr * 64 + cc * 2; return st * 1024 + (ob ^ (((ob >> 9) & 1) << 5)); }
__host__ __device__ __forceinline__ void stage_rc(int b, int& R, int& C) { const int st = b / 1024, sb = b % 1024, swz = sb ^ (((sb >> 9) & 1) << 5); R = (st >> 1) * 16 + swz / 64; C = (st & 1) * 32 + (swz % 64) / 2; }
__host__ __device__ __forceinline__ int perm32(int rho) { const int n = rho >> 4, i = rho & 15; return 8 * (i >> 2) + 4 * n + (i & 3); }

struct Unit { int pm, pn, g, k0, nt; };
struct Gemm { const bf16_t* A; const bf16_t* Bt; int lda, ldb, K; size_t gsA, gsB; };

struct StaticOrder {
    int nM, nN, nwg, G, c, ntf;
    __device__ void init(int M, int N, int K, int G_, int c_) { nM = M / BM; nN = N / BM; nwg = nM * nN; G = G_; c = c_; ntf = K / BK; }
    __device__ bool next(int i, Unit& u) const { const long L = (long)i * G + c; if (L >= nwg) return false; unit_of((int)L, u); return true; }
    __device__ void unit_of(int L, Unit& u) const {
        int wgid = L; { const int q = nwg / NXCD, r = nwg % NXCD, xcd = wgid % NXCD, off = wgid / NXCD; wgid = (xcd < r ? xcd * (q + 1) : r * (q + 1) + (xcd - r) * q) + off; }
        const int nig = WGM * nN, gid = wgid / nig, fm = gid * WGM, gsz = (nM - fm) < WGM ? (nM - fm) : WGM;
        u.pm = fm + ((wgid % nig) % gsz); u.pn = (wgid % nig) / gsz; u.g = 0; u.k0 = 0; u.nt = ntf;
    }
};
struct TailOrder {
    StaticOrder base; int nmini, nks, pn0, npn;
    __device__ void init(int M, int N, int K, int G_, int c_, int nmini_, int nks_, int pn0_, int npn_) { base.init(M, N, K, G_, c_); nmini = nmini_; nks = nks_; pn0 = pn0_; npn = npn_; }
    __device__ bool next(int i, Unit& u) const {
        const long L = (long)i * base.G + base.c; if (L < base.nwg) { base.unit_of((int)L, u); return true; }
        const int idx = (int)(L - base.nwg); if (idx >= nmini) return false;
        const int ks = idx % nks, t = idx / nks; u.pm = 64 + t / npn; u.pn = pn0 + t % npn; u.g = 0; u.k0 = ks * 256; u.nt = 4; return true;
    }
};
struct GroupOrder {
    int nM, nN, ng, G, c, ntf;
    __device__ void init(int nM_, int nN_, int ng_, int K, int G_, int c_) { nM = nM_; nN = nN_; ng = ng_; G = G_; c = c_; ntf = K / BK; }
    __device__ bool next(int i, Unit& u) const {
        if (c >= G) return false;
        const long L = (long)i * G + c; if (L >= (long)ng * nM * nN) return false;
        const int per = nM * nN, l = (int)L; u.g = l / per; const int r = l % per; u.pm = r / nN; u.pn = r % nN; u.k0 = 0; u.nt = ntf; return true;
    }
};

template <class Epi, class Sched>
__device__ __forceinline__ void gemm_phase(LAS unsigned char* lds, const Gemm g, const Sched& S, const Epi& E) {
    int tid_ = threadIdx.x; asm volatile("" : "+v"(tid_));
    const int tid = tid_, wid = __builtin_amdgcn_readfirstlane(tid >> 6), lane = tid & 63, wr = wid >> 2, wc = wid & 3, fr = lane & 15, fq = lane >> 4;
    unsigned voffA[2], voffB[2];
#pragma unroll
    for (int i = 0; i < 2; ++i) { int R, C; stage_rc(tid * 16 + i * 8192, R, C); const int Rb = Epi::PERM ? ((R & ~31) + perm32(R & 31)) : R;
        voffA[i] = (unsigned)(R * g.lda + C) * 2u; voffB[i] = (unsigned)(Rb * g.ldb + C) * 2u; }
    const size_t kstep = (size_t)(BK * 2);
    const size_t hstepA = (size_t)HALF * g.lda * 2, hstepB = (size_t)HALF * g.ldb * 2;
    const size_t tstepA = 2 * hstepA, tstepB = 2 * hstepB;
    const unsigned ldsw = (unsigned)wid * 1024u;
    const int aoff = lds_byte(wr * 64 + fr, fq * 8), boff = lds_byte(wc * 32 + fr, fq * 8);
#define PG8_SA(b, h) (((b) * 2 + (h)) * HTB)
#define PG8_SB(b, h) ((4 + (b) * 2 + (h)) * HTB)
#define PG8_STAGE(bufoff, gbase, voff) do { _Pragma("unroll") for (int _i = 0; _i < 2; ++_i) \
        __builtin_amdgcn_global_load_lds((const unsigned*)((const char*)(gbase) + (voff)[_i]), (LAS unsigned*)(lds + (bufoff) + ldsw + _i * 8192), 16, 0, 0); } while (0)
#define PG8_LDA(dst, b, h) do { _Pragma("unroll") for (int m = 0; m < 4; ++m) _Pragma("unroll") for (int k = 0; k < 2; ++k) dst[m][k] = *(const LAS bf16x8*)(lds + PG8_SA(b, h) + aoff + m * 2048 + k * 1024); } while (0)
#define PG8_LDB(dst, b, h) do { _Pragma("unroll") for (int n = 0; n < 2; ++n) _Pragma("unroll") for (int k = 0; k < 2; ++k) dst[n][k] = *(const LAS bf16x8*)(lds + PG8_SB(b, h) + boff + n * 2048 + k * 1024); } while (0)
#define PG8_MMA(ai, bj, At, Bt) do { __builtin_amdgcn_s_setprio(1); _Pragma("unroll") for (int m = 0; m < 4; ++m) _Pragma("unroll") for (int n = 0; n < 2; ++n) _Pragma("unroll") for (int k = 0; k < 2; ++k) \
        acc[ai][bj][m][n] = __builtin_amdgcn_mfma_f32_16x16x32_bf16(Bt[n][k], At[m][k], acc[ai][bj][m][n], 0, 0, 0); __builtin_amdgcn_s_setprio(0); } while (0)
#define PG8_WAIT_V(n) asm volatile("s_waitcnt vmcnt(" #n ")" ::: "memory")
#define PG8_WAIT_L(n) asm volatile("s_waitcnt lgkmcnt(" #n ")" ::: "memory")
#define PG8_BAR __builtin_amdgcn_s_barrier()
#define PG8_SCHED __builtin_amdgcn_sched_barrier(0)
    Unit cur, nxt; int ui = 0;
    if (!S.next(0, cur)) return;
    f32x4 acc[2][2][4][2];
#pragma unroll
    for (int a = 0; a < 2; ++a)
#pragma unroll
        for (int b = 0; b < 2; ++b)
#pragma unroll
            for (int m = 0; m < 4; ++m)
#pragma unroll
                for (int n = 0; n < 2; ++n) acc[a][b][m][n] = (f32x4){0.f, 0.f, 0.f, 0.f};
    bf16x8 At[4][2], B0[2][2], B1[2][2];
    const char* cA = (const char*)(g.A + (size_t)cur.g * g.gsA + cur.k0) + (size_t)cur.pm * tstepA; const char* cB = (const char*)(g.Bt + (size_t)cur.g * g.gsB + cur.k0) + (size_t)cur.pn * tstepB;
    PG8_STAGE(PG8_SB(0, 0), cB, voffB); PG8_STAGE(PG8_SB(0, 1), cB + hstepB, voffB); PG8_STAGE(PG8_SA(0, 0), cA, voffA); PG8_STAGE(PG8_SA(0, 1), cA + hstepA, voffA);
    if (wr == 1) PG8_BAR;
    PG8_WAIT_V(2); PG8_BAR;
    PG8_STAGE(PG8_SB(1, 0), cB + kstep, voffB); PG8_STAGE(PG8_SA(1, 0), cA + kstep, voffA); PG8_STAGE(PG8_SB(1, 1), cB + hstepB + kstep, voffB);
    PG8_WAIT_V(6); PG8_BAR;
    for (;;) {
        const bool has_next = S.next(ui + 1, nxt);
        const char* nA = has_next ? (const char*)(g.A + (size_t)nxt.g * g.gsA + nxt.k0) + (size_t)nxt.pm * tstepA : cA;
        const char* nB = has_next ? (const char*)(g.Bt + (size_t)nxt.g * g.gsB + nxt.k0) + (size_t)nxt.pn * tstepB : cB;
        const int nt = cur.nt;
        for (int t = 0; t < nt; t += 2) {
            const bool last = (t == nt - 2);
            const char* a1 = cA + (size_t)(t + 1) * kstep;
            const char* a2 = last ? nA : cA + (size_t)(t + 2) * kstep; const char* b2 = last ? nB : cB + (size_t)(t + 2) * kstep;
            const char* a3 = a2 + kstep; const char* b3 = b2 + kstep;
            PG8_LDB(B0, 0, 0); PG8_LDB(B1, 0, 1); PG8_SCHED; PG8_LDA(At, 0, 0); PG8_STAGE(PG8_SA(1, 1), a1 + hstepA, voffA);
            PG8_WAIT_V(8); PG8_WAIT_L(0); PG8_BAR; PG8_MMA(0, 0, At, B0); PG8_MMA(0, 1, At, B1); PG8_BAR; PG8_SCHED;
            PG8_LDA(At, 0, 1); PG8_STAGE(PG8_SB(0, 0), b2, voffB); PG8_STAGE(PG8_SB(0, 1), b2 + hstepB, voffB); PG8_STAGE(PG8_SA(0, 0), a2, voffA);
            PG8_WAIT_V(8); PG8_WAIT_L(0); PG8_BAR; PG8_MMA(1, 0, At, B0); PG8_MMA(1, 1, At, B1); PG8_BAR; PG8_SCHED;
            PG8_LDB(B0, 1, 0); PG8_LDB(B1, 1, 1); PG8_SCHED; PG8_LDA(At, 1, 0); PG8_STAGE(PG8_SA(0, 1), a2 + hstepA, voffA);
            PG8_WAIT_V(8); PG8_WAIT_L(0); PG8_BAR; PG8_MMA(0, 0, At, B0); PG8_MMA(0, 1, At, B1); PG8_BAR; PG8_SCHED;
            PG8_LDA(At, 1, 1); PG8_STAGE(PG8_SB(1, 0), b3, voffB); PG8_STAGE(PG8_SB(1, 1), b3 + hstepB, voffB); PG8_STAGE(PG8_SA(1, 0), a3, voffA);
            PG8_WAIT_V(8); PG8_WAIT_L(0); PG8_BAR; PG8_MMA(1, 0, At, B0); PG8_MMA(1, 1, At, B1); PG8_BAR; PG8_SCHED;
        }
        if (wr == 0) PG8_BAR;
        E(acc, cur, wr, wc, fr, fq);
        if (!has_next) break;
#pragma unroll
        for (int a = 0; a < 2; ++a)
#pragma unroll
            for (int b = 0; b < 2; ++b)
#pragma unroll
                for (int m = 0; m < 4; ++m)
#pragma unroll
                    for (int n = 0; n < 2; ++n) acc[a][b][m][n] = (f32x4){0.f, 0.f, 0.f, 0.f};
        cur = nxt; cA = nA; cB = nB; ++ui;
        if (wr == 1) PG8_BAR;
    }
    PG8_WAIT_V(0);
    PG8_BAR;
#undef PG8_SA
#undef PG8_SB
#undef PG8_STAGE
#undef PG8_LDA
#undef PG8_LDB
#undef PG8_MMA
#undef PG8_WAIT_V
#undef PG8_WAIT_L
#undef PG8_BAR
#undef PG8_SCHED
}
}

constexpr int D = 1024, SEQ = 8192, ML = 16384, CTXL = 256, MC = 512, MALL = ML + MC, FF = 2816, NMODW = 9 * 1024;
constexpr int TCH = 32, KS5 = 768, ROWS5 = 512;
constexpr float EPS = 1e-6f;
constexpr size_t MiB = 1u << 20;
constexpr size_t WS_MOD = 128 * 1024, WS_HCTX = 512 * 1024;
constexpr size_t WS_WIN = 1 * MiB, WS_WMIX = 3 * MiB, WS_WGLU = 5 * MiB, WS_BB = 5 * MiB + 512 * 1024, WS_KTAB = 6 * MiB, WS_PW = 8 * MiB;
constexpr size_t WS_W13A = 10 * MiB, WS_W2A = 21 * MiB, WS_W13B = 27 * MiB, WS_W2B = 38 * MiB, WS_WST = 44 * MiB, WS_BS5 = 52 * MiB;
constexpr size_t WS_HN = 76 * MiB, WS_MIX = 109 * MiB, WS_X1C = 141 * MiB, WS_UCTX = 143 * MiB, WS_UB = 144 * MiB;
constexpr size_t WS_POOL = 144 * MiB, WS_AS5 = 160 * MiB, WS_S = 184 * MiB, WS_Y = 200 * MiB, WS_UCTXP = 216 * MiB, WS_END = 236 * MiB;
constexpr size_t WS_PC = WS_MIX;
constexpr int LDS_BYTES = 147456;

struct KArgs { const float* in[24]; float* out; unsigned char* ws; };

struct EpiUp {
    static constexpr bool PERM = true;
    bf16_t* O;
    __device__ __forceinline__ void operator()(const f32x4 (&acc)[2][2][4][2], const pg8::Unit& u, int wr, int wc, int fr, int fq) const {
        const int row0 = u.pm * 256 + wr * 64 + fr, f0 = u.pn * 128 + wc * 16 + 4 * fq;
#pragma unroll
        for (int ai = 0; ai < 2; ++ai)
#pragma unroll
            for (int m = 0; m < 4; ++m) { bf16_t* rowp = O + (size_t)(row0 + ai * 128 + m * 16) * FF + f0;
#pragma unroll
                for (int bj = 0; bj < 2; ++bj) { const f32x4 a = acc[ai][bj][m][0], b = acc[ai][bj][m][1];
                    u32x2 w; w.x = cvt_pk_bf16(silu_fast(a[0]) * b[0], silu_fast(a[1]) * b[1]); w.y = cvt_pk_bf16(silu_fast(a[2]) * b[2], silu_fast(a[3]) * b[3]);
                    *(u32x2*)(rowp + bj * 64) = w; } }
    }
};
struct EpiRes {
    static constexpr bool PERM = false;
    const float* resid_l; float* out_l; float* part_c; const float* gate; float coef;
    __device__ __forceinline__ void operator()(const f32x4 (&acc)[2][2][4][2], const pg8::Unit& u, int wr, int wc, int fr, int fq) const {
        const int set = u.pm < 32 ? 0 : 1;
        const int row0 = u.pm * 256 + wr * 64 + fr, col0 = u.pn * 256 + wc * 32 + 4 * fq;
        if (u.pm >= 64) { float* pb = part_c + (size_t)(u.k0 >> 8) * MC * D;
#pragma unroll
            for (int ai = 0; ai < 2; ++ai)
#pragma unroll
                for (int m = 0; m < 4; ++m) { const size_t off = (size_t)(row0 - ML + ai * 128 + m * 16) * D + col0;
#pragma unroll
                    for (int bj = 0; bj < 2; ++bj)
#pragma unroll
                        for (int n = 0; n < 2; ++n) *(f32x4*)(pb + off + bj * 128 + n * 16) = acc[ai][bj][m][n]; }
            return; }
        const float* rb = resid_l; float* ob = out_l;
        f32x4 gv[2][2];
#pragma unroll
        for (int bj = 0; bj < 2; ++bj)
#pragma unroll
            for (int n = 0; n < 2; ++n) gv[bj][n] = *(const f32x4*)(gate + set * NMODW + col0 + bj * 128 + n * 16) * coef;
#pragma unroll
        for (int am = 0; am < 4; ++am) { f32x4 rv[2][2][2];
#pragma unroll
            for (int mm = 0; mm < 2; ++mm) { const int ai = am >> 1, m = (am & 1) * 2 + mm; const size_t off = (size_t)(row0 + ai * 128 + m * 16) * D + col0;
#pragma unroll
                for (int bj = 0; bj < 2; ++bj)
#pragma unroll
                    for (int n = 0; n < 2; ++n) rv[mm][bj][n] = *(const f32x4*)(rb + off + bj * 128 + n * 16); }
            asm volatile("" ::: "memory");
#pragma unroll
            for (int mm = 0; mm < 2; ++mm) { const int ai = am >> 1, m = (am & 1) * 2 + mm; const size_t off = (size_t)(row0 + ai * 128 + m * 16) * D + col0;
#pragma unroll
                for (int bj = 0; bj < 2; ++bj)
#pragma unroll
                    for (int n = 0; n < 2; ++n) *(f32x4*)(ob + off + bj * 128 + n * 16) = rv[mm][bj][n] + gv[bj][n] * acc[ai][bj][m][n]; }
            asm volatile("" ::: "memory"); }
    }
};
struct EpiWin {
    static constexpr bool PERM = true;
    bf16_t* pool; bf16_t* As5; float* Uctx;
    __device__ __forceinline__ void operator()(const f32x4 (&acc)[2][2][4][2], const pg8::Unit& u, int wr, int wc, int fr, int fq) const {
        const int row0 = u.pm * 256 + wr * 64 + fr;
        const bool isc = u.pm >= 64, ispool = u.pn < 2;
        if (isc && ispool) return;
#pragma unroll
        for (int ai = 0; ai < 2; ++ai)
#pragma unroll
            for (int m = 0; m < 4; ++m) { const int row = row0 + ai * 128 + m * 16;
#pragma unroll
                for (int bj = 0; bj < 2; ++bj) { const int col0 = u.pn * 256 + bj * 128 + wc * 32 + 8 * fq; const f32x4 v0 = acc[ai][bj][m][0], v1 = acc[ai][bj][m][1];
                    if (isc) { float* p = Uctx + (size_t)(u.k0 >> 8) * MC * 512 + (size_t)(row - ML) * 512 + (col0 - 512); *(f32x4*)p = v0; *(f32x4*)(p + 4) = v1; }
                    else { u32x4 w; w.x = cvt_pk_bf16(v0[0], v0[1]); w.y = cvt_pk_bf16(v0[2], v0[3]); w.z = cvt_pk_bf16(v1[0], v1[1]); w.w = cvt_pk_bf16(v1[2], v1[3]);
                        const int b = row >> 13, tok = row & 8191;
                        if (ispool) { const int k = col0 >> 7, slab = (col0 >> 3) & 15; *(u32x4*)(pool + ((size_t)((b * 4 + k) * 16 + slab) * 8192 + tok) * 8) = w; }
                        else { const int cs = col0 - 512, gg = cs >> 4, c0 = cs & 15; *(u32x4*)(As5 + ((size_t)gg * ROWS5 + b * 256 + (tok >> 5)) * KS5 + (tok & 31) * 16 + c0) = w; } } } }
    }
};
struct EpiState {
    static constexpr bool PERM = false;
    float* S;
    __device__ __forceinline__ void operator()(const f32x4 (&acc)[2][2][4][2], const pg8::Unit& u, int wr, int wc, int fr, int fq) const {
        const int row0 = u.pm * 256 + wr * 64 + fr, col0 = wc * 32 + 4 * fq;
#pragma unroll
        for (int ai = 0; ai < 2; ++ai)
#pragma unroll
            for (int m = 0; m < 4; ++m) { float* rowp = S + ((size_t)u.g * ROWS5 + row0 + ai * 128 + m * 16) * 256 + col0;
#pragma unroll
                for (int bj = 0; bj < 2; ++bj)
#pragma unroll
                    for (int n = 0; n < 2; ++n) *(f32x4*)(rowp + bj * 128 + n * 16) = acc[ai][bj][m][n]; }
    }
};
struct EpiS5 {
    static constexpr bool PERM = true;
    bf16_t* Y;
    __device__ __forceinline__ void operator()(const f32x4 (&acc)[2][2][4][2], const pg8::Unit& u, int wr, int wc, int fr, int fq) const {
        const int row0 = u.pm * 256 + wr * 64 + fr;
#pragma unroll
        for (int ai = 0; ai < 2; ++ai)
#pragma unroll
            for (int m = 0; m < 4; ++m) { const int row = row0 + ai * 128 + m * 16, b = row >> 8, chunk = row & 255;
#pragma unroll
                for (int bj = 0; bj < 2; ++bj) { const int n0 = u.pn * 256 + bj * 128 + wc * 32 + 8 * fq, t = n0 >> 4, c0 = n0 & 15; const f32x4 v0 = acc[ai][bj][m][0], v1 = acc[ai][bj][m][1];
                    u32x4 w; w.x = cvt_pk_bf16(gelu_tanh(v0[0]), gelu_tanh(v0[1])); w.y = cvt_pk_bf16(gelu_tanh(v0[2]), gelu_tanh(v0[3]));
                    w.z = cvt_pk_bf16(gelu_tanh(v1[0]), gelu_tanh(v1[1])); w.w = cvt_pk_bf16(gelu_tanh(v1[2]), gelu_tanh(v1[3]));
                    *(u32x4*)(Y + (size_t)(b * SEQ + chunk * TCH + t) * 512 + u.g * 16 + c0) = w; } }
    }
};
struct EpiGlu {
    static constexpr bool PERM = true;
    const bf16_t* Y; bf16_t* mix;
    __device__ __forceinline__ void operator()(const f32x4 (&acc)[2][2][4][2], const pg8::Unit& u, int wr, int wc, int fr, int fq) const {
        const int row0 = u.pm * 256 + wr * 64 + fr;
#pragma unroll
        for (int ai = 0; ai < 2; ++ai)
#pragma unroll
            for (int m = 0; m < 4; ++m) { const int row = row0 + ai * 128 + m * 16;
#pragma unroll
                for (int bj = 0; bj < 2; ++bj) { const int col0 = u.pn * 256 + bj * 128 + wc * 32 + 8 * fq; const f32x4 v0 = acc[ai][bj][m][0], v1 = acc[ai][bj][m][1];
                    const u32x4 y = *(const u32x4*)(Y + (size_t)row * 512 + col0); u32x4 w;
                    w.x = cvt_pk_bf16(bf_lo(y.x) * sigmoid_fast(v0[0]), bf_hi(y.x) * sigmoid_fast(v0[1])); w.y = cvt_pk_bf16(bf_lo(y.y) * sigmoid_fast(v0[2]), bf_hi(y.y) * sigmoid_fast(v0[3]));
                    w.z = cvt_pk_bf16(bf_lo(y.z) * sigmoid_fast(v1[0]), bf_hi(y.z) * sigmoid_fast(v1[1])); w.w = cvt_pk_bf16(bf_lo(y.w) * sigmoid_fast(v1[2]), bf_hi(y.w) * sigmoid_fast(v1[3]));
                    *(u32x4*)(mix + (size_t)row * D + 512 + col0) = w; } }
    }
};

__device__ __forceinline__ float wave_sum(float v) {
#pragma unroll
    for (int o = 1; o < 64; o <<= 1) v += __shfl_xor(v, o);
    return v;
}
__device__ __forceinline__ void transpose_item(const float* W, int ldw, bf16_t* WT, int ldd, int mode, LAS float* scr, int kb, int nb, int lane) {
    const int k0 = 64 * kb, n0 = 32 * nb;
#pragma unroll 8
    for (int i = 0; i < 32; ++i) { const int kk = 2 * i + (lane >> 5); scr[kk * 33 + (lane & 31)] = W[(size_t)(k0 + kk) * ldw + n0 + (lane & 31)]; }
    asm volatile("s_waitcnt lgkmcnt(0)" ::: "memory");
    const int c = lane & 7;
#pragma unroll
    for (int j = 0; j < 4; ++j) { const int n = (lane >> 3) + 8 * j, ncol = n0 + n; const LAS float* s = scr + (8 * c) * 33 + n;
        const int row = mode == 0 ? ncol : (8 * (ncol >> 2) + (ncol & 3) + (mode == 2 ? 4 : 0));
        u32x4 o; o.x = cvt_pk_bf16(s[0 * 33], s[1 * 33]); o.y = cvt_pk_bf16(s[2 * 33], s[3 * 33]); o.z = cvt_pk_bf16(s[4 * 33], s[5 * 33]); o.w = cvt_pk_bf16(s[6 * 33], s[7 * 33]);
        *(u32x4*)(WT + (size_t)row * ldd + k0 + 8 * c) = o; }
    asm volatile("s_waitcnt lgkmcnt(0)" ::: "memory");
}
__device__ __forceinline__ void norm_mod_row(const float* xrow, const float* g, const float* shift, const float* scale, bf16_t* orow, int lane) {
    const f32x4* xr = (const f32x4*)xrow + lane; f32x4 v[4]; float s = 0.f;
#pragma unroll
    for (int j = 0; j < 4; ++j) { v[j] = xr[64 * j]; s += (v[j].x * v[j].x + v[j].y * v[j].y) + (v[j].z * v[j].z + v[j].w * v[j].w); }
    const float r = 1.0f / sqrtf(wave_sum(s) * (1.f / D) + EPS);
    u32x2* o8 = (u32x2*)orow + lane;
#pragma unroll
    for (int j = 0; j < 4; ++j) { const f32x4 gg = ((const f32x4*)g)[lane + 64 * j], sh = ((const f32x4*)shift)[lane + 64 * j], sc = ((const f32x4*)scale)[lane + 64 * j];
        const f32x4 y = (v[j] * r) * gg; const f32x4 h = y * (sc + 1.0f) + sh; u32x2 w; w.x = cvt_pk_bf16(h.x, h.y); w.y = cvt_pk_bf16(h.z, h.w); o8[64 * j] = w; }
}


#define XB_TMO      128
#define XB_XCNT(j)  (256  + 64 * (j))
#define XB_XSUB(j)  (1280 + 64 * (j))
#define XB_XGEN(j)  (2304 + 64 * (j))
#define XB_TOP      3328
#define XB_TOPGEN   3392
#define XCD_BAR_WORDS 3456
#define XB_SPIN_CAP (1u << 22)
__device__ __forceinline__ unsigned xb_ld(unsigned* p)              { return __hip_atomic_load(p, __ATOMIC_RELAXED, __HIP_MEMORY_SCOPE_AGENT); }
__device__ __forceinline__ unsigned xb_add(unsigned* p, unsigned v) { return __hip_atomic_fetch_add(p, v, __ATOMIC_RELAXED, __HIP_MEMORY_SCOPE_AGENT); }
__device__ __forceinline__ unsigned xb_xcc_id() { return (unsigned)__builtin_amdgcn_s_getreg((3 << 11) | 20) & 0xFu; }
#define XB_SPIN(cond, bar) do { unsigned _sp = 0; while (cond) { __builtin_amdgcn_s_sleep(1); \
    if ((++_sp & 255u) == 0u) { if (xb_ld(&(bar)[XB_TMO])) break; if (_sp > XB_SPIN_CAP) { atomicAdd(&(bar)[XB_TMO], 1u); break; } } } } while (0)
struct XcdBarrier { unsigned* bar; unsigned x; volatile LAS unsigned* st; };
__device__ __forceinline__ XcdBarrier xcd_barrier_post(unsigned* bar, volatile LAS unsigned* st) {
    XcdBarrier b; b.bar = bar; b.x = xb_xcc_id(); b.st = st;
    if (threadIdx.x == 0) (void)xb_add(&bar[XB_XCNT(b.x)], 1u);
    return b;
}
__device__ __forceinline__ void xcd_barrier_complete(unsigned* bar, unsigned x, unsigned& nloc, unsigned& nx) {
    const unsigned G = gridDim.x * gridDim.y * gridDim.z;
    unsigned sum, cnt, mine, sp = 0u;
    for (;;) {
        sum = 0u; cnt = 0u; mine = 0u;
#pragma unroll
        for (unsigned j = 0; j < 16; ++j) { const unsigned c = xb_ld(&bar[XB_XCNT(j)]); sum += c; cnt += (c > 0u) ? 1u : 0u; mine = (j == x) ? c : mine; }
        if (sum == G) break;
        __builtin_amdgcn_s_sleep(1);
        if ((++sp & 255u) == 0u) { if (xb_ld(&bar[XB_TMO])) break; if (sp > XB_SPIN_CAP) { atomicAdd(&bar[XB_TMO], 1u); break; } }
    }
    nloc = mine > 0u ? mine : 1u; nx = cnt > 0u ? cnt : 1u;
}
__device__ __forceinline__ void xcd_barrier(const XcdBarrier& b) {
    asm volatile("s_waitcnt vmcnt(0)" ::: "memory");
    __syncthreads();
    if (threadIdx.x == 0) {
        unsigned* bar = b.bar;
        __builtin_amdgcn_s_waitcnt(0);
        unsigned nloc = b.st[0], nx = b.st[1];
        if (nloc == 0u) { xcd_barrier_complete(bar, b.x, nloc, nx); b.st[0] = nloc; b.st[1] = nx; }
        const unsigned old = xb_add(&bar[XB_XSUB(b.x)], 1u);
        const unsigned gen = old / nloc;
        if (old + 1u == (gen + 1u) * nloc) {
            __builtin_amdgcn_fence(__ATOMIC_RELEASE, "agent");
            asm volatile("s_waitcnt vmcnt(0)" ::: "memory");
            const unsigned og = xb_add(&bar[XB_TOP], 1u);
            const unsigned tg = og / nx;
            if (og + 1u == (tg + 1u) * nx) xb_add(&bar[XB_TOPGEN], 1u);
            else XB_SPIN(xb_ld(&bar[XB_TOPGEN]) == tg, bar);
            __builtin_amdgcn_fence(__ATOMIC_ACQUIRE, "agent");
            xb_add(&bar[XB_XGEN(b.x)], 1u);
            asm volatile("s_waitcnt vmcnt(0)" ::: "memory");
        } else {
            XB_SPIN(xb_ld(&bar[XB_XGEN(b.x)]) == gen, bar);
            __builtin_amdgcn_fence(__ATOMIC_ACQUIRE, "agent");
            asm volatile("s_waitcnt vmcnt(0)" ::: "memory");
        }
    }
    __syncthreads();
}
#ifndef PHMASK
#define PHMASK 0xFFFFF
#endif
#ifndef REPMASK
#define REPMASK 0
#endif
#ifndef XSYNC
#define XSYNC 0
#endif
#define PH(k) for (int rep_ = 0; rep_ < 1 + (((REPMASK) >> (k)) & 1); ++rep_) if constexpr (((PHMASK) >> (k)) & 1)

template <int W>
__device__ __forceinline__ void pool_rows(LAS bf16_t* raw, LAS float* rowb, LAS bf16_t* ob, bf16_t* dst  , int tid, int r_begin, int r_end) {
    constexpr int lo = W / 2, hi = W - 1 - lo;
    const int c = tid >> 3, ch = tid & 7;
    const int clo = c - lo < 0 ? 0 : c - lo, chi = c + hi > 63 ? 63 : c + hi; const float icc = 1.0f / (float)(chi - clo + 1);
    float vs = 0.f;
    { const int ra = r_begin - lo < 0 ? 0 : r_begin - lo, rz = r_begin + hi > 127 ? 127 : r_begin + hi;
      for (int r = ra; r <= rz; ++r) vs += bf2f(raw[(r * 64 + c) * 8 + ch]); }
#pragma unroll 1
    for (int r = r_begin; r < r_end; r += 4) {
#pragma unroll
        for (int q = 0; q < 4; ++q) { const int rq = r + q, rlo = rq - lo < 0 ? 0 : rq - lo, rhi = rq + hi > 127 ? 127 : rq + hi;
            rowb[q * 512 + tid] = vs * __builtin_amdgcn_rcpf((float)(rhi - rlo + 1));
            if (rq + 1 + hi <= 127) vs += bf2f(raw[((rq + 1 + hi) * 64 + c) * 8 + ch]);
            if (rq - lo >= 0) vs -= bf2f(raw[((rq - lo) * 64 + c) * 8 + ch]); }
        __syncthreads();
#pragma unroll
        for (int q = 0; q < 4; ++q) { float hv[W];
#pragma unroll
            for (int i = 0; i < W; ++i) { int c2 = c - lo + i; c2 = c2 < 0 ? 0 : (c2 > 63 ? 63 : c2); hv[i] = rowb[q * 512 + c2 * 8 + ch]; }
            float hs = 0.f;
#pragma unroll
            for (int i = 0; i < W; ++i) { const int c2 = c - lo + i; hs += (c2 >= 0 && c2 <= 63) ? hv[i] : 0.f; }
            const float dval = hs * icc - bf2f(raw[((r + q) * 64 + c) * 8 + ch]);
            ob[q * 512 + tid] = (bf16_t)(cvt_pk_bf16(dval, 0.f) & 0xffffu); }
        __syncthreads();
        if (tid < 256) { const int q = tid >> 6, cc = tid & 63; *(u32x4*)(dst + (size_t)((r + q) * 64 + cc) * D) = *(const LAS u32x4*)(ob + q * 512 + cc * 8); }
    }
}

__global__ void __launch_bounds__(512, 2) fwd_megakernel(KArgs a) {
    extern __shared__ __attribute__((aligned(16))) unsigned char lds_raw[];
    LAS unsigned char* lds = (LAS unsigned char*)lds_raw;
    cg::grid_group grid = cg::this_grid();
    const int tid = threadIdx.x, lane = tid & 63, wave = __builtin_amdgcn_readfirstlane(tid >> 6);
    const int G = gridDim.x, bid = blockIdx.x;
    const int gw = bid * 8 + wave, NGW = G * 8;
    volatile LAS unsigned* bst = (volatile LAS unsigned*)(lds + LDS_BYTES - 64);
    if (tid == 0) { bst[0] = 0u; bst[1] = 0u; }
    __syncthreads();
    if (bid == 0) for (int i = tid; i < XCD_BAR_WORDS; i += 512) ((unsigned*)a.ws)[i] = 0u;
#ifndef TPROBE
#define TPROBE 0
#endif
#ifndef TSEL_A
#define TSEL_A 0
#define TSEL_B 1
#endif
#if TPROBE
    unsigned long long* tsb = (unsigned long long*)(a.ws + 65536); int tsi = 1;
    if (bid == 0 && tid == 0) tsb[0] = __builtin_amdgcn_s_memrealtime();
#define TSTAMP() do { if (bid == 0 && tid == 0) tsb[tsi] = __builtin_amdgcn_s_memrealtime(); ++tsi; } while (0)
#else
#define TSTAMP() do {} while (0)
#endif
#define GSYNC() do { xcd_barrier(xbar); TSTAMP(); } while (0)
#define DEFER_T(lo_, hi_) do { const int nidle_ = G > 128 ? G - 128 : G, rank_ = G > 128 ? bid - 128 : bid; \
        if (rank_ >= 0) { LAS float* scr_ = (LAS float*)(lds + wave * 16384); \
            for (int d_ = (lo_) + rank_ * 8 + wave; d_ < (hi_); d_ += nidle_ * 8) { int r_ = d_; \
                if (r_ < 1408) { transpose_item(a.in[7] + (size_t)D * FF, FF, W13b, D, 1, scr_, r_ / 88, r_ % 88, lane); continue; } r_ -= 1408; \
                if (r_ < 1408) { transpose_item(a.in[8] + (size_t)D * FF, FF, W13b, D, 2, scr_, r_ / 88, r_ % 88, lane); continue; } r_ -= 1408; \
                transpose_item(a.in[9] + (size_t)D * FF, D, W2b, FF, 0, scr_, r_ / 32, r_ % 32, lane); } } } while (0)
#define ws (a.ws)
#define xin_ (a.in[0])
#define cvec (a.in[1])
#define ctx (a.in[2])
#define cctx (a.in[3])
#define norm_g (a.in[4])
#define w_ada (a.in[5])
#define b_ada (a.in[6])
#define mod ((float*)(ws + WS_MOD))
#define Hctx ((f32x2*)(ws + WS_HCTX))
#define Win_t ((bf16_t*)(ws + WS_WIN))
#define Wmix_t ((bf16_t*)(ws + WS_WMIX))
#define Wglu_t ((bf16_t*)(ws + WS_WGLU))
#define BB ((f32x2*)(ws + WS_BB))
#define Ktab ((float*)(ws + WS_KTAB))
#define PW ((f32x2*)(ws + WS_PW))
#define W13a ((bf16_t*)(ws + WS_W13A))
#define W2a ((bf16_t*)(ws + WS_W2A))
#define W13b ((bf16_t*)(ws + WS_W13B))
#define W2b ((bf16_t*)(ws + WS_W2B))
#define Wst ((bf16_t*)(ws + WS_WST))
#define Bs5 ((bf16_t*)(ws + WS_BS5))
#define Hn ((bf16_t*)(ws + WS_HN))
#define mixcat ((bf16_t*)(ws + WS_MIX))
#define X1c ((float*)(ws + WS_X1C))
#define Uctx ((float*)(ws + WS_UCTXP))
#define Pc ((float*)(ws + WS_PC))
#define Ubuf ((bf16_t*)(ws + WS_UB))
#define poolb ((bf16_t*)(ws + WS_POOL))
#define As5 ((bf16_t*)(ws + WS_AS5))
#define Sbuf ((float*)(ws + WS_S))
#define Ybuf ((bf16_t*)(ws + WS_Y))
#define out (a.out)

    PH(0) {
        if (bid == 0 && tid == 0) *(unsigned*)(ws + 69632) = 0u;
        LAS float* sc = (LAS float*)lds;
        LAS float* red = (LAS float*)(lds + 16384);
        for (int i = tid; i < 3072; i += 512) { const float v = i < 2048 ? cvec[i] : cctx[i - 2048]; sc[i] = v / (1.f + expf(-v)); }
        __syncthreads();
        for (int strip = bid; strip < 256; strip += G) {
            const int cg4 = tid % 9, kk = tid / 9;
            f32x4 a0 = {0.f, 0.f, 0.f, 0.f}, a1 = a0, a2 = a0;
            if (tid < 504) {
#pragma unroll
                for (int it = 0; it < 19; ++it) { const int k = kk + 56 * it; if (k < 1024) { const f32x4 w = *(const f32x4*)(w_ada + (size_t)k * NMODW + strip * 36 + cg4 * 4);
                    a0 += w * sc[k]; a1 += w * sc[1024 + k]; a2 += w * sc[2048 + k]; } }
#pragma unroll
                for (int i = 0; i < 4; ++i) { red[kk * 112 + cg4 * 4 + i] = a0[i]; red[kk * 112 + 36 + cg4 * 4 + i] = a1[i]; red[kk * 112 + 72 + cg4 * 4 + i] = a2[i]; }
            }
            __syncthreads();
            if (tid < 108) { float s = 0.f;
#pragma unroll 8
                for (int k2 = 0; k2 < 56; ++k2) s += red[k2 * 112 + tid];
                const int r = tid / 36, col = strip * 36 + (tid % 36); mod[r * NMODW + col] = s + b_ada[col]; }
            __syncthreads();
        }
        LAS f32x2* pwL = (LAS f32x2*)(lds + 65536);
        LAS f32x2* bbL = (LAS f32x2*)(lds + 65536 + 17408);
        LAS f32x2* cL = (LAS f32x2*)(lds + 65536 + 17408 + 8192);
        const float* a_re = a.in[13]; const float* a_im = a.in[14]; const float* log_dt = a.in[15]; const float* b_re = a.in[16]; const float* b_im = a.in[17];
        const float* c_re = a.in[18]; const float* c_im = a.in[19];
#pragma unroll 1
        for (int it2 = G - 1 - bid; it2 < 256; it2 += G) {
            const int it = it2 >> 2, qq = it2 & 3; const bool wr_tab = qq == 0;
            const int g = it >> 1, dir = it & 1, pd = dir * 32 + g;
            const float dt = expf(log_dt[pd]);
            for (int idx = tid; idx < 33 * 64; idx += 512) { const int tau = idx >> 6, p = idx & 63; const float are = a_re[pd * 64 + p], aim = a_im[pd * 64 + p];
                const float mag = expf(are * dt * (float)tau); double ang = (double)aim * (double)dt * (double)tau; ang -= 6.283185307179586 * rint(ang * 0.15915494309189535);
                float sn, cs; sincosf((float)ang, &sn, &cs); const f32x2 v = {mag * cs, mag * sn}; pwL[idx] = v; if (wr_tab) PW[(size_t)it * 33 * 64 + idx] = v; }
            for (int idx = tid; idx < 1024; idx += 512) { const f32x2 v = {c_re[(size_t)pd * 1024 + idx], c_im[(size_t)pd * 1024 + idx]}; cL[idx] = v; }
            __syncthreads();
            for (int idx = tid; idx < 1024; idx += 512) { const int p = idx >> 4; const float are = a_re[pd * 64 + p], aim = a_im[pd * 64 + p]; const float zr = are * dt, zi = aim * dt;
                float qr, qi;
                if (zr * zr + zi * zi < 0.25f) { float tr = 1.f, ti = 0.f;
                    for (int k = 12; k >= 2; --k) { const float ik = 1.0f / (float)k, wr_ = zr * ik, wi_ = zi * ik; const float nr = 1.f + (wr_ * tr - wi_ * ti), ni = wr_ * ti + wi_ * tr; tr = nr; ti = ni; }
                    qr = dt * tr; qi = dt * ti; }
                else { const f32x2 ab = pwL[64 + p]; const float nr = ab.x - 1.f, ni = ab.y, den = are * are + aim * aim; qr = (nr * are + ni * aim) / den; qi = (ni * are - nr * aim) / den; }
                const float br = b_re[(size_t)g * 1024 + idx], bi = b_im[(size_t)g * 1024 + idx];
                const f32x2 v = {qr * br - qi * bi, qr * bi + qi * br}; bbL[idx] = v; if (wr_tab) BB[(size_t)it * 1024 + idx] = v; }
            __syncthreads();
#pragma unroll 1
            for (int j = 0; j < 4; ++j) { const int idx = qq * 2048 + tid + 512 * j, tau = idx >> 8, c = (idx >> 4) & 15, cc = idx & 15; float s = 0.f;
#pragma unroll 8
                for (int p = 0; p < 64; ++p) { const f32x2 C = cL[c * 64 + p], w = pwL[tau * 64 + p], b = bbL[p * 16 + cc]; const float zr = C.x * w.x - C.y * w.y, zi = C.x * w.y + C.y * w.x; s += zr * b.x - zi * b.y; }
                Ktab[(size_t)it * 8192 + idx] = s; }
            __syncthreads();
        }
    }
    grid.sync(); TSTAMP();
    const XcdBarrier xbar = xcd_barrier_post((unsigned*)ws, bst);

    PH(1) {
        LAS float* scr = (LAS float*)(lds + wave * 16384);
        constexpr int I_UP = 16 * 88, I_DN = 44 * 32, I_IN = 16 * 32, I_OUT = 8 * 32, I_GLU = 8 * 16;
        constexpr int NITEMS = 2 * I_UP + I_DN + I_IN + I_OUT + I_GLU;
        for (int it = gw; it < NITEMS; it += NGW) {
            int r = it;
            if (r < I_UP) { transpose_item(a.in[7], FF, W13a, D, 1, scr, r / 88, r % 88, lane); continue; } r -= I_UP;
            if (r < I_UP) { transpose_item(a.in[8], FF, W13a, D, 2, scr, r / 88, r % 88, lane); continue; } r -= I_UP;
            if (r < I_DN) { transpose_item(a.in[9], D, W2a, FF, 0, scr, r / 32, r % 32, lane); continue; } r -= I_DN;
            if (r < I_IN) { transpose_item(a.in[10], D, Win_t, D, 0, scr, r / 32, r % 32, lane); continue; } r -= I_IN;
            if (r < I_OUT) { transpose_item(a.in[22] + (size_t)512 * D, D, Wmix_t + 512, D, 0, scr, r / 32, r % 32, lane); continue; } r -= I_OUT;
            transpose_item(a.in[21], 512, Wglu_t, 512, 0, scr, r / 16, r % 16, lane);
        }
        {
            const float* pool_w = a.in[11]; const float* pool_scale = a.in[12]; const float* w_out = a.in[22];
            for (int it = G - 1 - bid; it < 256; it += G) { const int k = it >> 6, cb = (it >> 2) & 15, nq = it & 3, n = nq * 256 + (tid & 255), c4 = cb * 8 + (tid >> 8) * 4;
                float ac[4] = {0.f, 0.f, 0.f, 0.f};
#pragma unroll 8
                for (int d = 0; d < 128; ++d) { const float wo = w_out[(size_t)(k * 128 + d) * D + n] * pool_scale[k * 128 + d];
#pragma unroll
                    for (int i = 0; i < 4; ++i) ac[i] += wo * pool_w[(size_t)(k * 128 + c4 + i) * 128 + d]; }
                u32x2 w0; w0.x = cvt_pk_bf16(ac[0], ac[1]); w0.y = cvt_pk_bf16(ac[2], ac[3]);
                *(u32x2*)(Wmix_t + (size_t)n * D + k * 128 + c4) = w0; }
        }
        {
            const float* c_re = a.in[18]; const float* c_im = a.in[19]; const float* dskip = a.in[20];
            const int gt = bid * 512 + tid, NT = G * 512;
            for (int e = gt; e < 32 * 512 * 96; e += NT) { const int k8 = e % 96, n = (e / 96) & 511, g = e / (96 * 512), t = n >> 4, c = n & 15; float v[8];
                if (k8 < 64) { const int s = k8 >> 1, c0 = (k8 & 1) * 8;
#pragma unroll
                    for (int i = 0; i < 8; ++i) v[i] = 0.f;
                    if (s <= t) { const float* kp = Ktab + ((size_t)((g * 2 + 0) * 32 + (t - s)) * 256 + c * 16 + c0); const f32x4 k0 = *(const f32x4*)kp, k1 = *(const f32x4*)(kp + 4);
                        v[0] += k0.x; v[1] += k0.y; v[2] += k0.z; v[3] += k0.w; v[4] += k1.x; v[5] += k1.y; v[6] += k1.z; v[7] += k1.w; }
                    if (s >= t) { const float* kp = Ktab + ((size_t)((g * 2 + 1) * 32 + (s - t)) * 256 + c * 16 + c0); const f32x4 k0 = *(const f32x4*)kp, k1 = *(const f32x4*)(kp + 4);
                        v[0] += k0.x; v[1] += k0.y; v[2] += k0.z; v[3] += k0.w; v[4] += k1.x; v[5] += k1.y; v[6] += k1.z; v[7] += k1.w; }
                    if (s == t) { const float dv = dskip[g * 16 + c];
#pragma unroll
                        for (int i = 0; i < 8; ++i) if (c0 + i == c) v[i] += dv; }
                } else { const int j = k8 - 64, dir = j >> 4, p0 = (j & 15) * 4, ex = dir == 0 ? t + 1 : 32 - t;
#pragma unroll
                    for (int i = 0; i < 4; ++i) { const int p = p0 + i; const size_t ci = ((size_t)(dir * 32 + g) * 16 + c) * 64 + p; const float cr = c_re[ci], cim = c_im[ci]; const f32x2 w = PW[((size_t)(g * 2 + dir) * 33 + ex) * 64 + p];
                        const float zr = cr * w.x - cim * w.y, zi = cr * w.y + cim * w.x; v[2 * i] = zr; v[2 * i + 1] = -zi; } }
                u32x4 o; o.x = cvt_pk_bf16(v[0], v[1]); o.y = cvt_pk_bf16(v[2], v[3]); o.z = cvt_pk_bf16(v[4], v[5]); o.w = cvt_pk_bf16(v[6], v[7]);
                *(u32x4*)(Bs5 + ((size_t)g * 512 + n) * KS5 + k8 * 8) = o; }
            for (int e = gt; e < 32 * 256 * 64; e += NT) { const int k8 = e & 63, n = (e >> 6) & 255, g = e >> 14, dir = n >> 7, reim = n & 1, p = (n >> 1) & 63, s = k8 >> 1, c0 = (k8 & 1) * 8, ex = dir == 0 ? 31 - s : s;
                const f32x2 w = PW[((size_t)(g * 2 + dir) * 33 + ex) * 64 + p]; float v[8];
#pragma unroll
                for (int i = 0; i < 8; ++i) { const f32x2 b = BB[((size_t)(g * 2 + dir) * 64 + p) * 16 + c0 + i]; v[i] = reim ? (w.x * b.y + w.y * b.x) : (w.x * b.x - w.y * b.y); }
                u32x4 o; o.x = cvt_pk_bf16(v[0], v[1]); o.y = cvt_pk_bf16(v[2], v[3]); o.z = cvt_pk_bf16(v[4], v[5]); o.w = cvt_pk_bf16(v[6], v[7]);
                *(u32x4*)(Wst + ((size_t)g * 256 + n) * 512 + k8 * 8) = o; }
        }
        for (int m = gw; m < MALL; m += NGW) { const int set = m < SEQ ? 0 : (m < ML ? 1 : 2); const float* src = m < ML ? xin_ + (size_t)m * D : ctx + (size_t)(m - ML) * D;
            norm_mod_row(src, norm_g, mod + set * NMODW + 0 * 1024, mod + set * NMODW + 1 * 1024, Hn + (size_t)m * D, lane); }
    }
    GSYNC();

    PH(2) { pg8::Gemm g{Hn, W13a, D, D, D, 0, 0}; pg8::StaticOrder S; S.init(MALL, 2 * FF, D, G, bid); EpiUp E{Ubuf}; pg8::gemm_phase(lds, g, S, E); }
    GSYNC();
    PH(3) { pg8::Gemm g{Ubuf, W2a, FF, FF, FF, 0, 0}; pg8::TailOrder S; S.init(ML, D, FF, G, bid, 88, 11, 0, 4); EpiRes E{xin_, out, Pc, mod + 2 * 1024, 0.5f}; pg8::gemm_phase(lds, g, S, E); }
    GSYNC();
    PH(4) {
        for (int m = (gw & 3) == 0 ? (gw >> 2) : MC; m < MC; m += (NGW + 3) >> 2) {
            const f32x4* xr = (const f32x4*)(ctx + (size_t)m * D) + lane; f32x4 v[4]; float ss = 0.f;
#pragma unroll
            for (int j = 0; j < 4; ++j) { f32x4 p = {0.f, 0.f, 0.f, 0.f};
#pragma unroll
                for (int ks = 0; ks < 11; ++ks) p += ((const f32x4*)(Pc + (size_t)ks * MC * D + (size_t)m * D))[lane + 64 * j];
                v[j] = xr[64 * j] + (((const f32x4*)(mod + 2 * NMODW + 2 * 1024))[lane + 64 * j] * 0.5f) * p;
                ss += (v[j].x * v[j].x + v[j].y * v[j].y) + (v[j].z * v[j].z + v[j].w * v[j].w); }
            const float r = 1.0f / sqrtf(wave_sum(ss) * (1.f / D) + EPS);
            u32x2* o8 = (u32x2*)(Hn + (size_t)(ML + m) * D) + lane;
#pragma unroll
            for (int j = 0; j < 4; ++j) { const f32x4 gg = ((const f32x4*)(norm_g + 1024))[lane + 64 * j], sh = ((const f32x4*)(mod + 2 * NMODW + 3 * 1024))[lane + 64 * j], sc = ((const f32x4*)(mod + 2 * NMODW + 4 * 1024))[lane + 64 * j];
                const f32x4 y = (v[j] * r) * gg; const f32x4 h = y * (sc + 1.0f) + sh; u32x2 w; w.x = cvt_pk_bf16(h.x, h.y); w.y = cvt_pk_bf16(h.z, h.w); o8[64 * j] = w; }
        }
        for (int m = gw; m < ML; m += NGW) { const int set = m < SEQ ? 0 : 1;
            norm_mod_row(out + (size_t)m * D, norm_g + 1024, mod + set * NMODW + 3 * 1024, mod + set * NMODW + 4 * 1024, Hn + (size_t)m * D, lane); }
    }
    GSYNC();
    PH(5) { pg8::Gemm g{Hn, Win_t, D, D, D, 0, 0}; pg8::TailOrder S; S.init(ML, D, D, G, bid, 16, 4, 2, 2); EpiWin E{poolb, As5, Uctx}; pg8::gemm_phase(lds, g, S, E); }
    GSYNC();
    PH(6) {
        const int Gg = G < 64 ? G : 64;
        { pg8::Gemm g{As5, Wst, KS5, 512, 512, (size_t)ROWS5 * KS5, (size_t)256 * 512}; pg8::GroupOrder S; S.init(2, 1, 32, 512, Gg, bid); EpiState E{Sbuf}; pg8::gemm_phase(lds, g, S, E); }
        const int r1 = (bid + G - Gg % G) % G;
        for (int it = r1; it < 16; it += G) { const int wi = it * 8 + wave, b = wi >> 6, g = (wi >> 1) & 31, dir = wi & 1, g0 = (it & 7) * 4;
            LAS float* ul = (LAS float*)lds;
            __syncthreads();
#pragma unroll 2
            for (int i = 0; i < 8; ++i) { const int idx = i * 512 + tid, t = idx >> 4, q = idx & 15; const size_t off = (size_t)(b * CTXL + t) * 512 + g0 * 16 + q * 4;
                const f32x4 s4 = (*(const f32x4*)(Uctx + off) + *(const f32x4*)(Uctx + (size_t)MC * 512 + off)) + (*(const f32x4*)(Uctx + (size_t)2 * MC * 512 + off) + *(const f32x4*)(Uctx + (size_t)3 * MC * 512 + off));
                *(LAS f32x4*)(ul + t * 64 + q * 4) = s4; }
            const f32x2 av = PW[((size_t)(g * 2 + dir) * 33 + 1) * 64 + lane]; f32x2 bb[16];
#pragma unroll
            for (int i = 0; i < 16; ++i) bb[i] = BB[((size_t)(g * 2 + dir) * 64 + lane) * 16 + i];
            __syncthreads();
            float hr = 0.f, hi = 0.f; const int gl = (wave >> 1) * 16;
#pragma unroll 4
            for (int step = 0; step < CTXL; ++step) { const int t = dir == 0 ? step : CTXL - 1 - step; const LAS f32x4* up = (const LAS f32x4*)(ul + t * 64 + gl);
                const f32x4 u0 = up[0], u1 = up[1], u2 = up[2], u3 = up[3]; f32x2 sa = {0.f, 0.f}, sb = {0.f, 0.f};
#pragma unroll
                for (int i = 0; i < 4; ++i) { sa += bb[i] * u0[i]; sb += bb[4 + i] * u1[i]; }
#pragma unroll
                for (int i = 0; i < 4; ++i) { sa += bb[8 + i] * u2[i]; sb += bb[12 + i] * u3[i]; }
                const f32x2 sv = sa + sb;
                const float nr = av.x * hr - av.y * hi + sv.x, ni = av.x * hi + av.y * hr + sv.y; hr = nr; hi = ni; }
            Hctx[(size_t)wi * 64 + lane] = (f32x2){hr, hi}; }
        {
            unsigned* pctr = (unsigned*)(ws + 69632);
            volatile LAS unsigned* sh_it = (volatile LAS unsigned*)(lds + LDS_BYTES - 32);
            LAS bf16_t* raw = (LAS bf16_t*)lds;
            LAS float* rowb = (LAS float*)(lds + 131072);
            LAS bf16_t* ob = (LAS bf16_t*)(lds + 131072 + 8192);
            for (;;) {
                __syncthreads();
                if (tid == 0) *sh_it = __hip_atomic_fetch_add(pctr, 1u, __ATOMIC_RELAXED, __HIP_MEMORY_SCOPE_AGENT);
                __syncthreads();
                const int it = (int)*sh_it;
                if (it >= 512) break;
                const int k = 3 - (it >> 7), bs = (it & 127) >> 2, r_begin = (it & 3) * 32, r_end = r_begin + 32, b = bs >> 4, slab = bs & 15;
                const int w = 2 << k, lo = w >> 1, hi = w - 1 - lo, ra = r_begin - lo < 0 ? 0 : r_begin - lo, rz = r_end - 1 + hi > 127 ? 127 : r_end - 1 + hi, ntok = (rz - ra + 1) * 64;
                const bf16_t* src = poolb + (size_t)((b * 4 + k) * 16 + slab) * 8192 * 8;
                for (int i = tid; i < ntok; i += 512) { const int tok = ra * 64 + i; *(LAS u32x4*)(raw + tok * 8) = *(const u32x4*)(src + (size_t)tok * 8); }
                __syncthreads();
                bf16_t* dst = mixcat + (size_t)b * SEQ * D + k * 128 + slab * 8;
                if (k == 0) pool_rows<2>(raw, rowb, ob, dst, tid, r_begin, r_end); else if (k == 1) pool_rows<4>(raw, rowb, ob, dst, tid, r_begin, r_end); else if (k == 2) pool_rows<8>(raw, rowb, ob, dst, tid, r_begin, r_end); else pool_rows<16>(raw, rowb, ob, dst, tid, r_begin, r_end);
            }
        }
    }
    GSYNC();
    PH(7) for (int wi = bid; wi < 128; wi += G) {
        const int b = wi >> 6, g = (wi >> 1) & 31, dir = wi & 1; const size_t rbase = (size_t)g * ROWS5 + b * 256;
        LAS float* sl = (LAS float*)lds;
        __syncthreads();
#pragma unroll 4
        for (int i = 0; i < 16; ++i) { const int row = i * 16 + (tid >> 5), q = tid & 31; *(LAS f32x4*)(sl + row * 128 + q * 4) = *(const f32x4*)(Sbuf + (rbase + row) * 256 + dir * 128 + q * 4); }
        __syncthreads();
        if (wave == 0) { const f32x2 a32 = PW[((size_t)(g * 2 + dir) * 33 + 32) * 64 + lane]; f32x2 h = Hctx[(size_t)wi * 64 + lane];
#pragma unroll 8
            for (int step = 0; step < 256; ++step) { const int j = dir == 0 ? step : 255 - step; const f32x2 sv = *(const LAS f32x2*)(sl + j * 128 + lane * 2);
                *(unsigned*)(As5 + (rbase + j) * KS5 + 512 + dir * 128 + lane * 2) = cvt_pk_bf16(h.x, h.y);
                const float nr = a32.x * h.x - a32.y * h.y + sv.x, ni = a32.x * h.y + a32.y * h.x + sv.y; h.x = nr; h.y = ni; } }
    }
    PH(7) { __syncthreads(); DEFER_T(0, 1056); }
    GSYNC();
    PH(8) { pg8::Gemm g{As5, Bs5, KS5, KS5, KS5, (size_t)ROWS5 * KS5, (size_t)512 * KS5}; pg8::GroupOrder S; S.init(2, 2, 32, KS5, G, bid); EpiS5 E{Ybuf}; pg8::gemm_phase(lds, g, S, E); DEFER_T(1056, 3168); }
    GSYNC();
    PH(9) { pg8::Gemm g{Ybuf, Wglu_t, 512, 512, 512, 0, 0}; pg8::StaticOrder S; S.init(ML, 512, 512, G, bid); EpiGlu E{Ybuf, mixcat}; pg8::gemm_phase(lds, g, S, E); DEFER_T(3168, 4224); }
    GSYNC();
    PH(10) { pg8::Gemm g{mixcat, Wmix_t, D, D, D, 0, 0}; pg8::StaticOrder S; S.init(ML, D, D, G, bid); EpiRes E{out, out, Pc, mod + 5 * 1024, 1.0f}; pg8::gemm_phase(lds, g, S, E); }
    GSYNC();
    PH(11) for (int m = gw; m < ML; m += NGW) { const int set = m < SEQ ? 0 : 1;
        norm_mod_row(out + (size_t)m * D, norm_g + 2048, mod + set * NMODW + 6 * 1024, mod + set * NMODW + 7 * 1024, Hn + (size_t)m * D, lane); }
    GSYNC();
    PH(12) { pg8::Gemm g{Hn, W13b, D, D, D, 0, 0}; pg8::StaticOrder S; S.init(ML, 2 * FF, D, G, bid); EpiUp E{Ubuf}; pg8::gemm_phase(lds, g, S, E); }
    GSYNC();
    PH(13) { pg8::Gemm g{Ubuf, W2b, FF, FF, FF, 0, 0}; pg8::StaticOrder S; S.init(ML, D, FF, G, bid); EpiRes E{out, out, Pc, mod + 8 * 1024, 0.5f}; pg8::gemm_phase(lds, g, S, E); }
    GSYNC();
    for (int xs_ = 0; xs_ < XSYNC; ++xs_) GSYNC();
    PH(14) {
        const float* fg = a.in[23];
        for (int m = gw; m < ML; m += NGW) { f32x4* xr = (f32x4*)(out + (size_t)m * D) + lane; f32x4 v[4]; float s = 0.f;
#pragma unroll
            for (int j = 0; j < 4; ++j) { v[j] = xr[64 * j]; s += (v[j].x * v[j].x + v[j].y * v[j].y) + (v[j].z * v[j].z + v[j].w * v[j].w); }
            const float r = 1.0f / sqrtf(wave_sum(s) * (1.f / D) + EPS);
#pragma unroll
            for (int j = 0; j < 4; ++j) xr[64 * j] = (v[j] * r) * ((const f32x4*)fg)[lane + 64 * j]; }
    }
#if TPROBE
    GSYNC();
    if (bid == 0) { __syncthreads();
        long K = TPROBE == 2 ? 400000 : (long)(tsb[TSEL_B] - tsb[TSEL_A]) * 5; if (K > 900000) K = 900000; if (K < 0) K = 0;
        for (long i = tid; i < K; i += 512) out[i] += 0.02f; }
#endif
}

#undef ws
#undef xin_
#undef cvec
#undef ctx
#undef cctx
#undef norm_g
#undef w_ada
#undef b_ada
#undef mod
#undef Hctx
#undef Win_t
#undef Wmix_t
#undef Wglu_t
#undef BB
#undef Ktab
#undef PW
#undef W13a
#undef W2a
#undef W13b
#undef W2b
#undef Wst
#undef Bs5
#undef Hn
#undef mixcat
#undef X1c
#undef Uctx
#undef Pc
#undef Ubuf
#undef poolb
#undef As5
#undef Sbuf
#undef Ybuf
#undef out
extern "C" void kernel_launch(void* const* d_in, const int* in_sizes, int n_in, void* d_out, int out_size, void* d_ws, size_t ws_size, hipStream_t stream) {
    static int grid = 0;
    if (grid == 0) {
        if (n_in != 24 || out_size != ML * D || ws_size < WS_END) { fprintf(stderr, "kernel_launch: unexpected shapes (n_in %d out %d ws %zu)\n", n_in, out_size, ws_size); grid = -1; return; }
        int dev = 0, cus = 0, per_cu = 0;
        hipGetDevice(&dev); hipDeviceGetAttribute(&cus, hipDeviceAttributeMultiprocessorCount, dev);
        hipFuncSetAttribute((const void*)fwd_megakernel, hipFuncAttributeMaxDynamicSharedMemorySize, LDS_BYTES);
        if (hipOccupancyMaxActiveBlocksPerMultiprocessor(&per_cu, (const void*)fwd_megakernel, 512, LDS_BYTES) != hipSuccess || per_cu < 1) per_cu = 1;
        (void)hipGetLastError();
        grid = cus * 1;
        if (grid <= 0) grid = 256;
    }
    if (grid < 0) return;
    KArgs a{};
    for (int i = 0; i < 24; ++i) a.in[i] = (const float*)d_in[i];
    a.out = (float*)d_out; a.ws = (unsigned char*)d_ws;
    void* args[] = {&a};
    hipError_t e = hipLaunchCooperativeKernel((const void*)fwd_megakernel, dim3(grid), dim3(512), args, LDS_BYTES, stream);
    if (e != hipSuccess) fprintf(stderr, "cooperative launch failed: %s (grid %d)\n", hipGetErrorString(e), grid);
}
```

```cpp
#include <hip/hip_runtime.h>
#include <hip/hip_cooperative_groups.h>
#include <cstdio>
#include <cstdint>
namespace cg = cooperative_groups;

#define LAS __attribute__((address_space(3)))
typedef unsigned short bf16_t;
typedef short bf16x8 __attribute__((ext_vector_type(8)));
typedef float f32x4 __attribute__((ext_vector_type(4)));
typedef float f32x2 __attribute__((ext_vector_type(2)));
typedef unsigned u32x4 __attribute__((ext_vector_type(4)));
typedef unsigned u32x2 __attribute__((ext_vector_type(2)));

__device__ __forceinline__ unsigned cvt_pk_bf16(float lo, float hi) { unsigned r; asm volatile("v_cvt_pk_bf16_f32 %0, %1, %2" : "=v"(r) : "v"(lo), "v"(hi)); return r; }
__device__ __forceinline__ float bf_lo(unsigned w) { return __builtin_bit_cast(float, w << 16); }
__device__ __forceinline__ float bf_hi(unsigned w) { return __builtin_bit_cast(float, w & 0xffff0000u); }
__device__ __forceinline__ float bf2f(bf16_t h) { return __builtin_bit_cast(float, ((unsigned)h) << 16); }
__device__ __forceinline__ float sigmoid_fast(float x) { return __builtin_amdgcn_rcpf(1.f + __expf(-x)); }
__device__ __forceinline__ float silu_fast(float x) { return x * sigmoid_fast(x); }
__device__ __forceinline__ float gelu_tanh(float x) { const float z = 1.5957691216057308f * (x + 0.044715f * x * x * x); return x * sigmoid_fast(z); }

namespace pg8 {
constexpr int BM = 256, BK = 64, HALF = 128, HTB = HALF * BK * 2, STAGE_BYTES = 8 * HTB, NXCD = 8, WGM = 8;
__host__ __device__ __forceinline__ int lds_byte(int r, int c) { const int st = (r >> 4) * 2 + (c >> 5), rr = r & 15, cc = c & 31, ob = rr * 64 + cc * 2; return st * 1024 + (ob ^ (((ob >> 9) & 1) << 5)); }
__host__ __device__ __forceinline__ void stage_rc(int b, int& R, int& C) { const int st = b / 1024, sb = b % 1024, swz = sb ^ (((sb >> 9) & 1) << 5); R = (st >> 1) * 16 + swz / 64; C = (st & 1) * 32 + (swz % 64) / 2; }
__host__ __device__ __forceinline__ int perm32(int rho) { const int n = rho >> 4, i = rho & 15; return 8 * (i >> 2) + 4 * n + (i & 3); }

struct Unit { int pm, pn, g, k0, nt; };
struct Gemm { const bf16_t* A; const bf16_t* Bt; int lda, ldb, K; size_t gsA, gsB; };

struct StaticOrder {
    int nM, nN, nwg, G, c, ntf;
    __device__ void init(int M, int N, int K, int G_, int c_) { nM = M / BM; nN = N / BM; nwg = nM * nN; G = G_; c = c_; ntf = K / BK; }
    __device__ bool next(int i, Unit& u) const { const long L = (long)i * G + c; if (L >= nwg) return false; unit_of((int)L, u); return true; }
    __device__ void unit_of(int L, Unit& u) const {
        int wgid = L; { const int q = nwg / NXCD, r = nwg % NXCD, xcd = wgid % NXCD, off = wgid / NXCD; wgid = (xcd < r ? xcd * (q + 1) : r * (q + 1) + (xcd - r) * q) + off; }
        const int nig = WGM * nN, gid = wgid / nig, fm = gid * WGM, gsz = (nM - fm) < WGM ? (nM - fm) : WGM;
        u.pm = fm + ((wgid % nig) % gsz); u.pn = (wgid % nig) / gsz; u.g = 0; u.k0 = 0; u.nt = ntf;
    }
};
struct TailOrder {
    StaticOrder base; int nmini, nks, pn0, npn;
    __device__ void init(int M, int N, int K, int G_, int c_, int nmini_, int nks_, int pn0_, int npn_) { base.init(M, N, K, G_, c_); nmini = nmini_; nks = nks_; pn0 = pn0_; npn = npn_; }
    __device__ bool next(int i, Unit& u) const {
        const long L = (long)i * base.G + base.c; if (L < base.nwg) { base.unit_of((int)L, u); return true; }
        const int idx = (int)(L - base.nwg); if (idx >= nmini) return false;
        const int ks = idx % nks, t = idx / nks; u.pm = 64 + t / npn; u.pn = pn0 + t % npn; u.g = 0; u.k0 = ks * 256; u.nt = 4; return true;
    }
};
struct GroupOrder {
    int nM, nN, ng, G, c, ntf;
    __device__ void init(int nM_, int nN_, int ng_, int K, int G_, int c_) { nM = nM_; nN = nN_; ng = ng_; G = G_; c = c_; ntf = K / BK; }
    __device__ bool next(int i, Unit& u) const {
        if (c >= G) return false;
        const long L = (long)i * G + c; if (L >= (long)ng * nM * nN) return false;
        const int per = nM * nN, l = (int)L; u.g = l / per; const int r = l % per; u.pm = r / nN; u.pn = r % nN; u.k0 = 0; u.nt = ntf; return true;
    }
};

template <class Epi, class Sched>
__device__ __forceinline__ void gemm_phase(LAS unsigned char* lds, const Gemm g, const Sched& S, const Epi& E) {
    int tid_ = threadIdx.x; asm volatile("" : "+v"(tid_));
    const int tid = tid_, wid = __builtin_amdgcn_readfirstlane(tid >> 6), lane = tid & 63, wr = wid >> 2, wc = wid & 3, fr = lane & 15, fq = lane >> 4;
    unsigned voffA[2], voffB[2];
#pragma unroll
    for (int i = 0; i < 2; ++i) { int R, C; stage_rc(tid * 16 + i * 8192, R, C); const int Rb = Epi::PERM ? ((R & ~31) + perm32(R & 31)) : R;
        voffA[i] = (unsigned)(R * g.lda + C) * 2u; voffB[i] = (unsigned)(Rb * g.ldb + C) * 2u; }
    const size_t kstep = (size_t)(BK * 2);
    const size_t hstepA = (size_t)HALF * g.lda * 2, hstepB = (size_t)HALF * g.ldb * 2;
    const size_t tstepA = 2 * hstepA, tstepB = 2 * hstepB;
    const unsigned ldsw = (unsigned)wid * 1024u;
    const int aoff = lds_byte(wr * 64 + fr, fq * 8), boff = lds_byte(wc * 32 + fr, fq * 8);
#define PG8_SA(b, h) (((b) * 2 + (h)) * HTB)
#define PG8_SB(b, h) ((4 + (b) * 2 + (h)) * HTB)
#define PG8_STAGE(bufoff, gbase, voff) do { _Pragma("unroll") for (int _i = 0; _i < 2; ++_i) \
        __builtin_amdgcn_global_load_lds((const unsigned*)((const char*)(gbase) + (voff)[_i]), (LAS unsigned*)(lds + (bufoff) + ldsw + _i * 8192), 16, 0, 0); } while (0)
#define PG8_LDA(dst, b, h) do { _Pragma("unroll") for (int m = 0; m < 4; ++m) _Pragma("unroll") for (int k = 0; k < 2; ++k) dst[m][k] = *(const LAS bf16x8*)(lds + PG8_SA(b, h) + aoff + m * 2048 + k * 1024); } while (0)
#define PG8_LDB(dst, b, h) do { _Pragma("unroll") for (int n = 0; n < 2; ++n) _Pragma("unroll") for (int k = 0; k < 2; ++k) dst[n][k] = *(const LAS bf16x8*)(lds + PG8_SB(b, h) + boff + n * 2048 + k * 1024); } while (0)
#define PG8_MMA(ai, bj, At, Bt) do { __builtin_amdgcn_s_setprio(1); _Pragma("unroll") for (int m = 0; m < 4; ++m) _Pragma("unroll") for (int n = 0; n < 2; ++n) _Pragma("unroll") for (int k = 0; k < 2; ++k) \
        acc[ai][bj][m][n] = __builtin_amdgcn_mfma_f32_16x16x32_bf16(Bt[n][k], At[m][k], acc[ai][bj][m][n], 0, 0, 0); __builtin_amdgcn_s_setprio(0); } while (0)
#define PG8_WAIT_V(n) asm volatile("s_waitcnt vmcnt(" #n ")" ::: "memory")
#define PG8_WAIT_L(n) asm volatile("s_waitcnt lgkmcnt(" #n ")" ::: "memory")
#define PG8_BAR __builtin_amdgcn_s_barrier()
#define PG8_SCHED __builtin_amdgcn_sched_barrier(0)
    Unit cur, nxt; int ui = 0;
    if (!S.next(0, cur)) return;
    f32x4 acc[2][2][4][2];
#pragma unroll
    for (int a = 0; a < 2; ++a)
#pragma unroll
        for (int b = 0; b < 2; ++b)
#pragma unroll
            for (int m = 0; m < 4; ++m)
#pragma unroll
                for (int n = 0; n < 2; ++n) acc[a][b][m][n] = (f32x4){0.f, 0.f, 0.f, 0.f};
    bf16x8 At[4][2], B0[2][2], B1[2][2];
    const char* cA = (const char*)(g.A + (size_t)cur.g * g.gsA + cur.k0) + (size_t)cur.pm * tstepA; const char* cB = (const char*)(g.Bt + (size_t)cur.g * g.gsB + cur.k0) + (size_t)cur.pn * tstepB;
    PG8_STAGE(PG8_SB(0, 0), cB, voffB); PG8_STAGE(PG8_SB(0, 1), cB + hstepB, voffB); PG8_STAGE(PG8_SA(0, 0), cA, voffA); PG8_STAGE(PG8_SA(0, 1), cA + hstepA, voffA);
    if (wr == 1) PG8_BAR;
    PG8_WAIT_V(2); PG8_BAR;
    PG8_STAGE(PG8_SB(1, 0), cB + kstep, voffB); PG8_STAGE(PG8_SA(1, 0), cA + kstep, voffA); PG8_STAGE(PG8_SB(1, 1), cB + hstepB + kstep, voffB);
    PG8_WAIT_V(6); PG8_BAR;
    for (;;) {
        const bool has_next = S.next(ui + 1, nxt);
        const char* nA = has_next ? (const char*)(g.A + (size_t)nxt.g * g.gsA + nxt.k0) + (size_t)nxt.pm * tstepA : cA;
        const char* nB = has_next ? (const char*)(g.Bt + (size_t)nxt.g * g.gsB + nxt.k0) + (size_t)nxt.pn * tstepB : cB;
        const int nt = cur.nt;
        for (int t = 0; t < nt; t += 2) {
            const bool last = (t == nt - 2);
            const char* a1 = cA + (size_t)(t + 1) * kstep;
            const char* a2 = last ? nA : cA + (size_t)(t + 2) * kstep; const char* b2 = last ? nB : cB + (size_t)(t + 2) * kstep;
            const char* a3 = a2 + kstep; const char* b3 = b2 + kstep;
            PG8_LDB(B0, 0, 0); PG8_LDB(B1, 0, 1); PG8_SCHED; PG8_LDA(At, 0, 0); PG8_STAGE(PG8_SA(1, 1), a1 + hstepA, voffA);
            PG8_WAIT_V(8); PG8_WAIT_L(0); PG8_BAR; PG8_MMA(0, 0, At, B0); PG8_MMA(0, 1, At, B1); PG8_BAR; PG8_SCHED;
            PG8_LDA(At, 0, 1); PG8_STAGE(PG8_SB(0, 0), b2, voffB); PG8_STAGE(PG8_SB(0, 1), b2 + hstepB, voffB); PG8_STAGE(PG8_SA(0, 0), a2, voffA);
            PG8_WAIT_V(8); PG8_WAIT_L(0); PG8_BAR; PG8_MMA(1, 0, At, B0); PG8_MMA(1, 1, At, B1); PG8_BAR; PG8_SCHED;
            PG8_LDB(B0, 1, 0); PG8_LDB(B1, 1, 1); PG8_SCHED; PG8_LDA(At, 1, 0); PG8_STAGE(PG8_SA(0, 1), a2 + hstepA, voffA);
            PG8_WAIT_V(8); PG8_WAIT_L(0); PG8_BAR; PG8_MMA(0, 0, At, B0); PG8_MMA(0, 1, At, B1); PG8_BAR; PG8_SCHED;
            PG8_LDA(At, 1, 1); PG8_STAGE(PG8_SB(1, 0), b3, voffB); PG8_STAGE(PG8_SB(1, 1), b3 + hstepB, voffB); PG8_STAGE(PG8_SA(1, 0), a3, voffA);
            PG8_WAIT_V(8); PG8_WAIT_L(0); PG8_BAR; PG8_MMA(1, 0, At, B0); PG8_MMA(1, 1, At, B1); PG8_BAR; PG8_SCHED;
        }
        if (wr == 0) PG8_BAR;
        E(acc, cur, wr, wc, fr, fq);
        if (!has_next) break;
#pragma unroll
        for (int a = 0; a < 2; ++a)
#pragma unroll
            for (int b = 0; b < 2; ++b)
#pragma unroll
                for (int m = 0; m < 4; ++m)
#pragma unroll
                    for (int n = 0; n < 2; ++n) acc[a][b][m][n] = (f32x4){0.f, 0.f, 0.f, 0.f};
        cur = nxt; cA = nA; cB = nB; ++ui;
        if (wr == 1) PG8_BAR;
    }
    PG8_WAIT_V(0);
    PG8_BAR;
#undef PG8_SA
#undef PG8_SB
#undef PG8_STAGE
#undef PG8_LDA
#undef PG8_LDB
#undef PG8_MMA
#undef PG8_WAIT_V
#undef PG8_WAIT_L
#undef PG8_BAR
#undef PG8_SCHED
}
}

constexpr int D = 1024, SEQ = 8192, ML = 16384, CTXL = 256, MC = 512, MALL = ML + MC, FF = 2816, NMODW = 9 * 1024;
constexpr int TCH = 32, KS5 = 768, ROWS5 = 512;
constexpr float EPS = 1e-6f;
constexpr size_t MiB = 1u << 20;
constexpr size_t WS_MOD = 128 * 1024, WS_HCTX = 512 * 1024;
constexpr size_t WS_WIN = 1 * MiB, WS_WMIX = 3 * MiB, WS_WGLU = 5 * MiB, WS_BB = 5 * MiB + 512 * 1024, WS_KTAB = 6 * MiB, WS_PW = 8 * MiB;
constexpr size_t WS_W13A = 10 * MiB, WS_W2A = 21 * MiB, WS_W13B = 27 * MiB, WS_W2B = 38 * MiB, WS_WST = 44 * MiB, WS_BS5 = 52 * MiB;
constexpr size_t WS_HN = 76 * MiB, WS_MIX = 109 * MiB, WS_X1C = 141 * MiB, WS_UCTX = 143 * MiB, WS_UB = 144 * MiB;
constexpr size_t WS_POOL = 144 * MiB, WS_AS5 = 160 * MiB, WS_S = 184 * MiB, WS_Y = 200 * MiB, WS_UCTXP = 216 * MiB, WS_END = 236 * MiB;
constexpr size_t WS_PC = WS_MIX;
constexpr int LDS_BYTES = 147456;

struct KArgs { const float* in[24]; float* out; unsigned char* ws; };

struct EpiUp {
    static constexpr bool PERM = true;
    bf16_t* O; const float* ssq; const float* sw1; const float* sw3;
    __device__ __forceinline__ void operator()(const f32x4 (&acc)[2][2][4][2], const pg8::Unit& u, int wr, int wc, int fr, int fq) const {
        const int row0 = u.pm * 256 + wr * 64 + fr, f0 = u.pn * 128 + wc * 16 + 4 * fq, set = u.pm < 32 ? 0 : (u.pm < 64 ? 1 : 2);
        f32x4 s1[2], s3[2];
#pragma unroll
        for (int bj = 0; bj < 2; ++bj) { s1[bj] = ssq ? *(const f32x4*)(sw1 + set * FF + f0 + bj * 64) : (f32x4){0.f, 0.f, 0.f, 0.f}; s3[bj] = ssq ? *(const f32x4*)(sw3 + set * FF + f0 + bj * 64) : (f32x4){0.f, 0.f, 0.f, 0.f}; }
#pragma unroll
        for (int ai = 0; ai < 2; ++ai)
#pragma unroll
            for (int m = 0; m < 4; ++m) { bf16_t* rowp = O + (size_t)(row0 + ai * 128 + m * 16) * FF + f0;
                float r = 1.f;
                if (ssq) { const f32x4* sp = (const f32x4*)(ssq + (size_t)(row0 + ai * 128 + m * 16) * 16); const f32x4 t = (sp[0] + sp[1]) + (sp[2] + sp[3]); r = 1.0f / sqrtf(((t.x + t.y) + (t.z + t.w)) * (1.f / D) + EPS); }
#pragma unroll
                for (int bj = 0; bj < 2; ++bj) { const f32x4 a = acc[ai][bj][m][0] * r + s1[bj], b = acc[ai][bj][m][1] * r + s3[bj];
                    u32x2 w; w.x = cvt_pk_bf16(silu_fast(a[0]) * b[0], silu_fast(a[1]) * b[1]); w.y = cvt_pk_bf16(silu_fast(a[2]) * b[2], silu_fast(a[3]) * b[3]);
                    *(u32x2*)(rowp + bj * 64) = w; } }
    }
};
template <int HALFC> struct EpiRes {
    static constexpr bool PERM = false;
    static constexpr float coef = HALFC ? 0.5f : 1.0f;
    const float* resid_l; float* out_l; float* part_c; const float* gate;
    bf16_t* xn; const float* gvec; const float* scl; float* ssq;
    __device__ __forceinline__ void operator()(const f32x4 (&acc)[2][2][4][2], const pg8::Unit& u, int wr, int wc, int fr, int fq) const {
        const int set = u.pm < 32 ? 0 : 1;
        const int row0 = u.pm * 256 + wr * 64 + fr, col0 = u.pn * 256 + wc * 32 + 4 * fq;
        if (u.pm >= 64) { float* pb = part_c + (size_t)(u.k0 >> 8) * MC * D;
#pragma unroll
            for (int ai = 0; ai < 2; ++ai)
#pragma unroll
                for (int m = 0; m < 4; ++m) { const size_t off = (size_t)(row0 - ML + ai * 128 + m * 16) * D + col0;
#pragma unroll
                    for (int bj = 0; bj < 2; ++bj)
#pragma unroll
                        for (int n = 0; n < 2; ++n) *(f32x4*)(pb + off + bj * 128 + n * 16) = acc[ai][bj][m][n]; }
            return; }
        const float* rb = resid_l; float* ob = out_l;
        f32x4 gv[2][2];
#pragma unroll
        for (int bj = 0; bj < 2; ++bj)
#pragma unroll
            for (int n = 0; n < 2; ++n) gv[bj][n] = *(const f32x4*)(gate + set * NMODW + col0 + bj * 128 + n * 16) * coef;
#pragma unroll
        for (int am = 0; am < 4; ++am) { f32x4 rv[2][2][2];
#pragma unroll
            for (int mm = 0; mm < 2; ++mm) { const int ai = am >> 1, m = (am & 1) * 2 + mm; const size_t off = (size_t)(row0 + ai * 128 + m * 16) * D + col0;
#pragma unroll
                for (int bj = 0; bj < 2; ++bj)
#pragma unroll
                    for (int n = 0; n < 2; ++n) rv[mm][bj][n] = *(const f32x4*)(rb + off + bj * 128 + n * 16); }
            asm volatile("" ::: "memory");
#pragma unroll
            for (int mm = 0; mm < 2; ++mm) { const int ai = am >> 1, m = (am & 1) * 2 + mm; const size_t off = (size_t)(row0 + ai * 128 + m * 16) * D + col0; float sq = 0.f;
#pragma unroll
                for (int bj = 0; bj < 2; ++bj)
#pragma unroll
                    for (int n = 0; n < 2; ++n) { const f32x4 v = rv[mm][bj][n] + gv[bj][n] * acc[ai][bj][m][n]; *(f32x4*)(ob + off + bj * 128 + n * 16) = v;
                        if (xn) { const int cc = col0 + bj * 128 + n * 16; const f32x4 xv = v * (*(const f32x4*)(gvec + cc) * (*(const f32x4*)(scl + set * NMODW + cc) + 1.0f));
                            u32x2 w; w.x = cvt_pk_bf16(xv.x, xv.y); w.y = cvt_pk_bf16(xv.z, xv.w); *(u32x2*)(xn + off + bj * 128 + n * 16) = w; sq += (v.x * v.x + v.y * v.y) + (v.z * v.z + v.w * v.w); } }
                if (xn) { sq += __shfl_xor(sq, 16); sq += __shfl_xor(sq, 32); if (fq == 0) ssq[(size_t)(row0 + ai * 128 + m * 16) * 16 + u.pn * 4 + wc] = sq; } }
            asm volatile("" ::: "memory"); }
    }
};
struct EpiWin {
    static constexpr bool PERM = true;
    bf16_t* pool; bf16_t* As5; float* Uctx; const float* ssq; const float* sw;
    __device__ __forceinline__ void operator()(const f32x4 (&acc)[2][2][4][2], const pg8::Unit& u, int wr, int wc, int fr, int fq) const {
        const int row0 = u.pm * 256 + wr * 64 + fr;
        const bool isc = u.pm >= 64, ispool = u.pn < 2;
        if (isc && ispool) return;
#pragma unroll
        for (int ai = 0; ai < 2; ++ai)
#pragma unroll
            for (int m = 0; m < 4; ++m) { const int row = row0 + ai * 128 + m * 16;
                float r = 1.f;
                if (!isc) { const f32x4* sp = (const f32x4*)(ssq + (size_t)row * 16); const f32x4 t = (sp[0] + sp[1]) + (sp[2] + sp[3]); r = 1.0f / sqrtf(((t.x + t.y) + (t.z + t.w)) * (1.f / D) + EPS); }
#pragma unroll
                for (int bj = 0; bj < 2; ++bj) { const int col0 = u.pn * 256 + bj * 128 + wc * 32 + 8 * fq; f32x4 v0 = acc[ai][bj][m][0], v1 = acc[ai][bj][m][1];
                    if (!isc) { const float* swp = sw + (u.pm < 32 ? 0 : 1024) + col0; v0 = v0 * r + *(const f32x4*)swp; v1 = v1 * r + *(const f32x4*)(swp + 4); }
                    if (isc) { float* p = Uctx + (size_t)(u.k0 >> 8) * MC * 512 + (size_t)(row - ML) * 512 + (col0 - 512); *(f32x4*)p = v0; *(f32x4*)(p + 4) = v1; }
                    else { u32x4 w; w.x = cvt_pk_bf16(v0[0], v0[1]); w.y = cvt_pk_bf16(v0[2], v0[3]); w.z = cvt_pk_bf16(v1[0], v1[1]); w.w = cvt_pk_bf16(v1[2], v1[3]);
                        const int b = row >> 13, tok = row & 8191;
                        if (ispool) { const int k = col0 >> 7, slab = (col0 >> 3) & 15; *(u32x4*)(pool + ((size_t)((b * 4 + k) * 16 + slab) * 8192 + tok) * 8) = w; }
                        else { const int cs = col0 - 512, gg = cs >> 4, c0 = cs & 15; *(u32x4*)(As5 + ((size_t)gg * ROWS5 + b * 256 + (tok >> 5)) * KS5 + (tok & 31) * 16 + c0) = w; } } } }
    }
};
struct EpiState {
    static constexpr bool PERM = false;
    float* S;
    __device__ __forceinline__ void operator()(const f32x4 (&acc)[2][2][4][2], const pg8::Unit& u, int wr, int wc, int fr, int fq) const {
        const int row0 = u.pm * 256 + wr * 64 + fr, col0 = wc * 32 + 4 * fq;
#pragma unroll
        for (int ai = 0; ai < 2; ++ai)
#pragma unroll
            for (int m = 0; m < 4; ++m) { float* rowp = S + ((size_t)u.g * ROWS5 + row0 + ai * 128 + m * 16) * 256 + col0;
#pragma unroll
                for (int bj = 0; bj < 2; ++bj)
#pragma unroll
                    for (int n = 0; n < 2; ++n) *(f32x4*)(rowp + bj * 128 + n * 16) = acc[ai][bj][m][n]; }
    }
};
struct EpiS5 {
    static constexpr bool PERM = true;
    bf16_t* Y;
    __device__ __forceinline__ void operator()(const f32x4 (&acc)[2][2][4][2], const pg8::Unit& u, int wr, int wc, int fr, int fq) const {
        const int row0 = u.pm * 256 + wr * 64 + fr;
#pragma unroll
        for (int ai = 0; ai < 2; ++ai)
#pragma unroll
            for (int m = 0; m < 4; ++m) { const int row = row0 + ai * 128 + m * 16, b = row >> 8, chunk = row & 255;
#pragma unroll
                for (int bj = 0; bj < 2; ++bj) { const int n0 = u.pn * 256 + bj * 128 + wc * 32 + 8 * fq, t = n0 >> 4, c0 = n0 & 15; const f32x4 v0 = acc[ai][bj][m][0], v1 = acc[ai][bj][m][1];
                    u32x4 w; w.x = cvt_pk_bf16(gelu_tanh(v0[0]), gelu_tanh(v0[1])); w.y = cvt_pk_bf16(gelu_tanh(v0[2]), gelu_tanh(v0[3]));
                    w.z = cvt_pk_bf16(gelu_tanh(v1[0]), gelu_tanh(v1[1])); w.w = cvt_pk_bf16(gelu_tanh(v1[2]), gelu_tanh(v1[3]));
                    *(u32x4*)(Y + (size_t)(b * SEQ + chunk * TCH + t) * 512 + u.g * 16 + c0) = w; } }
    }
};
struct EpiGlu {
    static constexpr bool PERM = true;
    const bf16_t* Y; bf16_t* mix;
    __device__ __forceinline__ void operator()(const f32x4 (&acc)[2][2][4][2], const pg8::Unit& u, int wr, int wc, int fr, int fq) const {
        const int row0 = u.pm * 256 + wr * 64 + fr;
#pragma unroll
        for (int ai = 0; ai < 2; ++ai)
#pragma unroll
            for (int m = 0; m < 4; ++m) { const int row = row0 + ai * 128 + m * 16;
#pragma unroll
                for (int bj = 0; bj < 2; ++bj) { const int col0 = u.pn * 256 + bj * 128 + wc * 32 + 8 * fq; const f32x4 v0 = acc[ai][bj][m][0], v1 = acc[ai][bj][m][1];
                    const u32x4 y = *(const u32x4*)(Y + (size_t)row * 512 + col0); u32x4 w;
                    w.x = cvt_pk_bf16(bf_lo(y.x) * sigmoid_fast(v0[0]), bf_hi(y.x) * sigmoid_fast(v0[1])); w.y = cvt_pk_bf16(bf_lo(y.y) * sigmoid_fast(v0[2]), bf_hi(y.y) * sigmoid_fast(v0[3]));
                    w.z = cvt_pk_bf16(bf_lo(y.z) * sigmoid_fast(v1[0]), bf_hi(y.z) * sigmoid_fast(v1[1])); w.w = cvt_pk_bf16(bf_lo(y.w) * sigmoid_fast(v1[2]), bf_hi(y.w) * sigmoid_fast(v1[3]));
                    *(u32x4*)(mix + (size_t)row * D + 512 + col0) = w; } }
    }
};

__device__ __forceinline__ float wave_sum(float v) {
#pragma unroll
    for (int o = 1; o < 64; o <<= 1) v += __shfl_xor(v, o);
    return v;
}
__device__ __forceinline__ void transpose_item(const float* W, int ldw, bf16_t* WT, int ldd, int mode, LAS float* scr, int kb, int nb, int lane) {
    const int k0 = 64 * kb, n0 = 32 * nb;
#pragma unroll 8
    for (int i = 0; i < 32; ++i) { const int kk = 2 * i + (lane >> 5); scr[kk * 33 + (lane & 31)] = W[(size_t)(k0 + kk) * ldw + n0 + (lane & 31)]; }
    asm volatile("s_waitcnt lgkmcnt(0)" ::: "memory");
    const int c = lane & 7;
#pragma unroll
    for (int j = 0; j < 4; ++j) { const int n = (lane >> 3) + 8 * j, ncol = n0 + n; const LAS float* s = scr + (8 * c) * 33 + n;
        const int row = mode == 0 ? ncol : (8 * (ncol >> 2) + (ncol & 3) + (mode == 2 ? 4 : 0));
        u32x4 o; o.x = cvt_pk_bf16(s[0 * 33], s[1 * 33]); o.y = cvt_pk_bf16(s[2 * 33], s[3 * 33]); o.z = cvt_pk_bf16(s[4 * 33], s[5 * 33]); o.w = cvt_pk_bf16(s[6 * 33], s[7 * 33]);
        *(u32x4*)(WT + (size_t)row * ldd + k0 + 8 * c) = o; }
    asm volatile("s_waitcnt lgkmcnt(0)" ::: "memory");
}
__device__ __forceinline__ void norm_mod_row(const float* xrow, const float* g, const float* shift, const float* scale, bf16_t* orow, int lane) {
    const f32x4* xr = (const f32x4*)xrow + lane; f32x4 v[4]; float s = 0.f;
#pragma unroll
    for (int j = 0; j < 4; ++j) { v[j] = xr[64 * j]; s += (v[j].x * v[j].x + v[j].y * v[j].y) + (v[j].z * v[j].z + v[j].w * v[j].w); }
    const float r = 1.0f / sqrtf(wave_sum(s) * (1.f / D) + EPS);
    u32x2* o8 = (u32x2*)orow + lane;
#pragma unroll
    for (int j = 0; j < 4; ++j) { const f32x4 gg = ((const f32x4*)g)[lane + 64 * j], sh = ((const f32x4*)shift)[lane + 64 * j], sc = ((const f32x4*)scale)[lane + 64 * j];
        const f32x4 y = (v[j] * r) * gg; const f32x4 h = y * (sc + 1.0f) + sh; u32x2 w; w.x = cvt_pk_bf16(h.x, h.y); w.y = cvt_pk_bf16(h.z, h.w); o8[64 * j] = w; }
}


#define XB_TMO      128
#define XB_XCNT(j)  (256  + 64 * (j))
#define XB_XSUB(j)  (1280 + 64 * (j))
#define XB_XGEN(j)  (2304 + 64 * (j))
#define XB_TOP      3328
#define XB_TOPGEN   3392
#define XCD_BAR_WORDS 3456
#define XB_SPIN_CAP (1u << 22)
__device__ __forceinline__ unsigned xb_ld(unsigned* p)              { return __hip_atomic_load(p, __ATOMIC_RELAXED, __HIP_MEMORY_SCOPE_AGENT); }
__device__ __forceinline__ unsigned xb_add(unsigned* p, unsigned v) { return __hip_atomic_fetch_add(p, v, __ATOMIC_RELAXED, __HIP_MEMORY_SCOPE_AGENT); }
__device__ __forceinline__ unsigned xb_xcc_id() { return (unsigned)__builtin_amdgcn_s_getreg((3 << 11) | 20) & 0xFu; }
#define XB_SPIN(cond, bar) do { unsigned _sp = 0; while (cond) { __builtin_amdgcn_s_sleep(1); \
    if ((++_sp & 255u) == 0u) { if (xb_ld(&(bar)[XB_TMO])) break; if (_sp > XB_SPIN_CAP) { atomicAdd(&(bar)[XB_TMO], 1u); break; } } } } while (0)
struct XcdBarrier { unsigned* bar; unsigned x; volatile LAS unsigned* st; };
__device__ __forceinline__ XcdBarrier xcd_barrier_post(unsigned* bar, volatile LAS unsigned* st) {
    XcdBarrier b; b.bar = bar; b.x = xb_xcc_id(); b.st = st;
    if (threadIdx.x == 0) (void)xb_add(&bar[XB_XCNT(b.x)], 1u);
    return b;
}
__device__ __forceinline__ void xcd_barrier_complete(unsigned* bar, unsigned x, unsigned& nloc, unsigned& nx) {
    const unsigned G = gridDim.x * gridDim.y * gridDim.z;
    unsigned sum, cnt, mine, sp = 0u;
    for (;;) {
        sum = 0u; cnt = 0u; mine = 0u;
#pragma unroll
        for (unsigned j = 0; j < 16; ++j) { const unsigned c = xb_ld(&bar[XB_XCNT(j)]); sum += c; cnt += (c > 0u) ? 1u : 0u; mine = (j == x) ? c : mine; }
        if (sum == G) break;
        __builtin_amdgcn_s_sleep(1);
        if ((++sp & 255u) == 0u) { if (xb_ld(&bar[XB_TMO])) break; if (sp > XB_SPIN_CAP) { atomicAdd(&bar[XB_TMO], 1u); break; } }
    }
    nloc = mine > 0u ? mine : 1u; nx = cnt > 0u ? cnt : 1u;
}
__device__ __forceinline__ void xcd_barrier(const XcdBarrier& b) {
    asm volatile("s_waitcnt vmcnt(0)" ::: "memory");
    __syncthreads();
    if (threadIdx.x == 0) {
        unsigned* bar = b.bar;
        __builtin_amdgcn_s_waitcnt(0);
        unsigned nloc = b.st[0], nx = b.st[1];
        if (nloc == 0u) { xcd_barrier_complete(bar, b.x, nloc, nx); b.st[0] = nloc; b.st[1] = nx; }
        const unsigned old = xb_add(&bar[XB_XSUB(b.x)], 1u);
        const unsigned gen = old / nloc;
        if (old + 1u == (gen + 1u) * nloc) {
            __builtin_amdgcn_fence(__ATOMIC_RELEASE, "agent");
            asm volatile("s_waitcnt vmcnt(0)" ::: "memory");
            const unsigned og = xb_add(&bar[XB_TOP], 1u);
            const unsigned tg = og / nx;
            if (og + 1u == (tg + 1u) * nx) xb_add(&bar[XB_TOPGEN], 1u);
            else XB_SPIN(xb_ld(&bar[XB_TOPGEN]) == tg, bar);
            __builtin_amdgcn_fence(__ATOMIC_ACQUIRE, "agent");
            xb_add(&bar[XB_XGEN(b.x)], 1u);
            asm volatile("s_waitcnt vmcnt(0)" ::: "memory");
        } else {
            XB_SPIN(xb_ld(&bar[XB_XGEN(b.x)]) == gen, bar);
            __builtin_amdgcn_fence(__ATOMIC_ACQUIRE, "agent");
            asm volatile("s_waitcnt vmcnt(0)" ::: "memory");
        }
    }
    __syncthreads();
}
#ifndef PHMASK
#define PHMASK 0xFFFFF
#endif
#ifndef REPMASK
#define REPMASK 0
#endif
#ifndef XSYNC
#define XSYNC 0
#endif
#define PH(k) for (int rep_ = 0; rep_ < 1 + (((REPMASK) >> (k)) & 1); ++rep_) if constexpr (((PHMASK) >> (k)) & 1)

template <int W>
__device__ __forceinline__ void pool_rows(LAS bf16_t* raw, LAS float* rowb, LAS bf16_t* ob, bf16_t* dst  , int tid, int r_begin, int r_end) {
    constexpr int lo = W / 2, hi = W - 1 - lo;
    const int c = tid >> 3, ch = tid & 7;
    const int clo = c - lo < 0 ? 0 : c - lo, chi = c + hi > 63 ? 63 : c + hi; const float icc = 1.0f / (float)(chi - clo + 1);
    float vs = 0.f;
    { const int ra = r_begin - lo < 0 ? 0 : r_begin - lo, rz = r_begin + hi > 127 ? 127 : r_begin + hi;
      for (int r = ra; r <= rz; ++r) vs += bf2f(raw[(r * 64 + c) * 8 + ch]); }
#pragma unroll 1
    for (int r = r_begin; r < r_end; r += 4) {
#pragma unroll
        for (int q = 0; q < 4; ++q) { const int rq = r + q, rlo = rq - lo < 0 ? 0 : rq - lo, rhi = rq + hi > 127 ? 127 : rq + hi;
            rowb[q * 512 + tid] = vs * __builtin_amdgcn_rcpf((float)(rhi - rlo + 1));
            if (rq + 1 + hi <= 127) vs += bf2f(raw[((rq + 1 + hi) * 64 + c) * 8 + ch]);
            if (rq - lo >= 0) vs -= bf2f(raw[((rq - lo) * 64 + c) * 8 + ch]); }
        __syncthreads();
#pragma unroll
        for (int q = 0; q < 4; ++q) { float hv[W];
#pragma unroll
            for (int i = 0; i < W; ++i) { int c2 = c - lo + i; c2 = c2 < 0 ? 0 : (c2 > 63 ? 63 : c2); hv[i] = rowb[q * 512 + c2 * 8 + ch]; }
            float hs = 0.f;
#pragma unroll
            for (int i = 0; i < W; ++i) { const int c2 = c - lo + i; hs += (c2 >= 0 && c2 <= 63) ? hv[i] : 0.f; }
            const float dval = hs * icc - bf2f(raw[((r + q) * 64 + c) * 8 + ch]);
            ob[q * 512 + tid] = (bf16_t)(cvt_pk_bf16(dval, 0.f) & 0xffffu); }
        __syncthreads();
        if (tid < 256) { const int q = tid >> 6, cc = tid & 63; *(u32x4*)(dst + (size_t)((r + q) * 64 + cc) * D) = *(const LAS u32x4*)(ob + q * 512 + cc * 8); }
    }
}

__global__ void __launch_bounds__(512, 2) fwd_megakernel(KArgs a) {
    extern __shared__ __attribute__((aligned(16))) unsigned char lds_raw[];
    LAS unsigned char* lds = (LAS unsigned char*)lds_raw;
    cg::grid_group grid = cg::this_grid();
    const int tid = threadIdx.x, lane = tid & 63, wave = __builtin_amdgcn_readfirstlane(tid >> 6);
    const int G = gridDim.x, bid = blockIdx.x;
    const int gw = bid * 8 + wave, NGW = G * 8;
    volatile LAS unsigned* bst = (volatile LAS unsigned*)(lds + LDS_BYTES - 64);
    if (tid == 0) { bst[0] = 0u; bst[1] = 0u; }
    __syncthreads();
    if (bid == 0) for (int i = tid; i < XCD_BAR_WORDS; i += 512) ((unsigned*)a.ws)[i] = 0u;
#ifndef TPROBE
#define TPROBE 0
#endif
#ifndef TSEL_A
#define TSEL_A 0
#define TSEL_B 1
#endif
#if TPROBE
    unsigned long long* tsb = (unsigned long long*)(a.ws + 65536); int tsi = 1;
    if (bid == 0 && tid == 0) tsb[0] = __builtin_amdgcn_s_memrealtime();
#define TSTAMP() do { if (bid == 0 && tid == 0) tsb[tsi] = __builtin_amdgcn_s_memrealtime(); ++tsi; } while (0)
#else
#define TSTAMP() do {} while (0)
#endif
#define GSYNC() do { xcd_barrier(xbar); TSTAMP(); } while (0)
#define DEFER_T(lo_, hi_) do { const int nidle_ = G > 128 ? G - 128 : G, rank_ = G > 128 ? bid - 128 : bid; \
        if (rank_ >= 0) { LAS float* scr_ = (LAS float*)(lds + wave * 16384); \
            for (int d_ = (lo_) + rank_ * 8 + wave; d_ < (hi_); d_ += nidle_ * 8) { int r_ = d_; \
                if (r_ < 1408) { transpose_item(a.in[7] + (size_t)D * FF, FF, W13b, D, 1, scr_, r_ / 88, r_ % 88, lane); continue; } r_ -= 1408; \
                if (r_ < 1408) { transpose_item(a.in[8] + (size_t)D * FF, FF, W13b, D, 2, scr_, r_ / 88, r_ % 88, lane); continue; } r_ -= 1408; \
                transpose_item(a.in[9] + (size_t)D * FF, D, W2b, FF, 0, scr_, r_ / 32, r_ % 32, lane); } } } while (0)
#define ws (a.ws)
#define xin_ (a.in[0])
#define cvec (a.in[1])
#define ctx (a.in[2])
#define cctx (a.in[3])
#define norm_g (a.in[4])
#define w_ada (a.in[5])
#define b_ada (a.in[6])
#define mod ((float*)(ws + WS_MOD))
#define Hctx ((f32x2*)(ws + WS_HCTX))
#define Win_t ((bf16_t*)(ws + WS_WIN))
#define Wmix_t ((bf16_t*)(ws + WS_WMIX))
#define Wglu_t ((bf16_t*)(ws + WS_WGLU))
#define BB ((f32x2*)(ws + WS_BB))
#define Ktab ((float*)(ws + WS_KTAB))
#define PW ((f32x2*)(ws + WS_PW))
#define W13a ((bf16_t*)(ws + WS_W13A))
#define W2a ((bf16_t*)(ws + WS_W2A))
#define W13b ((bf16_t*)(ws + WS_W13B))
#define W2b ((bf16_t*)(ws + WS_W2B))
#define Wst ((bf16_t*)(ws + WS_WST))
#define Bs5 ((bf16_t*)(ws + WS_BS5))
#define Hn ((bf16_t*)(ws + WS_HN))
#define mixcat ((bf16_t*)(ws + WS_MIX))
#define X1c ((float*)(ws + WS_X1C))
#define Uctx ((float*)(ws + WS_UCTXP))
#define Pc ((float*)(ws + WS_PC))
#define SSQ ((float*)(ws + WS_X1C))
#define SW_IN ((float*)(ws + WS_X1C + MiB))
#define SW1 ((float*)(ws + WS_X1C + MiB + 16384))
#define SW3 ((float*)(ws + WS_X1C + MiB + 65536))
#define RCTX ((float*)(ws + 73728))
#define Ubuf ((bf16_t*)(ws + WS_UB))
#define poolb ((bf16_t*)(ws + WS_POOL))
#define As5 ((bf16_t*)(ws + WS_AS5))
#define Sbuf ((float*)(ws + WS_S))
#define Ybuf ((bf16_t*)(ws + WS_Y))
#define out (a.out)

    PH(0) {
        if (bid == 0 && tid == 0) *(unsigned*)(ws + 69632) = 0u;
        LAS float* sc = (LAS float*)lds;
        LAS float* red = (LAS float*)(lds + 16384);
        for (int i = tid; i < 3072; i += 512) { const float v = i < 2048 ? cvec[i] : cctx[i - 2048]; sc[i] = v / (1.f + expf(-v)); }
        __syncthreads();
        for (int strip = bid; strip < 256; strip += G) {
            const int cg4 = tid % 9, kk = tid / 9;
            f32x4 a0 = {0.f, 0.f, 0.f, 0.f}, a1 = a0, a2 = a0;
            if (tid < 504) {
#pragma unroll
                for (int it = 0; it < 19; ++it) { const int k = kk + 56 * it; if (k < 1024) { const f32x4 w = *(const f32x4*)(w_ada + (size_t)k * NMODW + strip * 36 + cg4 * 4);
                    a0 += w * sc[k]; a1 += w * sc[1024 + k]; a2 += w * sc[2048 + k]; } }
#pragma unroll
                for (int i = 0; i < 4; ++i) { red[kk * 112 + cg4 * 4 + i] = a0[i]; red[kk * 112 + 36 + cg4 * 4 + i] = a1[i]; red[kk * 112 + 72 + cg4 * 4 + i] = a2[i]; }
            }
            __syncthreads();
            if (tid < 108) { float s = 0.f;
#pragma unroll 8
                for (int k2 = 0; k2 < 56; ++k2) s += red[k2 * 112 + tid];
                const int r = tid / 36, col = strip * 36 + (tid % 36); mod[r * NMODW + col] = s + b_ada[col]; }
            __syncthreads();
        }
        LAS f32x2* pwL = (LAS f32x2*)(lds + 65536);
        LAS f32x2* bbL = (LAS f32x2*)(lds + 65536 + 17408);
        LAS f32x2* cL = (LAS f32x2*)(lds + 65536 + 17408 + 8192);
        const float* a_re = a.in[13]; const float* a_im = a.in[14]; const float* log_dt = a.in[15]; const float* b_re = a.in[16]; const float* b_im = a.in[17];
        const float* c_re = a.in[18]; const float* c_im = a.in[19];
#pragma unroll 1
        for (int it2 = G - 1 - bid; it2 < 256; it2 += G) {
            const int it = it2 >> 2, qq = it2 & 3; const bool wr_tab = qq == 0;
            const int g = it >> 1, dir = it & 1, pd = dir * 32 + g;
            const float dt = expf(log_dt[pd]);
            for (int idx = tid; idx < 33 * 64; idx += 512) { const int tau = idx >> 6, p = idx & 63; const float are = a_re[pd * 64 + p], aim = a_im[pd * 64 + p];
                const float mag = expf(are * dt * (float)tau); double ang = (double)aim * (double)dt * (double)tau; ang -= 6.283185307179586 * rint(ang * 0.15915494309189535);
                float sn, cs; sincosf((float)ang, &sn, &cs); const f32x2 v = {mag * cs, mag * sn}; pwL[idx] = v; if (wr_tab) PW[(size_t)it * 33 * 64 + idx] = v; }
            for (int idx = tid; idx < 1024; idx += 512) { const f32x2 v = {c_re[(size_t)pd * 1024 + idx], c_im[(size_t)pd * 1024 + idx]}; cL[idx] = v; }
            __syncthreads();
            for (int idx = tid; idx < 1024; idx += 512) { const int p = idx >> 4; const float are = a_re[pd * 64 + p], aim = a_im[pd * 64 + p]; const float zr = are * dt, zi = aim * dt;
                float qr, qi;
                if (zr * zr + zi * zi < 0.25f) { float tr = 1.f, ti = 0.f;
                    for (int k = 12; k >= 2; --k) { const float ik = 1.0f / (float)k, wr_ = zr * ik, wi_ = zi * ik; const float nr = 1.f + (wr_ * tr - wi_ * ti), ni = wr_ * ti + wi_ * tr; tr = nr; ti = ni; }
                    qr = dt * tr; qi = dt * ti; }
                else { const f32x2 ab = pwL[64 + p]; const float nr = ab.x - 1.f, ni = ab.y, den = are * are + aim * aim; qr = (nr * are + ni * aim) / den; qi = (ni * are - nr * aim) / den; }
                const float br = b_re[(size_t)g * 1024 + idx], bi = b_im[(size_t)g * 1024 + idx];
                const f32x2 v = {qr * br - qi * bi, qr * bi + qi * br}; bbL[idx] = v; if (wr_tab) BB[(size_t)it * 1024 + idx] = v; }
            __syncthreads();
#pragma unroll 1
            for (int j = 0; j < 4; ++j) { const int idx = qq * 2048 + tid + 512 * j, tau = idx >> 8, c = (idx >> 4) & 15, cc = idx & 15; float s = 0.f;
#pragma unroll 8
                for (int p = 0; p < 64; ++p) { const f32x2 C = cL[c * 64 + p], w = pwL[tau * 64 + p], b = bbL[p * 16 + cc]; const float zr = C.x * w.x - C.y * w.y, zi = C.x * w.y + C.y * w.x; s += zr * b.x - zi * b.y; }
                Ktab[(size_t)it * 8192 + idx] = s; }
            __syncthreads();
        }
    }
    grid.sync(); TSTAMP();
    const XcdBarrier xbar = xcd_barrier_post((unsigned*)ws, bst);

    PH(1) {
        LAS float* scr = (LAS float*)(lds + wave * 16384);
        constexpr int I_UP = 16 * 88, I_DN = 44 * 32, I_IN = 16 * 32, I_OUT = 8 * 32, I_GLU = 8 * 16;
        constexpr int NITEMS = 2 * I_UP + I_DN + I_IN + I_OUT + I_GLU;
        for (int it = gw; it < NITEMS; it += NGW) {
            int r = it;
            if (r < I_UP) { transpose_item(a.in[7], FF, W13a, D, 1, scr, r / 88, r % 88, lane); continue; } r -= I_UP;
            if (r < I_UP) { transpose_item(a.in[8], FF, W13a, D, 2, scr, r / 88, r % 88, lane); continue; } r -= I_UP;
            if (r < I_DN) { transpose_item(a.in[9], D, W2a, FF, 0, scr, r / 32, r % 32, lane); continue; } r -= I_DN;
            if (r < I_IN) { transpose_item(a.in[10], D, Win_t, D, 0, scr, r / 32, r % 32, lane); continue; } r -= I_IN;
            if (r < I_OUT) { transpose_item(a.in[22] + (size_t)512 * D, D, Wmix_t + 512, D, 0, scr, r / 32, r % 32, lane); continue; } r -= I_OUT;
            transpose_item(a.in[21], 512, Wglu_t, 512, 0, scr, r / 16, r % 16, lane);
        }
        {
            const float* pool_w = a.in[11]; const float* pool_scale = a.in[12]; const float* w_out = a.in[22];
            for (int it = G - 1 - bid; it < 256; it += G) { const int k = it >> 6, cb = (it >> 2) & 15, nq = it & 3, n = nq * 256 + (tid & 255), c4 = cb * 8 + (tid >> 8) * 4;
                float ac[4] = {0.f, 0.f, 0.f, 0.f};
#pragma unroll 8
                for (int d = 0; d < 128; ++d) { const float wo = w_out[(size_t)(k * 128 + d) * D + n] * pool_scale[k * 128 + d];
#pragma unroll
                    for (int i = 0; i < 4; ++i) ac[i] += wo * pool_w[(size_t)(k * 128 + c4 + i) * 128 + d]; }
                u32x2 w0; w0.x = cvt_pk_bf16(ac[0], ac[1]); w0.y = cvt_pk_bf16(ac[2], ac[3]);
                *(u32x2*)(Wmix_t + (size_t)n * D + k * 128 + c4) = w0; }
        }
        {
            const float* c_re = a.in[18]; const float* c_im = a.in[19]; const float* dskip = a.in[20];
            const int gt = bid * 512 + tid, NT = G * 512;
            for (int e = gt; e < 32 * 512 * 96; e += NT) { const int k8 = e % 96, n = (e / 96) & 511, g = e / (96 * 512), t = n >> 4, c = n & 15; float v[8];
                if (k8 < 64) { const int s = k8 >> 1, c0 = (k8 & 1) * 8;
#pragma unroll
                    for (int i = 0; i < 8; ++i) v[i] = 0.f;
                    if (s <= t) { const float* kp = Ktab + ((size_t)((g * 2 + 0) * 32 + (t - s)) * 256 + c * 16 + c0); const f32x4 k0 = *(const f32x4*)kp, k1 = *(const f32x4*)(kp + 4);
                        v[0] += k0.x; v[1] += k0.y; v[2] += k0.z; v[3] += k0.w; v[4] += k1.x; v[5] += k1.y; v[6] += k1.z; v[7] += k1.w; }
                    if (s >= t) { const float* kp = Ktab + ((size_t)((g * 2 + 1) * 32 + (s - t)) * 256 + c * 16 + c0); const f32x4 k0 = *(const f32x4*)kp, k1 = *(const f32x4*)(kp + 4);
                        v[0] += k0.x; v[1] += k0.y; v[2] += k0.z; v[3] += k0.w; v[4] += k1.x; v[5] += k1.y; v[6] += k1.z; v[7] += k1.w; }
                    if (s == t) { const float dv = dskip[g * 16 + c];
#pragma unroll
                        for (int i = 0; i < 8; ++i) if (c0 + i == c) v[i] += dv; }
                } else { const int j = k8 - 64, dir = j >> 4, p0 = (j & 15) * 4, ex = dir == 0 ? t + 1 : 32 - t;
#pragma unroll
                    for (int i = 0; i < 4; ++i) { const int p = p0 + i; const size_t ci = ((size_t)(dir * 32 + g) * 16 + c) * 64 + p; const float cr = c_re[ci], cim = c_im[ci]; const f32x2 w = PW[((size_t)(g * 2 + dir) * 33 + ex) * 64 + p];
                        const float zr = cr * w.x - cim * w.y, zi = cr * w.y + cim * w.x; v[2 * i] = zr; v[2 * i + 1] = -zi; } }
                u32x4 o; o.x = cvt_pk_bf16(v[0], v[1]); o.y = cvt_pk_bf16(v[2], v[3]); o.z = cvt_pk_bf16(v[4], v[5]); o.w = cvt_pk_bf16(v[6], v[7]);
                *(u32x4*)(Bs5 + ((size_t)g * 512 + n) * KS5 + k8 * 8) = o; }
            for (int e = gt; e < 32 * 256 * 64; e += NT) { const int k8 = e & 63, n = (e >> 6) & 255, g = e >> 14, dir = n >> 7, reim = n & 1, p = (n >> 1) & 63, s = k8 >> 1, c0 = (k8 & 1) * 8, ex = dir == 0 ? 31 - s : s;
                const f32x2 w = PW[((size_t)(g * 2 + dir) * 33 + ex) * 64 + p]; float v[8];
#pragma unroll
                for (int i = 0; i < 8; ++i) { const f32x2 b = BB[((size_t)(g * 2 + dir) * 64 + p) * 16 + c0 + i]; v[i] = reim ? (w.x * b.y + w.y * b.x) : (w.x * b.x - w.y * b.y); }
                u32x4 o; o.x = cvt_pk_bf16(v[0], v[1]); o.y = cvt_pk_bf16(v[2], v[3]); o.z = cvt_pk_bf16(v[4], v[5]); o.w = cvt_pk_bf16(v[6], v[7]);
                *(u32x4*)(Wst + ((size_t)g * 256 + n) * 512 + k8 * 8) = o; }
        }
        __syncthreads();
        for (int it = bid; it < 208; it += G) {
            const float* W; int ldw, n0, chunk; float* dst;
            if (it < 32) { W = a.in[10]; ldw = D; n0 = it * 32; chunk = 3; dst = SW_IN; }
            else if (it < 120) { W = a.in[7] + (size_t)D * FF; ldw = FF; n0 = (it - 32) * 32; chunk = 6; dst = SW1; }
            else { W = a.in[8] + (size_t)D * FF; ldw = FF; n0 = (it - 120) * 32; chunk = 6; dst = SW3; }
            const int kc = tid >> 5, nl = tid & 31; float s0 = 0.f, s1 = 0.f, s2 = 0.f;
#pragma unroll 16
            for (int kk = 0; kk < 64; ++kk) { const int k = kc * 64 + kk; const float w = W[(size_t)k * ldw + n0 + nl];
                s0 += mod[0 * NMODW + chunk * 1024 + k] * w; s1 += mod[1 * NMODW + chunk * 1024 + k] * w; s2 += mod[2 * NMODW + chunk * 1024 + k] * w; }
            LAS float* red = (LAS float*)lds;
            red[kc * 96 + nl] = s0; red[kc * 96 + 32 + nl] = s1; red[kc * 96 + 64 + nl] = s2;
            __syncthreads();
            if (tid < 96) { float t = 0.f;
#pragma unroll
                for (int k2 = 0; k2 < 16; ++k2) t += red[k2 * 96 + tid];
                dst[(tid >> 5) * ldw + n0 + (tid & 31)] = t; }
            __syncthreads();
        }
        for (int m = gw; m < MALL; m += NGW) { const int set = m < SEQ ? 0 : (m < ML ? 1 : 2); const float* src = m < ML ? xin_ + (size_t)m * D : ctx + (size_t)(m - ML) * D;
            norm_mod_row(src, norm_g, mod + set * NMODW + 0 * 1024, mod + set * NMODW + 1 * 1024, Hn + (size_t)m * D, lane); }
    }
    GSYNC();

    PH(2) { pg8::Gemm g{Hn, W13a, D, D, D, 0, 0}; pg8::StaticOrder S; S.init(MALL, 2 * FF, D, G, bid); EpiUp E{Ubuf, nullptr, nullptr, nullptr}; pg8::gemm_phase(lds, g, S, E); }
    GSYNC();
    PH(3) { pg8::Gemm g{Ubuf, W2a, FF, FF, FF, 0, 0}; pg8::TailOrder S; S.init(ML, D, FF, G, bid, 88, 11, 0, 4); EpiRes<1> E{xin_, out, Pc, mod + 2 * 1024, Hn, norm_g + 1024, mod + 4 * 1024, SSQ}; pg8::gemm_phase(lds, g, S, E); }
    GSYNC();
    PH(4) {
        for (int m = (gw & 3) == 0 ? (gw >> 2) : MC; m < MC; m += (NGW + 3) >> 2) {
            const f32x4* xr = (const f32x4*)(ctx + (size_t)m * D) + lane; f32x4 v[4]; float ss = 0.f;
#pragma unroll
            for (int j = 0; j < 4; ++j) { f32x4 p = {0.f, 0.f, 0.f, 0.f};
#pragma unroll
                for (int ks = 0; ks < 11; ++ks) p += ((const f32x4*)(Pc + (size_t)ks * MC * D + (size_t)m * D))[lane + 64 * j];
                v[j] = xr[64 * j] + (((const f32x4*)(mod + 2 * NMODW + 2 * 1024))[lane + 64 * j] * 0.5f) * p;
                ss += (v[j].x * v[j].x + v[j].y * v[j].y) + (v[j].z * v[j].z + v[j].w * v[j].w); }
            const float r = 1.0f / sqrtf(wave_sum(ss) * (1.f / D) + EPS);
            if (lane == 0) RCTX[m] = r;
            u32x2* o8 = (u32x2*)(Hn + (size_t)(ML + m) * D) + lane;
#pragma unroll
            for (int j = 0; j < 4; ++j) { const f32x4 gg = ((const f32x4*)(norm_g + 1024))[lane + 64 * j], sc = ((const f32x4*)(mod + 2 * NMODW + 4 * 1024))[lane + 64 * j];
                const f32x4 h = v[j] * (gg * (sc + 1.0f)); u32x2 w; w.x = cvt_pk_bf16(h.x, h.y); w.y = cvt_pk_bf16(h.z, h.w); o8[64 * j] = w; }
        }
    }
    GSYNC();
    PH(5) { pg8::Gemm g{Hn, Win_t, D, D, D, 0, 0}; pg8::TailOrder S; S.init(ML, D, D, G, bid, 16, 4, 2, 2); EpiWin E{poolb, As5, Uctx, SSQ, SW_IN}; pg8::gemm_phase(lds, g, S, E); }
    GSYNC();
    PH(6) {
        const int Gg = G < 64 ? G : 64;
        { pg8::Gemm g{As5, Wst, KS5, 512, 512, (size_t)ROWS5 * KS5, (size_t)256 * 512}; pg8::GroupOrder S; S.init(2, 1, 32, 512, Gg, bid); EpiState E{Sbuf}; pg8::gemm_phase(lds, g, S, E); }
        const int r1 = (bid + G - Gg % G) % G;
        for (int it = r1; it < 32; it += G) { const int b = it >> 4, g0 = (it & 15) * 2, g = g0 + ((wave >> 1) & 1), dir = wave & 1, wi = (b * 32 + g) * 2 + dir;
            LAS float* ul = (LAS float*)lds;
            int tid_c = tid; asm volatile("" : "+v"(tid_c));
            __syncthreads();
#pragma unroll
            for (int i = 0; i < 4; ++i) { const int idx = i * 512 + tid_c, t = idx >> 3, q = idx & 7; const size_t off = (size_t)(b * CTXL + t) * 512 + g0 * 16 + q * 4;
                const f32x4 s4 = (*(const f32x4*)(Uctx + off) + *(const f32x4*)(Uctx + (size_t)MC * 512 + off)) + (*(const f32x4*)(Uctx + (size_t)2 * MC * 512 + off) + *(const f32x4*)(Uctx + (size_t)3 * MC * 512 + off));
                *(LAS f32x4*)(ul + t * 32 + q * 4) = s4 * RCTX[b * CTXL + t] + *(const f32x4*)(SW_IN + 2 * 1024 + 512 + g0 * 16 + q * 4); }
            const f32x2 av = PW[((size_t)(g * 2 + dir) * 33 + 1) * 64 + lane]; f32x2 bb[16];
#pragma unroll
            for (int i = 0; i < 16; ++i) bb[i] = BB[((size_t)(g * 2 + dir) * 64 + lane) * 16 + i];
            __syncthreads();
            float hr = 0.f, hi = 0.f; const int gl = ((wave >> 1) & 1) * 16;
            if (wave < 4) {
#pragma unroll 4
            for (int step = 0; step < CTXL; ++step) { const int t = dir == 0 ? step : CTXL - 1 - step; const LAS f32x4* up = (const LAS f32x4*)(ul + t * 32 + gl);
                const f32x4 u0 = up[0], u1 = up[1], u2 = up[2], u3 = up[3]; f32x2 sa = {0.f, 0.f}, sb = {0.f, 0.f};
#pragma unroll
                for (int i = 0; i < 4; ++i) { sa += bb[i] * u0[i]; sb += bb[4 + i] * u1[i]; }
#pragma unroll
                for (int i = 0; i < 4; ++i) { sa += bb[8 + i] * u2[i]; sb += bb[12 + i] * u3[i]; }
                const f32x2 sv = sa + sb;
                const float nr = av.x * hr - av.y * hi + sv.x, ni = av.x * hi + av.y * hr + sv.y; hr = nr; hi = ni; }
            Hctx[(size_t)wi * 64 + lane] = (f32x2){hr, hi}; } }
        {
            unsigned* pctr = (unsigned*)(ws + 69632);
            volatile LAS unsigned* sh_it = (volatile LAS unsigned*)(lds + LDS_BYTES - 32);
            LAS bf16_t* raw = (LAS bf16_t*)lds;
            LAS float* rowb = (LAS float*)(lds + 131072);
            LAS bf16_t* ob = (LAS bf16_t*)(lds + 131072 + 8192);
            for (;;) {
                __syncthreads();
                if (tid == 0) *sh_it = __hip_atomic_fetch_add(pctr, 1u, __ATOMIC_RELAXED, __HIP_MEMORY_SCOPE_AGENT);
                __syncthreads();
                const int it = (int)*sh_it;
                if (it >= 512) break;
                const int k = 3 - (it >> 7), bs = (it & 127) >> 2, r_begin = (it & 3) * 32, r_end = r_begin + 32, b = bs >> 4, slab = bs & 15;
                const int w = 2 << k, lo = w >> 1, hi = w - 1 - lo, ra = r_begin - lo < 0 ? 0 : r_begin - lo, rz = r_end - 1 + hi > 127 ? 127 : r_end - 1 + hi, ntok = (rz - ra + 1) * 64;
                const bf16_t* src = poolb + (size_t)((b * 4 + k) * 16 + slab) * 8192 * 8;
                for (int i = tid; i < ntok; i += 512) { const int tok = ra * 64 + i; *(LAS u32x4*)(raw + tok * 8) = *(const u32x4*)(src + (size_t)tok * 8); }
                __syncthreads();
                bf16_t* dst = mixcat + (size_t)b * SEQ * D + k * 128 + slab * 8;
                if (k == 0) pool_rows<2>(raw, rowb, ob, dst, tid, r_begin, r_end); else if (k == 1) pool_rows<4>(raw, rowb, ob, dst, tid, r_begin, r_end); else if (k == 2) pool_rows<8>(raw, rowb, ob, dst, tid, r_begin, r_end); else pool_rows<16>(raw, rowb, ob, dst, tid, r_begin, r_end);
            }
        }
    }
    GSYNC();
    PH(7) for (int wi = bid; wi < 128; wi += G) {
        const int b = wi >> 6, g = (wi >> 1) & 31, dir = wi & 1; const size_t rbase = (size_t)g * ROWS5 + b * 256;
        LAS float* sl = (LAS float*)lds;
        __syncthreads();
#pragma unroll 4
        for (int i = 0; i < 16; ++i) { const int row = i * 16 + (tid >> 5), q = tid & 31; *(LAS f32x4*)(sl + row * 128 + q * 4) = *(const f32x4*)(Sbuf + (rbase + row) * 256 + dir * 128 + q * 4); }
        __syncthreads();
        if (wave == 0) { const f32x2 a32 = PW[((size_t)(g * 2 + dir) * 33 + 32) * 64 + lane]; f32x2 h = Hctx[(size_t)wi * 64 + lane];
#pragma unroll 8
            for (int step = 0; step < 256; ++step) { const int j = dir == 0 ? step : 255 - step; const f32x2 sv = *(const LAS f32x2*)(sl + j * 128 + lane * 2);
                *(unsigned*)(As5 + (rbase + j) * KS5 + 512 + dir * 128 + lane * 2) = cvt_pk_bf16(h.x, h.y);
                const float nr = a32.x * h.x - a32.y * h.y + sv.x, ni = a32.x * h.y + a32.y * h.x + sv.y; h.x = nr; h.y = ni; } }
    }
    PH(7) { __syncthreads(); DEFER_T(0, 1056); }
    GSYNC();
    PH(8) { pg8::Gemm g{As5, Bs5, KS5, KS5, KS5, (size_t)ROWS5 * KS5, (size_t)512 * KS5}; pg8::GroupOrder S; S.init(2, 2, 32, KS5, G, bid); EpiS5 E{Ybuf}; pg8::gemm_phase(lds, g, S, E); DEFER_T(1056, 3168); }
    GSYNC();
    PH(9) { pg8::Gemm g{Ybuf, Wglu_t, 512, 512, 512, 0, 0}; pg8::StaticOrder S; S.init(ML, 512, 512, G, bid); EpiGlu E{Ybuf, mixcat}; pg8::gemm_phase(lds, g, S, E); DEFER_T(3168, 4224); }
    GSYNC();
    PH(10) { pg8::Gemm g{mixcat, Wmix_t, D, D, D, 0, 0}; pg8::StaticOrder S; S.init(ML, D, D, G, bid); EpiRes<0> E{out, out, Pc, mod + 5 * 1024, Hn, norm_g + 2048, mod + 7 * 1024, SSQ}; pg8::gemm_phase(lds, g, S, E); }
    GSYNC();
    PH(12) { pg8::Gemm g{Hn, W13b, D, D, D, 0, 0}; pg8::StaticOrder S; S.init(ML, 2 * FF, D, G, bid); EpiUp E{Ubuf, SSQ, SW1, SW3}; pg8::gemm_phase(lds, g, S, E); }
    GSYNC();
    PH(13) { pg8::Gemm g{Ubuf, W2b, FF, FF, FF, 0, 0}; pg8::StaticOrder S; S.init(ML, D, FF, G, bid); EpiRes<1> E{out, out, Pc, mod + 8 * 1024, nullptr, nullptr, nullptr, nullptr}; pg8::gemm_phase(lds, g, S, E); }
    GSYNC();
    for (int xs_ = 0; xs_ < XSYNC; ++xs_) GSYNC();
    PH(14) {
        const float* fg = a.in[23];
        for (int m = gw; m < ML; m += NGW) { f32x4* xr = (f32x4*)(out + (size_t)m * D) + lane; f32x4 v[4]; float s = 0.f;
#pragma unroll
            for (int j = 0; j < 4; ++j) { v[j] = xr[64 * j]; s += (v[j].x * v[j].x + v[j].y * v[j].y) + (v[j].z * v[j].z + v[j].w * v[j].w); }
            const float r = 1.0f / sqrtf(wave_sum(s) * (1.f / D) + EPS);
#pragma unroll
            for (int j = 0; j < 4; ++j) xr[64 * j] = (v[j] * r) * ((const f32x4*)fg)[lane + 64 * j]; }
    }
#if TPROBE
    GSYNC();
    if (bid == 0) { __syncthreads();
        long K = TPROBE == 2 ? 400000 : (long)(tsb[TSEL_B] - tsb[TSEL_A]) * 5; if (K > 900000) K = 900000; if (K < 0) K = 0;
        for (long i = tid; i < K; i += 512) out[i] += 0.02f; }
#endif
}

#undef ws
#undef xin_
#undef cvec
#undef ctx
#undef cctx
#undef norm_g
#undef w_ada
#undef b_ada
#undef mod
#undef Hctx
#undef Win_t
#undef Wmix_t
#undef Wglu_t
#undef BB
#undef Ktab
#undef PW
#undef W13a
#undef W2a
#undef W13b
#undef W2b
#undef Wst
#undef Bs5
#undef Hn
#undef mixcat
#undef X1c
#undef Uctx
#undef Pc
#undef SSQ
#undef SW_IN
#undef SW1
#undef SW3
#undef RCTX
#undef Ubuf
#undef poolb
#undef As5
#undef Sbuf
#undef Ybuf
#undef out
extern "C" void kernel_launch(void* const* d_in, const int* in_sizes, int n_in, void* d_out, int out_size, void* d_ws, size_t ws_size, hipStream_t stream) {
    static int grid = 0;
    if (grid == 0) {
        if (n_in != 24 || out_size != ML * D || ws_size < WS_END) { fprintf(stderr, "kernel_launch: unexpected shapes (n_in %d out %d ws %zu)\n", n_in, out_size, ws_size); grid = -1; return; }
        int dev = 0, cus = 0, per_cu = 0;
        hipGetDevice(&dev); hipDeviceGetAttribute(&cus, hipDeviceAttributeMultiprocessorCount, dev);
        hipFuncSetAttribute((const void*)fwd_megakernel, hipFuncAttributeMaxDynamicSharedMemorySize, LDS_BYTES);
        if (hipOccupancyMaxActiveBlocksPerMultiprocessor(&per_cu, (const void*)fwd_megakernel, 512, LDS_BYTES) != hipSuccess || per_cu < 1) per_cu = 1;
        (void)hipGetLastError();
        grid = cus * 1;
        if (grid <= 0) grid = 256;
    }
    if (grid < 0) return;
    KArgs a{};
    for (int i = 0; i < 24; ++i) a.in[i] = (const float*)d_in[i];
    a.out = (float*)d_out; a.ws = (unsigned char*)d_ws;
    void* args[] = {&a};
    hipError_t e = hipLaunchCooperativeKernel((const void*)fwd_megakernel, dim3(grid), dim3(512), args, LDS_BYTES, stream);
    if (e != hipSuccess) fprintf(stderr, "cooperative launch failed: %s (grid %d)\n", hipGetErrorString(e), grid);
}
```
